# Optimizing an MI355X kernel written in HIP

```python
import math
import jax, jax.numpy as jnp
from jax import lax
import numpy as np

D_MODEL = 1024
BATCH = 16
SEQ = 2048
DEPTH = 4

GRID_W = 64
N_EVEN = (DEPTH + 1) // 2
N_ODD = DEPTH // 2
EPS = 1e-6

DA_HEADS = 4
DA_HEAD_DIM = 64
DA_WIDTH = DA_HEADS * 2 * DA_HEAD_DIM
Q_BLOCK = 128
T5_BUCKETS = 32
T5_MAX_DIST = 128
LRU_WIDTH = D_MODEL // 2
LRU_BLOCKS = 8
LRU_BLOCK = LRU_WIDTH // LRU_BLOCKS
CONV_W = 4
CONV_PAD = (2, 1)
LRU_C = 8.0
EVEN_IN = 4 * DA_WIDTH + 2 * LRU_WIDTH
EVEN_MIX = DA_WIDTH + LRU_WIDTH
NA_HEADS = 16
NA_HEAD_DIM = 64
NA_WIDTH = NA_HEADS * NA_HEAD_DIM
NA_WIN_R = 8
NA_WIN_C = 16
ODD_IN = 4 * NA_WIDTH

kernel_name = "hybrid_diffattn_rglru_natten_encoder"


def rms_norm(x, g):
    xf = x.astype(jnp.float32)
    y = xf * lax.rsqrt(jnp.mean(xf * xf, axis=-1, keepdims=True) + EPS)
    return (y * g.astype(jnp.float32)).astype(x.dtype)


def t5_bucket(rel):
    nb = T5_BUCKETS // 2
    max_exact = nb // 2
    ret = jnp.where(rel > 0, nb, 0)
    n = jnp.abs(rel)
    nf = jnp.maximum(n, 1).astype(jnp.float32)
    large = max_exact + (jnp.log(nf / max_exact) / math.log(T5_MAX_DIST / max_exact)
                         * (nb - max_exact)).astype(jnp.int32)
    large = jnp.minimum(large, nb - 1)
    return ret + jnp.where(n < max_exact, n, large)


def diff_attention(q, k, v, t5_table, lam, lam_init, subln_g):
    B, S = q.shape[0], q.shape[1]
    H, d = DA_HEADS, DA_HEAD_DIM
    scale = d ** -0.5
    n_blk = S // Q_BLOCK
    qh = q.transpose(0, 2, 3, 1, 4)
    kh = k.transpose(0, 2, 3, 1, 4)
    vh = v.transpose(0, 2, 1, 3)
    qb = qh.reshape(B, H, 2, n_blk, Q_BLOCK, d).transpose(3, 0, 1, 2, 4, 5)
    k_pos = jnp.arange(S)

    def block(args):
        q_blk, start = args
        q_pos = start + jnp.arange(Q_BLOCK)
        bias = t5_table[:, t5_bucket(k_pos[None, :] - q_pos[:, None])].astype(jnp.float32)
        logits = jnp.einsum('bhmqd,bhmkd->bhmqk', q_blk, kh,
                            preferred_element_type=jnp.float32) * scale + bias[None, :, None]
        p = jax.nn.softmax(logits, axis=-1)
        attn = p[:, :, 0] - lam * p[:, :, 1]
        return jnp.einsum('bhqk,bhke->bhqe', attn.astype(vh.dtype), vh)

    out = lax.map(block, (qb, jnp.arange(n_blk) * Q_BLOCK))
    out = out.transpose(1, 0, 3, 2, 4).reshape(B, S, H, 2 * d)
    out = rms_norm(out, subln_g) * (1.0 - lam_init)
    return out.reshape(B, S, H * 2 * d)


def bidir_rglru(x, conv_w, conv_b, w_a, b_a, w_x, b_x, lam):
    B, S, W = x.shape
    xc = lax.conv_general_dilated(x, conv_w[:, None, :], window_strides=(1,), padding=[CONV_PAD],
                                  dimension_numbers=('NWC', 'WIO', 'NWC'),
                                  feature_group_count=W) + conv_b
    xb = xc.reshape(B, S, LRU_BLOCKS, LRU_BLOCK)
    za = jnp.einsum('bsnc,rncd->rbsnd', xb, w_a) + b_a.reshape(2, 1, 1, LRU_BLOCKS, LRU_BLOCK)
    zx = jnp.einsum('bsnc,rncd->rbsnd', xb, w_x) + b_x.reshape(2, 1, 1, LRU_BLOCKS, LRU_BLOCK)
    gate_a = jax.nn.sigmoid(za.astype(jnp.float32)).reshape(2, B, S, W)
    gate_x = jax.nn.sigmoid(zx.astype(jnp.float32)).reshape(2, B, S, W)
    log_a = -LRU_C * gate_a * jax.nn.softplus(-lam.astype(jnp.float32))[:, None, None, :]
    a = jnp.exp(log_a)
    mult = jnp.sqrt(-jnp.expm1(2.0 * log_a))
    u = mult * gate_x * xc.astype(jnp.float32)[None]

    def combine(l, r):
        return (l[0] * r[0], r[0] * l[1] + r[1])

    _, h_f = lax.associative_scan(combine, (a[0], u[0]), axis=1)
    _, h_b = lax.associative_scan(combine, (a[1], u[1]), axis=1, reverse=True)
    return (h_f + h_b).astype(x.dtype)


def neighborhood_attention(q, k, v, rpb):
    B, S, H, d = q.shape
    rows = S // GRID_W
    win_r = min(NA_WIN_R, rows)
    scale = d ** -0.5
    qg = q.reshape(B, rows, GRID_W, H, d).transpose(1, 0, 3, 2, 4)
    kg = k.reshape(B, rows, GRID_W, H, d).transpose(0, 3, 1, 2, 4)
    vg = v.reshape(B, rows, GRID_W, H, d).transpose(0, 3, 1, 2, 4)
    cols = jnp.arange(GRID_W)
    col_start = jnp.clip(cols - NA_WIN_C // 2, 0, GRID_W - NA_WIN_C)
    col_mask = (cols[None, :] >= col_start[:, None]) & (cols[None, :] < col_start[:, None] + NA_WIN_C)
    dc_idx = jnp.clip(cols[None, :] - cols[:, None], -(NA_WIN_C - 1), NA_WIN_C - 1) + NA_WIN_C - 1

    def row_block(args):
        q_row, r = args
        rs = jnp.clip(r - NA_WIN_R // 2, 0, rows - win_r)
        k_blk = lax.dynamic_slice_in_dim(kg, rs, win_r, axis=2)
        v_blk = lax.dynamic_slice_in_dim(vg, rs, win_r, axis=2)
        dr_idx = rs + jnp.arange(win_r) - r + NA_WIN_R - 1
        bias = rpb[:, dr_idx[None, :, None], dc_idx[:, None, :]].astype(jnp.float32)
        logits = jnp.einsum('bhqd,bhikd->bhqik', q_row, k_blk,
                            preferred_element_type=jnp.float32) * scale + bias
        logits = jnp.where(col_mask[:, None, :], logits, -jnp.inf)
        p = jax.nn.softmax(logits.reshape(B, H, GRID_W, win_r * GRID_W), axis=-1)
        p = p.reshape(B, H, GRID_W, win_r, GRID_W)
        return jnp.einsum('bhqik,bhikd->bhqd', p.astype(v_blk.dtype), v_blk)

    out = lax.map(row_block, (qg, jnp.arange(rows)))
    return out.transpose(1, 0, 3, 2, 4).reshape(B, S, H * d)


def setup_inputs(seed: int = 0) -> dict:
    key = jax.random.key(seed)
    ks = jax.random.split(key, 24)
    f32 = jnp.float32
    D = D_MODEL
    nrm = lambda k, shape, s: jax.random.normal(k, shape, f32) * s
    a0 = jax.random.uniform(ks[16], (N_EVEN, 2, LRU_WIDTH), f32, 0.9, 0.999)
    p0 = a0 ** (1.0 / LRU_C)
    lru_lambda = jnp.log(p0) - jnp.log1p(-p0)
    return {
        "x": nrm(ks[0], (BATCH, SEQ, D), 1.0),
        "c": nrm(ks[1], (BATCH, D), 1.0),
        "ada_w": nrm(ks[2], (DEPTH, D, 3 * D), 0.5 * D ** -0.5),
        "ada_b": nrm(ks[3], (DEPTH, 3 * D), 0.01),
        "norm_g": 1.0 + nrm(ks[4], (DEPTH, D), 0.02),
        "final_g": 1.0 + nrm(ks[5], (D,), 0.02),
        "t5_table": nrm(ks[6], (DA_HEADS, T5_BUCKETS), 0.5),
        "even_w_in": nrm(ks[7], (N_EVEN, D, EVEN_IN), D ** -0.5),
        "even_w_out": nrm(ks[8], (N_EVEN, EVEN_MIX, D), EVEN_MIX ** -0.5),
        "da_lam": nrm(ks[9], (N_EVEN, 4, DA_HEAD_DIM), 0.1),
        "da_subln_g": 1.0 + nrm(ks[10], (N_EVEN, 2 * DA_HEAD_DIM), 0.02),
        "lru_conv_w": nrm(ks[11], (N_EVEN, CONV_W, LRU_WIDTH), CONV_W ** -0.5),
        "lru_conv_b": nrm(ks[12], (N_EVEN, LRU_WIDTH), 0.01),
        "lru_w_a": nrm(ks[13], (N_EVEN, 2, LRU_BLOCKS, LRU_BLOCK, LRU_BLOCK), LRU_BLOCK ** -0.5),
        "lru_b_a": nrm(ks[14], (N_EVEN, 2, LRU_WIDTH), 0.01),
        "lru_w_x": nrm(ks[15], (N_EVEN, 2, LRU_BLOCKS, LRU_BLOCK, LRU_BLOCK), LRU_BLOCK ** -0.5),
        "lru_b_x": nrm(ks[17], (N_EVEN, 2, LRU_WIDTH), 0.01),
        "lru_lambda": lru_lambda,
        "odd_w_in": nrm(ks[18], (N_ODD, D, ODD_IN), D ** -0.5),
        "odd_w_out": nrm(ks[19], (N_ODD, NA_WIDTH, D), NA_WIDTH ** -0.5),
        "na_rpb": nrm(ks[20], (N_ODD, NA_HEADS, 2 * NA_WIN_R - 1, 2 * NA_WIN_C - 1), 0.3),
    }


def even_mixer(h, w_in, w_out, t5_table, lam_p, lam_init, subln_g,
               conv_w, conv_b, w_a, b_a, w_x, b_x, lru_lambda):
    B, S, _ = h.shape
    proj = h @ w_in
    q, k, v, g_a, x_b, g_b = jnp.split(
        proj, [DA_WIDTH, 2 * DA_WIDTH, 3 * DA_WIDTH, 4 * DA_WIDTH, 4 * DA_WIDTH + LRU_WIDTH], axis=-1)
    q = q.reshape(B, S, DA_HEADS, 2, DA_HEAD_DIM)
    k = k.reshape(B, S, DA_HEADS, 2, DA_HEAD_DIM)
    v = v.reshape(B, S, DA_HEADS, 2 * DA_HEAD_DIM)
    lp = lam_p.astype(jnp.float32)
    lam = jnp.exp(jnp.sum(lp[0] * lp[1])) - jnp.exp(jnp.sum(lp[2] * lp[3])) + lam_init
    a_out = diff_attention(q, k, v, t5_table, lam, lam_init, subln_g)
    b_out = bidir_rglru(x_b, conv_w, conv_b, w_a, b_a, w_x, b_x, lru_lambda)
    mixed = jnp.concatenate([a_out * jax.nn.silu(g_a), b_out * jax.nn.silu(g_b)], axis=-1)
    return mixed @ w_out


def odd_mixer(h, w_in, w_out, rpb):
    B, S, _ = h.shape
    proj = h @ w_in
    q, k, v, g = jnp.split(proj, 4, axis=-1)
    shp = (B, S, NA_HEADS, NA_HEAD_DIM)
    out = neighborhood_attention(q.reshape(shp), k.reshape(shp), v.reshape(shp), rpb)
    return (out * jax.nn.silu(g)) @ w_out


def reference(x, c, ada_w, ada_b, norm_g, final_g, t5_table, even_w_in, even_w_out, da_lam, da_subln_g,
              lru_conv_w, lru_conv_b, lru_w_a, lru_b_a, lru_w_x, lru_b_x, lru_lambda,
              odd_w_in, odd_w_out, na_rpb):
    c_act = jax.nn.silu(c)
    for l in range(DEPTH):
        mod = c_act @ ada_w[l] + ada_b[l]
        shift, scale, gate = jnp.split(mod, 3, axis=-1)
        h = rms_norm(x, norm_g[l]) * (1.0 + scale[:, None, :]) + shift[:, None, :]
        if l % 2 == 0:
            e = l // 2
            lam_init = 0.8 - 0.6 * math.exp(-0.3 * l)
            y = even_mixer(h, even_w_in[e], even_w_out[e], t5_table, da_lam[e], lam_init, da_subln_g[e],
                           lru_conv_w[e], lru_conv_b[e], lru_w_a[e], lru_b_a[e], lru_w_x[e], lru_b_x[e],
                           lru_lambda[e])
        else:
            o = l // 2
            y = odd_mixer(h, odd_w_in[o], odd_w_out[o], na_rpb[o])
        x = x + gate[:, None, :] * y
    return rms_norm(x, final_g)
```

```cpp
#include <hip/hip_runtime.h>
#include <cstdio>
#include <cstdint>
#include <cmath>

namespace nv {
constexpr int D = 1024, S = 2048, NB = 16;

__device__ __forceinline__ float silu(float v) { return v / (1.f + __expf(-v)); }
__device__ __forceinline__ float sigm(float v) { return 1.f / (1.f + __expf(-v)); }
__device__ __forceinline__ int t5_bucket(int rel) {
    const int n = rel < 0 ? -rel : rel; const int ret = rel > 0 ? 16 : 0;
    int v; if (n < 8) v = n; else { v = 33 - __clz(n * n); if (v > 15) v = 15; }
    return ret + v;
}
__device__ __forceinline__ float block_sum(float v, float* red) {
    const int tid = threadIdx.x;
#pragma unroll
    for (int o = 32; o > 0; o >>= 1) v += __shfl_xor(v, o);
    __syncthreads();
    if ((tid & 63) == 0) red[tid >> 6] = v;
    __syncthreads();
    return red[0] + red[1] + red[2] + red[3];
}
__device__ __forceinline__ float block_max(float v, float* red) {
    const int tid = threadIdx.x;
#pragma unroll
    for (int o = 32; o > 0; o >>= 1) v = fmaxf(v, __shfl_xor(v, o));
    __syncthreads();
    if ((tid & 63) == 0) red[tid >> 6] = v;
    __syncthreads();
    return fmaxf(fmaxf(red[0], red[1]), fmaxf(red[2], red[3]));
}

__global__ __launch_bounds__(256) void k_mod(const float* c, const float* ada_w, const float* ada_b, float* mod) {
    const int idx = blockIdx.x * 256 + threadIdx.x;
    const int j = idx % 3072, b = (idx / 3072) % 16, l = idx / (3072 * 16);
    const float* w = ada_w + (size_t)l * 1024 * 3072 + j; const float* cb = c + b * 1024;
    float acc = 0.f;
    for (int k = 0; k < 1024; ++k) acc += silu(cb[k]) * w[(size_t)k * 3072];
    mod[idx] = acc + ada_b[l * 3072 + j];
}
__global__ __launch_bounds__(256) void k_h(const float* x, const float* g, const float* modlb, float* h) {
    __shared__ float red[4];
    const int t = blockIdx.x, tid = threadIdx.x; const float* xr = x + (size_t)t * D;
    float v[4], ss = 0.f;
#pragma unroll
    for (int i = 0; i < 4; ++i) { v[i] = xr[tid + 256 * i]; ss += v[i] * v[i]; }
    ss = block_sum(ss, red);
    const float r = rsqrtf(ss * (1.f / D) + 1e-6f);
#pragma unroll
    for (int i = 0; i < 4; ++i) { const int k = tid + 256 * i; h[(size_t)t * D + k] = v[i] * r * g[k] * (1.f + modlb[1024 + k]) + modlb[k]; }
}
__global__ __launch_bounds__(256) void k_gemm(const float* A, const float* W, float* C, int M, int N, int K) {
    __shared__ float As[16][68]; __shared__ float Ws[16][68];
    const int tid = threadIdx.x, tx = tid & 15, ty = tid >> 4, m0 = blockIdx.y * 64, n0 = blockIdx.x * 64;
    float acc[4][4];
#pragma unroll
    for (int i = 0; i < 4; ++i)
#pragma unroll
        for (int j = 0; j < 4; ++j) acc[i][j] = 0.f;
    for (int k0 = 0; k0 < K; k0 += 16) {
        { const int row = tid >> 2, kq = (tid & 3) * 4; const float4 v = *(const float4*)&A[(size_t)(m0 + row) * K + k0 + kq];
          As[kq][row] = v.x; As[kq + 1][row] = v.y; As[kq + 2][row] = v.z; As[kq + 3][row] = v.w; }
        { const int kk = tid >> 4, n4 = (tid & 15) * 4; *(float4*)&Ws[kk][n4] = *(const float4*)&W[(size_t)(k0 + kk) * N + n0 + n4]; }
        __syncthreads();
#pragma unroll
        for (int kk = 0; kk < 16; ++kk) {
            const float4 a = *(const float4*)&As[kk][ty * 4]; const float4 b = *(const float4*)&Ws[kk][tx * 4];
            const float av[4] = {a.x, a.y, a.z, a.w}, bv[4] = {b.x, b.y, b.z, b.w};
#pragma unroll
            for (int i = 0; i < 4; ++i)
#pragma unroll
                for (int j = 0; j < 4; ++j) acc[i][j] += av[i] * bv[j];
        }
        __syncthreads();
    }
#pragma unroll
    for (int i = 0; i < 4; ++i) *(float4*)&C[(size_t)(m0 + ty * 4 + i) * N + n0 + tx * 4] = make_float4(acc[i][0], acc[i][1], acc[i][2], acc[i][3]);
}
__global__ __launch_bounds__(256) void k_diffattn(const float* proj, const float* t5, const float* lamp, float lam_init, const float* subg, float* mixed) {
    __shared__ float qs[128]; __shared__ float sc[2][2048]; __shared__ float red[4]; __shared__ float pv[256]; __shared__ float lam_s;
    const int q = blockIdx.x, h = blockIdx.y, tid = threadIdx.x;
    if (tid < 128) qs[tid] = proj[(size_t)q * 3072 + h * 128 + tid];
    if (tid == 0) { float s01 = 0.f, s23 = 0.f; for (int i = 0; i < 64; ++i) { s01 += lamp[i] * lamp[64 + i]; s23 += lamp[128 + i] * lamp[192 + i]; } lam_s = expf(s01) - expf(s23) + lam_init; }
    __syncthreads();
    for (int m = 0; m < 2; ++m)
        for (int k = tid; k < 2048; k += 256) {
            const float* kr = proj + (size_t)k * 3072 + 512 + h * 128 + m * 64; float d = 0.f;
            for (int i = 0; i < 64; ++i) d += qs[m * 64 + i] * kr[i];
            sc[m][k] = d * 0.125f + t5[h * 32 + t5_bucket(k - q)];
        }
    __syncthreads();
    float inv[2];
    for (int m = 0; m < 2; ++m) {
        float mx = -INFINITY; for (int k = tid; k < 2048; k += 256) mx = fmaxf(mx, sc[m][k]);
        mx = block_max(mx, red);
        float s = 0.f; for (int k = tid; k < 2048; k += 256) { const float e = expf(sc[m][k] - mx); sc[m][k] = e; s += e; }
        s = block_sum(s, red); inv[m] = 1.f / s;
    }
    const float lam = lam_s;
    for (int k = tid; k < 2048; k += 256) sc[0][k] = sc[0][k] * inv[0] - lam * sc[1][k] * inv[1];
    __syncthreads();
    { const int e = tid & 127, half = tid >> 7; float a = 0.f; const float* vb = proj + 1024 + h * 128 + e;
      for (int k = half * 1024; k < half * 1024 + 1024; ++k) a += sc[0][k] * vb[(size_t)k * 3072];
      pv[tid] = a; }
    __syncthreads();
    float o = 0.f; if (tid < 128) o = pv[tid] + pv[tid + 128];
    const float ss = block_sum(o * o, red);
    if (tid < 128) { const float r = rsqrtf(ss * (1.f / 128.f) + 1e-6f); const float val = o * r * subg[tid] * (1.f - lam_init);
        const float g = proj[(size_t)q * 3072 + 1536 + h * 128 + tid]; mixed[(size_t)q * 1024 + h * 128 + tid] = val * silu(g); }
}
__global__ __launch_bounds__(256) void k_conv(const float* proj, const float* cw, const float* cb, float* xc) {
    const int idx = blockIdx.x * 256 + threadIdx.x; const int c = idx & 511, t = idx >> 9;
    float a = cb[c];
#pragma unroll
    for (int j = 0; j < 4; ++j) { const int tt = t + j - 2; if (tt >= 0 && tt < 2048) a += cw[j * 512 + c] * proj[(size_t)tt * 3072 + 2048 + c]; }
    xc[idx] = a;
}
__global__ __launch_bounds__(256) void k_gates(const float* xc, const float* wa, const float* ba, const float* wx, const float* bx, const float* lam, float* Aout, float* Uout) {
    const int idx = blockIdx.x * 256 + threadIdx.x; const int c = idx & 511, t = idx >> 9, n = c >> 6, d = c & 63;
    const float* xr = xc + (size_t)t * 512 + n * 64; const float xv = xc[idx];
    for (int r = 0; r < 2; ++r) {
        const float* wap = wa + ((size_t)(r * 8 + n) * 64) * 64 + d; const float* wxp = wx + ((size_t)(r * 8 + n) * 64) * 64 + d;
        float za = ba[r * 512 + c], zx = bx[r * 512 + c];
        for (int cc = 0; cc < 64; ++cc) { za += xr[cc] * wap[cc * 64]; zx += xr[cc] * wxp[cc * 64]; }
        const float ga = sigm(za), gx = sigm(zx);
        const float y = -lam[r * 512 + c]; const float sp = fmaxf(y, 0.f) + log1pf(expf(-fabsf(y)));
        const float log_a = -8.f * ga * sp; const float a = expf(log_a); const float mult = sqrtf(-expm1f(2.f * log_a));
        Aout[(size_t)r * 2048 * 512 + idx] = a; Uout[(size_t)r * 2048 * 512 + idx] = mult * gx * xv;
    }
}
__global__ __launch_bounds__(256) void k_scan(const float* __restrict__ Ain, const float* __restrict__ Uin, const float* __restrict__ proj, float* __restrict__ mixed) {
    const int c = blockIdx.x * 256 + threadIdx.x;
    float h = 0.f;
    for (int t = 0; t < 2048; ++t) { h = Ain[(size_t)t * 512 + c] * h + Uin[(size_t)t * 512 + c]; mixed[(size_t)t * 1024 + 512 + c] = h; }
    h = 0.f; const float* A1 = Ain + (size_t)2048 * 512; const float* U1 = Uin + (size_t)2048 * 512;
    for (int t = 2047; t >= 0; --t) { h = A1[(size_t)t * 512 + c] * h + U1[(size_t)t * 512 + c];
        const float g = proj[(size_t)t * 3072 + 2560 + c]; mixed[(size_t)t * 1024 + 512 + c] = (mixed[(size_t)t * 1024 + 512 + c] + h) * silu(g); }
}
__global__ __launch_bounds__(256) void k_na(const float* proj, const float* rpb  , float* mixed) {
    __shared__ float ps[4][128];
    const int wid = threadIdx.x >> 6, lane = threadIdx.x & 63; const int item = blockIdx.x * 4 + wid; const int t = item >> 4, h = item & 15;
    const int r = t >> 6, c = t & 63; int rs = r - 4; rs = rs < 0 ? 0 : (rs > 24 ? 24 : rs); int cs = c - 8; cs = cs < 0 ? 0 : (cs > 48 ? 48 : cs);
    const float* qr = proj + (size_t)t * 4096 + h * 64;
    float sc[2];
#pragma unroll
    for (int i = 0; i < 2; ++i) { const int w = lane + 64 * i; const int kr = rs + (w >> 4), kc = cs + (w & 15); const float* kp = proj + (size_t)(kr * 64 + kc) * 4096 + 1024 + h * 64;
        float d = 0.f; for (int j = 0; j < 64; ++j) d += qr[j] * kp[j];
        sc[i] = d * 0.125f + rpb[(h * 15 + (kr - r + 7)) * 31 + (kc - c + 15)]; }
    float mx = fmaxf(sc[0], sc[1]);
#pragma unroll
    for (int o = 32; o > 0; o >>= 1) mx = fmaxf(mx, __shfl_xor(mx, o));
    const float e0 = expf(sc[0] - mx), e1 = expf(sc[1] - mx); float s = e0 + e1;
#pragma unroll
    for (int o = 32; o > 0; o >>= 1) s += __shfl_xor(s, o);
    ps[wid][lane] = e0 / s; ps[wid][lane + 64] = e1 / s;
    __syncthreads();
    float o = 0.f;
    for (int w = 0; w < 128; ++w) { const int kr = rs + (w >> 4), kc = cs + (w & 15); o += ps[wid][w] * proj[(size_t)(kr * 64 + kc) * 4096 + 2048 + h * 64 + lane]; }
    const float g = proj[(size_t)t * 4096 + 3072 + h * 64 + lane];
    mixed[(size_t)t * 1024 + h * 64 + lane] = o * silu(g);
}
__global__ __launch_bounds__(256) void k_resid(float* x, const float* y, const float* gate) {
    const int idx = blockIdx.x * 256 + threadIdx.x; x[idx] += gate[idx & 1023] * y[idx];
}
__global__ __launch_bounds__(256) void k_final(float* x, const float* g) {
    __shared__ float red[4];
    const int t = blockIdx.x, tid = threadIdx.x; float* xr = x + (size_t)t * D;
    float v[4], ss = 0.f;
#pragma unroll
    for (int i = 0; i < 4; ++i) { v[i] = xr[tid + 256 * i]; ss += v[i] * v[i]; }
    ss = block_sum(ss, red);
    const float r = rsqrtf(ss * (1.f / D) + 1e-6f);
#pragma unroll
    for (int i = 0; i < 4; ++i) xr[tid + 256 * i] = v[i] * r * g[tid + 256 * i];
}
}

extern "C" void kernel_launch(void* const* d_in, const int* in_sizes, int n_in, void* d_out, int out_size, void* d_ws, size_t ws_size, hipStream_t stream) {
    using namespace nv;
    const float* x_in = (const float*)d_in[0]; const float* c = (const float*)d_in[1]; const float* ada_w = (const float*)d_in[2]; const float* ada_b = (const float*)d_in[3];
    const float* norm_g = (const float*)d_in[4]; const float* final_g = (const float*)d_in[5]; const float* t5 = (const float*)d_in[6];
    const float* even_w_in = (const float*)d_in[7]; const float* even_w_out = (const float*)d_in[8]; const float* da_lam = (const float*)d_in[9]; const float* da_subg = (const float*)d_in[10];
    const float* conv_w = (const float*)d_in[11]; const float* conv_b = (const float*)d_in[12]; const float* w_a = (const float*)d_in[13]; const float* b_a = (const float*)d_in[14];
    const float* w_x = (const float*)d_in[15]; const float* b_x = (const float*)d_in[16]; const float* lru_lam = (const float*)d_in[17];
    const float* odd_w_in = (const float*)d_in[18]; const float* odd_w_out = (const float*)d_in[19]; const float* rpb = (const float*)d_in[20];
    float* x = (float*)d_out;
    char* ws = (char*)d_ws; const size_t MiB = 1u << 20;
    float* mod = (float*)(ws);
    float* hbuf = (float*)(ws + 1 * MiB);
    float* proj = (float*)(ws + 9 * MiB);
    float* mixed = (float*)(ws + 41 * MiB);
    float* ybuf = (float*)(ws + 49 * MiB);
    float* xc = (float*)(ws + 57 * MiB);
    float* Abuf = (float*)(ws + 61 * MiB);
    float* Ubuf = (float*)(ws + 69 * MiB);
    hipMemcpyAsync(x, x_in, (size_t)NB * S * D * 4, hipMemcpyDeviceToDevice, stream);
    k_mod<<<4 * 16 * 3072 / 256, 256, 0, stream>>>(c, ada_w, ada_b, mod);
    for (int l = 0; l < 4; ++l) {
        for (int b = 0; b < NB; ++b) {
            float* xb = x + (size_t)b * S * D; const float* modlb = mod + ((size_t)l * 16 + b) * 3072;
            k_h<<<S, 256, 0, stream>>>(xb, norm_g + l * 1024, modlb, hbuf);
            if ((l & 1) == 0) {
                const int e = l / 2; const float lam_init = (float)(0.8 - 0.6 * exp(-0.3 * (double)l));
                k_gemm<<<dim3(3072 / 64, S / 64), 256, 0, stream>>>(hbuf, even_w_in + (size_t)e * 1024 * 3072, proj, S, 3072, 1024);
                k_diffattn<<<dim3(S, 4), 256, 0, stream>>>(proj, t5, da_lam + e * 256, lam_init, da_subg + e * 128, mixed);
                k_conv<<<S * 512 / 256, 256, 0, stream>>>(proj, conv_w + e * 4 * 512, conv_b + e * 512, xc);
                k_gates<<<S * 512 / 256, 256, 0, stream>>>(xc, w_a + (size_t)e * 2 * 8 * 64 * 64, b_a + e * 1024, w_x + (size_t)e * 2 * 8 * 64 * 64, b_x + e * 1024, lru_lam + e * 1024, Abuf, Ubuf);
                k_scan<<<2, 256, 0, stream>>>(Abuf, Ubuf, proj, mixed);
                k_gemm<<<dim3(1024 / 64, S / 64), 256, 0, stream>>>(mixed, even_w_out + (size_t)e * 1024 * 1024, ybuf, S, 1024, 1024);
            } else {
                const int o = l / 2;
                k_gemm<<<dim3(4096 / 64, S / 64), 256, 0, stream>>>(hbuf, odd_w_in + (size_t)o * 1024 * 4096, proj, S, 4096, 1024);
                k_na<<<S * 16 / 4, 256, 0, stream>>>(proj, rpb + (size_t)o * 16 * 15 * 31, mixed);
                k_gemm<<<dim3(1024 / 64, S / 64), 256, 0, stream>>>(mixed, odd_w_out + (size_t)o * 1024 * 1024, ybuf, S, 1024, 1024);
            }
            k_resid<<<S * D / 256, 256, 0, stream>>>(xb, ybuf, modlb + 2048);
        }
    }
    k_final<<<NB * S, 256, 0, stream>>>(x, final_g);
}
```

```cpp
#define MK_PER_PHASE 1
#include <hip/hip_runtime.h>
#include <hip/hip_cooperative_groups.h>
#include <cstdio>
#include <cstdint>
#include <cmath>

#define LAS __attribute__((address_space(3)))
typedef unsigned short bf16_t;
typedef short bf16x8 __attribute__((ext_vector_type(8)));
typedef float f32x4 __attribute__((ext_vector_type(4)));
typedef float f32x16 __attribute__((ext_vector_type(16)));
typedef unsigned u32x4 __attribute__((ext_vector_type(4)));
typedef unsigned u32x2 __attribute__((ext_vector_type(2)));
typedef float f32x2_t __attribute__((ext_vector_type(2)));
typedef __bf16 bf16x2_t __attribute__((ext_vector_type(2)));

__device__ __forceinline__ unsigned pk2(float lo, float hi) { f32x2_t v = {lo, hi}; bf16x2_t b = __builtin_convertvector(v, bf16x2_t); return __builtin_bit_cast(unsigned, b); }
__device__ __forceinline__ float bflo(unsigned w) { return __uint_as_float(w << 16); }
__device__ __forceinline__ float bfhi(unsigned w) { return __uint_as_float(w & 0xffff0000u); }
__device__ __forceinline__ float bf2f(bf16_t h) { return __uint_as_float((unsigned)h << 16); }
__device__ __forceinline__ float fsilu(float v) { return v / (1.f + __expf(-v)); }
__device__ __forceinline__ float fsigm(float v) { return 1.f / (1.f + __expf(-v)); }
__device__ __forceinline__ float ex2(float v) { return __builtin_amdgcn_exp2f(v); }
__device__ __forceinline__ float wave_sum(float v) {
#pragma unroll
    for (int o = 1; o < 64; o <<= 1) v += __shfl_xor(v, o);
    return v;
}
__device__ __forceinline__ int t5_bucket(int rel) {
    const int n = rel < 0 ? -rel : rel; const int ret = rel > 0 ? 16 : 0;
    int v; if (n < 8) v = n; else { v = 33 - __clz(n * n); if (v > 15) v = 15; }
    return ret + v;
}
#define LDS_WAIT() asm volatile("s_waitcnt lgkmcnt(0)" ::: "memory")
constexpr float LOG2E = 1.4426950408889634f;
constexpr float QSCALE = 0.125f * 1.4426950408889634f;

constexpr int DM = 1024, SEQ = 2048, NBATCH = 16, MTOK = NBATCH * SEQ;
constexpr size_t MiB = 1u << 20;
constexpr size_t WS_CTL = 0, WS_MOD = 1 * MiB, WS_SW = 2 * MiB, WS_SSQ = 3 * MiB, WS_SCAL = 5 * MiB, WS_WG = 5 * MiB + 65536;
constexpr size_t WS_WTE = 6 * MiB, WS_WTO = 18 * MiB, WS_WTOUT = 34 * MiB;
constexpr size_t WS_XG = 48 * MiB, WS_MIXED = 112 * MiB, WS_PROJ = 176 * MiB, WS_VT = 368 * MiB, WS_END = 432 * MiB;
constexpr int LDS_BYTES = 163840;
constexpr int LDS_SPARE = 131072;

struct KP {
    const float *x, *c, *ada_w, *ada_b, *norm_g, *final_g, *t5, *even_w_in, *even_w_out, *da_lam, *da_subg, *conv_w, *conv_b, *w_a, *b_a, *w_x, *b_x, *lru_lam, *odd_w_in, *odd_w_out, *rpb;
    float* out; unsigned char* ws; int ph_lo, ph_hi;
};
typedef const __attribute__((address_space(4))) KP* KPC;
struct Frame { LAS unsigned char* lds; int tid, lane, wave, vcu, G, bx; };

namespace pg8 {
constexpr int BM = 256, BK = 64, HALF = 128, HTB = HALF * BK * 2, STAGE_BYTES = 8 * HTB, NXCD = 8, WGM = 8;
__host__ __device__ __forceinline__ int lds_byte(int r, int c) { const int st = (r >> 4) * 2 + (c >> 5), rr = r & 15, cc = c & 31, ob = rr * 64 + cc * 2; return st * 1024 + (ob ^ (((ob >> 9) & 1) << 5)); }
__host__ __device__ __forceinline__ void stage_rc(int b, int& R, int& C) { const int st = b / 1024, sb = b % 1024, swz = sb ^ (((sb >> 9) & 1) << 5); R = (st >> 1) * 16 + swz / 64; C = (st & 1) * 32 + (swz % 64) / 2; }
__host__ __device__ __forceinline__ int perm32(int rho) { const int n = rho >> 4, i = rho & 15; return 8 * (i >> 2) + 4 * n + (i & 3); }
struct Unit { int pm, pn; };
struct Gemm { const bf16_t* A; const bf16_t* Bt; int M, N, K; };
struct StaticOrder {
    int nM, nN, nwg, G, c;
    __host__ __device__ void init(int M, int N, int G_, int c_) { nM = M / BM; nN = N / BM; nwg = nM * nN; G = G_; c = c_; }
    __host__ __device__ bool next(int i, Unit& u) const {
        const long L = (long)i * G + c; if (L >= nwg) return false;
        int wgid = (int)L; { const int q = nwg / NXCD, r = nwg % NXCD, xcd = wgid % NXCD, off = wgid / NXCD; wgid = (xcd < r ? xcd * (q + 1) : r * (q + 1) + (xcd - r) * q) + off; }
        const int nig = WGM * nN, gid = wgid / nig, fm = gid * WGM, gsz = (nM - fm) < WGM ? (nM - fm) : WGM;
        u.pm = fm + ((wgid % nig) % gsz); u.pn = (wgid % nig) / gsz; return true;
    }
};

template <class Epi, class Sched, bool ALIGN_EPI = false, bool SP2 = false>
__device__ __forceinline__ void gemm_phase(LAS unsigned char* lds, const Gemm g, const Sched& S, const Epi& E, const int tid) {
    const int wid = __builtin_amdgcn_readfirstlane(tid >> 6), lane = tid & 63, wr = wid >> 2, wc = wid & 3, fr = lane & 15, fq = lane >> 4;
    const int K = g.K, nt = K / BK;
    unsigned voffA[2], voffB[2];
#pragma unroll
    for (int i = 0; i < 2; ++i) { int R, C; stage_rc(tid * 16 + i * 8192, R, C); const int Rb = Epi::PERM ? ((R & ~31) + perm32(R & 31)) : R;
        voffA[i] = (unsigned)(R * K + C) * 2u; voffB[i] = (unsigned)(Rb * K + C) * 2u; }
    const size_t kstep = (size_t)(BK * 2);
    const size_t hstep = (size_t)HALF * K * 2;
    const size_t tstep = 2 * hstep;
    const unsigned ldsw = (unsigned)wid * 1024u;
    const int aoff = lds_byte(wr * 64 + fr, fq * 8), boff = lds_byte(wc * 32 + fr, fq * 8);
#define PG8_SA(b, h) (((b) * 2 + (h)) * HTB)
#define PG8_SB(b, h) ((4 + (b) * 2 + (h)) * HTB)
#define PG8_STAGE(bufoff, gbase, voff) do { _Pragma("unroll") for (int _i = 0; _i < 2; ++_i) \
        __builtin_amdgcn_global_load_lds((const unsigned*)((const char*)(gbase) + (voff)[_i]), (LAS unsigned*)(lds + (bufoff) + ldsw + _i * 8192), 16, 0, 0); } while (0)
#define PG8_LDA(dst, b, h) do { _Pragma("unroll") for (int m = 0; m < 4; ++m) _Pragma("unroll") for (int k = 0; k < 2; ++k) dst[m][k] = *(const LAS bf16x8*)(lds + PG8_SA(b, h) + aoff + m * 2048 + k * 1024); } while (0)
#define PG8_LDB(dst, b, h) do { _Pragma("unroll") for (int n = 0; n < 2; ++n) _Pragma("unroll") for (int k = 0; k < 2; ++k) dst[n][k] = *(const LAS bf16x8*)(lds + PG8_SB(b, h) + boff + n * 2048 + k * 1024); } while (0)
#define PG8_MMA(ai, bj, At, Bt) do { __builtin_amdgcn_s_setprio(1); _Pragma("unroll") for (int m = 0; m < 4; ++m) _Pragma("unroll") for (int n = 0; n < 2; ++n) _Pragma("unroll") for (int k = 0; k < 2; ++k) \
        acc[ai][bj][m][n] = __builtin_amdgcn_mfma_f32_16x16x32_bf16(Bt[n][k], At[m][k], acc[ai][bj][m][n], 0, 0, 0); __builtin_amdgcn_s_setprio(0); } while (0)
#define PG8_WAIT_V(n) asm volatile("s_waitcnt vmcnt(" #n ")" ::: "memory")
#define PG8_WAIT_L(n) asm volatile("s_waitcnt lgkmcnt(" #n ")" ::: "memory")
#define PG8_BAR __builtin_amdgcn_s_barrier()
#define PG8_SCHED __builtin_amdgcn_sched_barrier(0)
    Unit cur, nxt; int ui = 0;
    if (!S.next(0, cur)) return;
    f32x4 acc[2][2][4][2];
#pragma unroll
    for (int a = 0; a < 2; ++a)
#pragma unroll
        for (int b = 0; b < 2; ++b)
#pragma unroll
            for (int m = 0; m < 4; ++m)
#pragma unroll
                for (int n = 0; n < 2; ++n) acc[a][b][m][n] = (f32x4){0.f, 0.f, 0.f, 0.f};
    bf16x8 At[4][2], B0[2][2], B1[2][2];
    const char* cA = (const char*)g.A + (size_t)cur.pm * tstep; const char* cB = (const char*)g.Bt + (size_t)cur.pn * tstep;
    if constexpr (SP2) {
        PG8_STAGE(PG8_SB(0, 0), cB, voffB); PG8_STAGE(PG8_SB(0, 1), cB + hstep, voffB); PG8_STAGE(PG8_SA(0, 0), cA, voffA); PG8_STAGE(PG8_SA(0, 1), cA + hstep, voffA);
        if (wr == 1) PG8_BAR;
        PG8_WAIT_V(2); PG8_BAR;
        PG8_STAGE(PG8_SB(1, 0), cB + kstep, voffB); PG8_STAGE(PG8_SA(1, 0), cA + kstep, voffA); PG8_STAGE(PG8_SB(1, 1), cB + hstep + kstep, voffB);
        PG8_WAIT_V(6); PG8_BAR;
    } else {
        PG8_STAGE(PG8_SB(0, 0), cB, voffB); PG8_STAGE(PG8_SA(0, 0), cA, voffA); PG8_STAGE(PG8_SB(0, 1), cB + hstep, voffB); PG8_STAGE(PG8_SA(0, 1), cA + hstep, voffA);
        if (wr == 1) PG8_BAR;
        PG8_WAIT_V(4); PG8_BAR;
        PG8_STAGE(PG8_SB(1, 0), cB + kstep, voffB); PG8_STAGE(PG8_SA(1, 0), cA + kstep, voffA); PG8_STAGE(PG8_SB(1, 1), cB + hstep + kstep, voffB);
        PG8_WAIT_V(6); PG8_BAR;
    }
    for (;;) {
        const bool has_next = S.next(ui + 1, nxt);
        const char* nA = has_next ? (const char*)g.A + (size_t)nxt.pm * tstep : cA; const char* nB = has_next ? (const char*)g.Bt + (size_t)nxt.pn * tstep : cB;
        for (int t = 0; t < nt; t += 2) {
            const bool last = (t == nt - 2);
            const char* a1 = cA + (size_t)(t + 1) * kstep;
            const char* a2 = last ? nA : cA + (size_t)(t + 2) * kstep; const char* b2 = last ? nB : cB + (size_t)(t + 2) * kstep;
            const char* a3 = a2 + kstep; const char* b3 = b2 + kstep;
            if constexpr (SP2) {
            PG8_LDB(B0, 0, 0); PG8_LDB(B1, 0, 1); PG8_SCHED; PG8_LDA(At, 0, 0); PG8_STAGE(PG8_SA(1, 1), a1 + hstep, voffA);
            PG8_WAIT_V(8); PG8_WAIT_L(0); PG8_BAR; PG8_MMA(0, 0, At, B0); PG8_MMA(0, 1, At, B1); PG8_BAR; PG8_SCHED;
            PG8_LDA(At, 0, 1); PG8_STAGE(PG8_SB(0, 0), b2, voffB); PG8_STAGE(PG8_SB(0, 1), b2 + hstep, voffB); PG8_STAGE(PG8_SA(0, 0), a2, voffA);
            PG8_WAIT_V(8); PG8_WAIT_L(0); PG8_BAR; PG8_MMA(1, 0, At, B0); PG8_MMA(1, 1, At, B1); PG8_BAR; PG8_SCHED;
            PG8_LDB(B0, 1, 0); PG8_LDB(B1, 1, 1); PG8_SCHED; PG8_LDA(At, 1, 0); PG8_STAGE(PG8_SA(0, 1), a2 + hstep, voffA);
            PG8_WAIT_V(8); PG8_WAIT_L(0); PG8_BAR; PG8_MMA(0, 0, At, B0); PG8_MMA(0, 1, At, B1); PG8_BAR; PG8_SCHED;
            PG8_LDA(At, 1, 1); PG8_STAGE(PG8_SB(1, 0), b3, voffB); PG8_STAGE(PG8_SB(1, 1), b3 + hstep, voffB); PG8_STAGE(PG8_SA(1, 0), a3, voffA);
            PG8_WAIT_V(8); PG8_WAIT_L(0); PG8_BAR; PG8_MMA(1, 0, At, B0); PG8_MMA(1, 1, At, B1); PG8_BAR; PG8_SCHED;
            } else {
            PG8_LDB(B0, 0, 0); PG8_SCHED; PG8_LDA(At, 0, 0); PG8_STAGE(PG8_SA(1, 1), a1 + hstep, voffA);
            PG8_WAIT_L(8); PG8_BAR; PG8_WAIT_L(0); PG8_MMA(0, 0, At, B0); PG8_BAR; PG8_SCHED;
            PG8_LDB(B1, 0, 1); PG8_STAGE(PG8_SB(0, 0), b2, voffB);
            PG8_BAR; PG8_WAIT_L(0); PG8_MMA(0, 1, At, B1); PG8_BAR;
            PG8_LDA(At, 0, 1); PG8_STAGE(PG8_SA(0, 0), a2, voffA);
            PG8_BAR; PG8_WAIT_L(0); PG8_MMA(1, 0, At, B0); PG8_BAR; PG8_SCHED;
            PG8_STAGE(PG8_SB(0, 1), b2 + hstep, voffB);
            PG8_WAIT_V(6); PG8_BAR; PG8_MMA(1, 1, At, B1); PG8_BAR;
            PG8_LDB(B0, 1, 0); PG8_SCHED; PG8_LDA(At, 1, 0); PG8_STAGE(PG8_SA(0, 1), a2 + hstep, voffA);
            PG8_WAIT_L(8); PG8_BAR; PG8_WAIT_L(0); PG8_MMA(0, 0, At, B0); PG8_BAR; PG8_SCHED;
            PG8_LDB(B1, 1, 1); PG8_STAGE(PG8_SB(1, 0), b3, voffB);
            PG8_BAR; PG8_WAIT_L(0); PG8_MMA(0, 1, At, B1); PG8_BAR;
            PG8_LDA(At, 1, 1); PG8_STAGE(PG8_SA(1, 0), a3, voffA);
            PG8_BAR; PG8_WAIT_L(0); PG8_MMA(1, 0, At, B0); PG8_BAR; PG8_SCHED;
            PG8_STAGE(PG8_SB(1, 1), b3 + hstep, voffB);
            PG8_WAIT_V(6); PG8_BAR; PG8_MMA(1, 1, At, B1); PG8_BAR;
            }
        }
        if constexpr (ALIGN_EPI) { if (wr == 0) PG8_BAR; }
        E(acc, cur, wr, wc, fr, fq);
        if (!has_next) break;
#pragma unroll
        for (int a = 0; a < 2; ++a)
#pragma unroll
            for (int b = 0; b < 2; ++b)
#pragma unroll
                for (int m = 0; m < 4; ++m)
#pragma unroll
                    for (int n = 0; n < 2; ++n) acc[a][b][m][n] = (f32x4){0.f, 0.f, 0.f, 0.f};
        cur = nxt; cA = nA; cB = nB; ++ui;
        if constexpr (ALIGN_EPI) { if (wr == 1) PG8_BAR; }
    }
    PG8_WAIT_V(0);
    if constexpr (!ALIGN_EPI) { if (wr == 0) PG8_BAR; }
    PG8_BAR;
#undef PG8_SA
#undef PG8_SB
#undef PG8_STAGE
#undef PG8_LDA
#undef PG8_LDB
#undef PG8_MMA
#undef PG8_WAIT_V
#undef PG8_WAIT_L
#undef PG8_BAR
#undef PG8_SCHED
}
}
__device__ __forceinline__ float ssq_rinv(const float* ssq, int row) {
    const f32x4* sp = (const f32x4*)(ssq + (size_t)row * 16);
    const f32x4 a = sp[0], b = sp[1], c = sp[2], d = sp[3];
    const float s = ((a[0] + a[1]) + (a[2] + a[3])) + ((b[0] + b[1]) + (b[2] + b[3])) + ((c[0] + c[1]) + (c[2] + c[3])) + ((d[0] + d[1]) + (d[2] + d[3]));
    return rsqrtf(s * (1.f / 1024.f) + 1e-6f);
}
struct EpiProj {
    static constexpr bool PERM = true;
    bf16_t* O; int ldc; const float* ssq; const float* sW; int qcols;
    __device__ __forceinline__ void operator()(const f32x4 (&acc)[2][2][4][2], const pg8::Unit& u, int wr, int wc, int fr, int fq) const {
        const int row0 = u.pm * 256 + wr * 64 + fr, colb = u.pn * 256 + wc * 32 + 8 * fq, b = (u.pm * 256) >> 11;
        const float* sWb = sW + (size_t)b * 4096;
        f32x4 bv[2][2];
#pragma unroll
        for (int bj = 0; bj < 2; ++bj)
#pragma unroll
            for (int n = 0; n < 2; ++n) bv[bj][n] = *(const f32x4*)(sWb + colb + bj * 128 + 4 * n);
#pragma unroll
        for (int ai = 0; ai < 2; ++ai)
#pragma unroll
            for (int m = 0; m < 4; ++m) {
                const int row = row0 + ai * 128 + m * 16; const float rt = ssq_rinv(ssq, row);
                bf16_t* rowp = O + (size_t)row * ldc + colb;
#pragma unroll
                for (int bj = 0; bj < 2; ++bj) {
                    const float sc = (u.pn * 256 + bj * 128 < qcols) ? QSCALE : 1.f;
                    const f32x4 v0 = (acc[ai][bj][m][0] * rt + bv[bj][0]) * sc, v1 = (acc[ai][bj][m][1] * rt + bv[bj][1]) * sc;
                    u32x4 w; w.x = pk2(v0[0], v0[1]); w.y = pk2(v0[2], v0[3]); w.z = pk2(v1[0], v1[1]); w.w = pk2(v1[2], v1[3]);
                    *(u32x4*)(rowp + bj * 128) = w;
                }
            }
    }
};
struct EpiProjT {
    static constexpr bool PERM = true;
    bf16_t* VT; int NV; const float* ssq; const float* sW;   int swap23;
    __device__ __forceinline__ void operator()(const f32x4 (&acc)[2][2][4][2], const pg8::Unit& u, int wr, int wc, int fr, int fq) const {
        const int tok0 = u.pn * 256, b = tok0 >> 11, t0 = tok0 & 2047;
        const int vrow0 = u.pm * 256 + wr * 64 + fr;
        const float* sWb = sW + (size_t)b * 4096;
        bf16_t* base = VT + (size_t)b * NV * 2048 + t0;
#pragma unroll
        for (int bj = 0; bj < 2; ++bj) {
            float rt[2][4];
#pragma unroll
            for (int n = 0; n < 2; ++n)
#pragma unroll
                for (int i = 0; i < 4; ++i) rt[n][i] = ssq_rinv(ssq, tok0 + bj * 128 + wc * 32 + 8 * fq + 4 * n + i);
            const int cl = bj * 128 + wc * 32;
#pragma unroll
            for (int ai = 0; ai < 2; ++ai)
#pragma unroll
                for (int m = 0; m < 4; ++m) {
                    const int vrow = vrow0 + ai * 128 + m * 16; const float bias = sWb[vrow];
                    bf16_t* rowp = base + (size_t)vrow * 2048 + cl;
                    const f32x4 a0 = acc[ai][bj][m][0], a1 = acc[ai][bj][m][1];
                    u32x2 w0, w1;
                    w0.x = pk2(a0[0] * rt[0][0] + bias, a0[1] * rt[0][1] + bias); w0.y = pk2(a0[2] * rt[0][2] + bias, a0[3] * rt[0][3] + bias);
                    w1.x = pk2(a1[0] * rt[1][0] + bias, a1[1] * rt[1][1] + bias); w1.y = pk2(a1[2] * rt[1][2] + bias, a1[3] * rt[1][3] + bias);
                    if (swap23) {
                        *(u32x2*)(rowp + 16 * (fq >> 1) + 4 * (fq & 1)) = w0;
                        *(u32x2*)(rowp + 16 * (fq >> 1) + 8 + 4 * (fq & 1)) = w1;
                    } else {
                        u32x4 w; w.x = w0.x; w.y = w0.y; w.z = w1.x; w.w = w1.y; *(u32x4*)(rowp + 8 * fq) = w;
                    }
                }
        }
    }
};
struct EpiOut {
    static constexpr bool PERM = true;
    const float* xin; float* xout; bf16_t* xg; float* ssq; const float* gate;   const float* gnext; const float* scnext;   int has_next;
    __device__ __forceinline__ void operator()(const f32x4 (&acc)[2][2][4][2], const pg8::Unit& u, int wr, int wc, int fr, int fq) const {
        const int row0 = u.pm * 256 + wr * 64 + fr, colb = u.pn * 256 + wc * 32 + 8 * fq, b = (u.pm * 256) >> 11;
        f32x4 gv[2][2], Gn[2][2];
#pragma unroll
        for (int bj = 0; bj < 2; ++bj)
#pragma unroll
            for (int n = 0; n < 2; ++n) {
                const int col = colb + bj * 128 + 4 * n;
                gv[bj][n] = *(const f32x4*)(gate + (size_t)b * 3072 + col);
                if (has_next) { const f32x4 g = *(const f32x4*)(gnext + col), s = *(const f32x4*)(scnext + (size_t)b * 3072 + col); Gn[bj][n] = g * (s + 1.f); }
                else Gn[bj][n] = (f32x4){0.f, 0.f, 0.f, 0.f};
            }
#pragma unroll
        for (int ai = 0; ai < 2; ++ai)
#pragma unroll
            for (int m = 0; m < 4; ++m) {
                const int row = row0 + ai * 128 + m * 16; float ps = 0.f;
#pragma unroll
                for (int bj = 0; bj < 2; ++bj) {
                    const size_t off = (size_t)row * 1024 + colb + bj * 128;
                    const f32x4 x0 = *(const f32x4*)(xin + off), x1 = *(const f32x4*)(xin + off + 4);
                    const f32x4 y0 = x0 + gv[bj][0] * acc[ai][bj][m][0], y1 = x1 + gv[bj][1] * acc[ai][bj][m][1];
                    *(f32x4*)(xout + off) = y0; *(f32x4*)(xout + off + 4) = y1;
                    ps += (y0[0] * y0[0] + y0[1] * y0[1]) + (y0[2] * y0[2] + y0[3] * y0[3]) + (y1[0] * y1[0] + y1[1] * y1[1]) + (y1[2] * y1[2] + y1[3] * y1[3]);
                    if (has_next) { const f32x4 z0 = y0 * Gn[bj][0], z1 = y1 * Gn[bj][1];
                        u32x4 w; w.x = pk2(z0[0], z0[1]); w.y = pk2(z0[2], z0[3]); w.z = pk2(z1[0], z1[1]); w.w = pk2(z1[2], z1[3]); *(u32x4*)(xg + off) = w; }
                }
                ps += __shfl_xor(ps, 16); ps += __shfl_xor(ps, 32);
                if (fq == 0) ssq[(size_t)row * 16 + u.pn * 4 + wc] = ps;
            }
    }
};

__device__ __forceinline__ int remap_col(int n, int mode) {
    if (mode == 1) return n < 1024 ? n : (n < 1536 ? n + 1536 : n - 512);
    if (mode == 2) return n < 2048 ? n : (n < 3072 ? n + 1024 : n - 1024);
    return n;
}
__device__ __forceinline__ int unmap_col(int c, int odd) {
    if (!odd) return c < 1024 ? c : (c < 2560 ? c + 512 : c - 1536);
    return c < 2048 ? c : (c < 3072 ? c + 1024 : c - 1024);
}
__device__ __forceinline__ void p0_transpose_item(const float* W, int K, int N, bf16_t* WT, int item, LAS float* scr, int lane, int mode) {
    const int nblk = N / 32, kb = item / nblk, nb = item % nblk, k0 = 64 * kb, n0 = 32 * nb;
#pragma unroll 8
    for (int i = 0; i < 32; ++i) { const int kk = 2 * i + (lane >> 5); scr[kk * 33 + (lane & 31)] = W[(size_t)(k0 + kk) * N + n0 + (lane & 31)]; }
    LDS_WAIT(); asm volatile("" ::: "memory");
    const int c = lane & 7;
#pragma unroll
    for (int j = 0; j < 4; ++j) { const int n = (lane >> 3) + 8 * j; const LAS float* s = scr + (8 * c) * 33 + n;
        u32x4 o; o.x = pk2(s[0 * 33], s[1 * 33]); o.y = pk2(s[2 * 33], s[3 * 33]); o.z = pk2(s[4 * 33], s[5 * 33]); o.w = pk2(s[6 * 33], s[7 * 33]);
        *(u32x4*)(WT + (size_t)remap_col(n0 + n, mode) * K + k0 + 8 * c) = o; }
    LDS_WAIT(); asm volatile("" ::: "memory");
}
__device__ __forceinline__ void gemv16_item(const LAS float* vec, const float* W, int ldw, int col0, float* out, int out_ld, int ocol0, const float* bias, int lane) {
    const int n = lane & 15, kq = lane >> 4;
    float acc[16];
#pragma unroll
    for (int b = 0; b < 16; ++b) acc[b] = 0.f;
    const float* wp = W + (size_t)(kq * 256) * ldw + col0 + n; const LAS float* vp = vec + kq * 256;
#pragma unroll 4
    for (int i = 0; i < 256; ++i) {
        const float w = wp[(size_t)i * ldw];
#pragma unroll
        for (int b = 0; b < 16; ++b) acc[b] += vp[b * 1024 + i] * w;
    }
#pragma unroll
    for (int b = 0; b < 16; ++b) { acc[b] += __shfl_xor(acc[b], 16); acc[b] += __shfl_xor(acc[b], 32); }
    if (kq == 0) { const float bs = bias ? bias[col0 + n] : 0.f;
#pragma unroll
        for (int b = 0; b < 16; ++b) out[(size_t)b * out_ld + ocol0 + n] = acc[b] + bs; }
}

__device__ __forceinline__ void phase_p0a(KPC p, const Frame& F) {
    unsigned char* ws = p->ws;
    bf16_t* WtE = (bf16_t*)(ws + WS_WTE); bf16_t* WtO = (bf16_t*)(ws + WS_WTO); bf16_t* WtOut = (bf16_t*)(ws + WS_WTOUT); bf16_t* Wg = (bf16_t*)(ws + WS_WG);
    float* mod = (float*)(ws + WS_MOD); float* scal = (float*)(ws + WS_SCAL);
    LAS float* scr = (LAS float*)(F.lds + F.wave * 8448);
    LAS float* vec = (LAS float*)(F.lds + 73728);
    const int gw = F.vcu * 8 + F.wave, NGW = F.G * 8;
    for (int i = F.tid; i < 16384; i += 512) vec[i] = fsilu(p->c[i]);
    for (int it = gw; it < 9216; it += NGW) {
        int r = it;
        if (r < 3072) { const int e = r / 1536; p0_transpose_item(p->even_w_in + (size_t)e * 1024 * 3072, 1024, 3072, WtE + (size_t)e * 3072 * 1024, r % 1536, scr, F.lane, 1); continue; }
        r -= 3072;
        if (r < 4096) { const int o = r / 2048; p0_transpose_item(p->odd_w_in + (size_t)o * 1024 * 4096, 1024, 4096, WtO + (size_t)o * 4096 * 1024, r % 2048, scr, F.lane, 2); continue; }
        r -= 4096;
        { const int j = r / 512; const int l = (j < 2) ? 2 * j : 2 * (j - 2) + 1; const float* src = (j < 2) ? p->even_w_out + (size_t)j * 1024 * 1024 : p->odd_w_out + (size_t)(j - 2) * 1024 * 1024;
          p0_transpose_item(src, 1024, 1024, WtOut + (size_t)l * 1024 * 1024, r % 512, scr, F.lane, 0); }
    }
    for (int idx = gw * 64 + F.lane; idx < 262144; idx += NGW * 64) {
        const int k = idx & 63, j = (idx >> 6) & 255, n = (idx >> 14) & 7, e = idx >> 17; const int set = j >> 6, d = j & 63, r = set >> 1;
        const float* src = (set & 1) ? p->w_x : p->w_a;
        const float v = src[((((size_t)e * 2 + r) * 8 + n) * 64 + k) * 64 + d];
        Wg[idx] = (bf16_t)(pk2(v, 0.f) & 0xffffu);
    }
    if (F.bx == 0 && F.tid < 2) {
        const int e = F.tid; const float* lp = p->da_lam + e * 256; float s01 = 0.f, s23 = 0.f;
        for (int i = 0; i < 64; ++i) { s01 += lp[i] * lp[64 + i]; s23 += lp[128 + i] * lp[192 + i]; }
        const float lam_init = (e == 0) ? 0.2f : 0.47071302f;
        scal[e * 4 + 0] = expf(s01) - expf(s23) + lam_init; scal[e * 4 + 1] = lam_init;
    }
    __syncthreads();
    for (int it = F.wave * F.G + F.vcu; it < 768; it += NGW) {
        const int l = it / 192, ch = it % 192;
        gemv16_item(vec, p->ada_w + (size_t)l * 1024 * 3072, 3072, ch * 16, mod + (size_t)l * 16 * 3072, 3072, ch * 16, p->ada_b + l * 3072, F.lane);
    }
}
__device__ __forceinline__ void phase_p0b(KPC p, const Frame& F) {
    unsigned char* ws = p->ws;
    const float* mod = (const float*)(ws + WS_MOD); float* sW = (float*)(ws + WS_SW); float* ssq = (float*)(ws + WS_SSQ); bf16_t* xg = (bf16_t*)(ws + WS_XG);
    LAS float* vec = (LAS float*)(F.lds);
    const int l = F.vcu & 3;
    for (int i = F.tid; i < 16384; i += 512) vec[i] = mod[((size_t)l * 16 + (i >> 10)) * 3072 + (i & 1023)];
    __syncthreads();
    {
        const int odd = l & 1, N = odd ? 4096 : 3072;
        const float* W = odd ? p->odd_w_in + (size_t)(l >> 1) * 1024 * 4096 : p->even_w_in + (size_t)(l >> 1) * 1024 * 3072;
        for (int it = (F.vcu >> 2) * 8 + F.wave; it < N / 16; it += (F.G >> 2) * 8)
            gemv16_item(vec, W, N, unmap_col(it * 16, odd), sW + (size_t)l * 16 * 4096, 4096, it * 16, nullptr, F.lane);
    }
    const int gw = F.vcu * 8 + F.wave, NGW = F.G * 8;
    for (int row = gw; row < MTOK; row += NGW) {
        const int b = row >> 11;
        const f32x4* xr = (const f32x4*)(p->x + (size_t)row * 1024) + F.lane;
        f32x4 v[4]; float s = 0.f;
#pragma unroll
        for (int j = 0; j < 4; ++j) { v[j] = xr[64 * j]; s += (v[j][0] * v[j][0] + v[j][1] * v[j][1]) + (v[j][2] * v[j][2] + v[j][3] * v[j][3]); }
        s = wave_sum(s);
        unsigned long long* o8 = (unsigned long long*)(xg + (size_t)row * 1024) + F.lane;
#pragma unroll
        for (int j = 0; j < 4; ++j) {
            const int k = 4 * F.lane + 256 * j;
            const f32x4 g = *(const f32x4*)(p->norm_g + k), sc = *(const f32x4*)(mod + (size_t)b * 3072 + 1024 + k);
            const f32x4 z = v[j] * g * (sc + 1.f);
            o8[64 * j] = (unsigned long long)pk2(z[0], z[1]) | ((unsigned long long)pk2(z[2], z[3]) << 32);
        }
        if (F.lane < 16) ssq[(size_t)row * 16 + F.lane] = (F.lane == 0) ? s : 0.f;
    }
}
__device__ __forceinline__ void phase_final(KPC p, const Frame& F) {
    const float* ssq = (const float*)(p->ws + WS_SSQ);
    const int gw = F.vcu * 8 + F.wave, NGW = F.G * 8;
    for (int row = gw; row < MTOK; row += NGW) {
        const float rt = ssq_rinv(ssq, row);
        f32x4* xr = (f32x4*)(p->out + (size_t)row * 1024) + F.lane;
#pragma unroll
        for (int j = 0; j < 4; ++j) { const f32x4 g = *(const f32x4*)(p->final_g + 4 * F.lane + 256 * j); xr[64 * j] = xr[64 * j] * rt * g; }
    }
}
#define MFMA32(a, b, c) __builtin_amdgcn_mfma_f32_32x32x16_bf16((a), (b), (c), 0, 0, 0)
#define MFMA16(a, b, c) __builtin_amdgcn_mfma_f32_16x16x32_bf16((a), (b), (c), 0, 0, 0)
__device__ __forceinline__ void attn_unit(KPC p, const Frame& F, int e_layer, int b, int h, int qb, float lam, float lam_init) {
    const int tid = F.tid, lane = F.lane, r = lane & 31, hh = lane >> 5, m = F.wave & 1, sub = F.wave >> 1;
    const bf16_t* P = (const bf16_t*)(p->ws + WS_PROJ); const bf16_t* VT = (const bf16_t*)(p->ws + WS_VT); bf16_t* mixed = (bf16_t*)(p->ws + WS_MIXED);
    LAS unsigned char* lds = F.lds;
    LAS float* lut = (LAS float*)(lds + 65536);
    const size_t tokbase = (size_t)b * 2048; const int q0w = qb * 128 + sub * 32;
    if (tid < 511) lut[tid] = p->t5[h * 32 + t5_bucket(tid - 255)] * LOG2E;
    const float cL = p->t5[h * 32 + 15] * LOG2E, cR = p->t5[h * 32 + 31] * LOG2E;
    bf16x8 qf[4];
    { const bf16_t* qp = P + (tokbase + q0w + r) * 2560 + h * 128 + m * 64 + hh * 8;
#pragma unroll
      for (int s = 0; s < 4; ++s) qf[s] = *(const bf16x8*)(qp + 16 * s); }
    const int skey = (tid >> 3) & 63, sch = tid & 7;
    const bf16_t* ksrc0 = P + (tokbase + skey) * 2560 + 512 + h * 128 + sch * 8;
    const unsigned kdst0 = (unsigned)(skey * 128 + ((sch ^ ((skey >> 1) & 7)) << 4));
    const int ve0 = tid >> 3;
    const bf16_t* vsrc0 = VT + ((size_t)(b * 512 + h * 128 + ve0)) * 2048 + sch * 8;
    const unsigned vdst0 = (unsigned)(16384 + ve0 * 128 + ((sch ^ ((ve0 >> 1) & 7)) << 4));
    u32x4 kr0, kr1, vr0, vr1;
    kr0 = *(const u32x4*)(ksrc0); kr1 = *(const u32x4*)(ksrc0 + 64); vr0 = *(const u32x4*)(vsrc0); vr1 = *(const u32x4*)(vsrc0 + (size_t)64 * 2048);
    *(LAS u32x4*)(lds + kdst0) = kr0; *(LAS u32x4*)(lds + 8192 + kdst0) = kr1; *(LAS u32x4*)(lds + vdst0) = vr0; *(LAS u32x4*)(lds + 8192 + vdst0) = vr1;
    __syncthreads();
    f32x16 O[4];
#pragma unroll
    for (int et = 0; et < 4; ++et)
#pragma unroll
        for (int i = 0; i < 16; ++i) O[et][i] = 0.f;
    float m_run = -INFINITY, l_run = 0.f;
    const unsigned swz = (unsigned)((r >> 1) & 7);
    for (int j = 0; j < 32; ++j) {
        const int st = (j & 1) * 32768;
        if (j + 1 < 32) {
            const bf16_t* ks = ksrc0 + (size_t)(j + 1) * 64 * 2560; const bf16_t* vs = vsrc0 + (j + 1) * 64;
            kr0 = *(const u32x4*)(ks); kr1 = *(const u32x4*)(ks + 64); vr0 = *(const u32x4*)(vs); vr1 = *(const u32x4*)(vs + (size_t)64 * 2048);
        }
        const LAS unsigned char* kb = lds + st + m * 8192; const LAS unsigned char* vb = lds + st + 16384;
        f32x16 S0, S1;
        { const int rel_max = 64 * j + 63 - q0w, rel_min = 64 * j - (q0w + 31);
          if (rel_max <= -91) {
#pragma unroll
              for (int i = 0; i < 16; ++i) { S0[i] = cL; S1[i] = cL; }
          } else if (rel_min >= 91) {
#pragma unroll
              for (int i = 0; i < 16; ++i) { S0[i] = cR; S1[i] = cR; }
          } else {
              const int ib = 64 * j + 4 * hh - (q0w + r) + 255;
#pragma unroll
              for (int i = 0; i < 16; ++i) { const int idx = ib + (i & 3) + 8 * (i >> 2); S0[i] = lut[idx]; S1[i] = lut[idx + 32]; }
          } }
#pragma unroll
        for (int s = 0; s < 4; ++s) {
            const unsigned co = (((unsigned)(2 * s + hh)) ^ swz) << 4;
            const bf16x8 a0 = *(const LAS bf16x8*)(kb + r * 128 + co);
            const bf16x8 a1 = *(const LAS bf16x8*)(kb + (32 + r) * 128 + co);
            S0 = MFMA32(a0, qf[s], S0); S1 = MFMA32(a1, qf[s], S1);
        }
        float mx = fmaxf(S0[0], S1[0]);
#pragma unroll
        for (int i = 1; i < 16; ++i) mx = fmaxf(mx, fmaxf(S0[i], S1[i]));
        mx = fmaxf(mx, __shfl_xor(mx, 32));
        const float m_new = fmaxf(m_run, mx); const float alpha = ex2(m_run - m_new); m_run = m_new;
        float ls = 0.f;
#pragma unroll
        for (int i = 0; i < 16; ++i) { S0[i] = ex2(S0[i] - m_new); S1[i] = ex2(S1[i] - m_new); ls += S0[i] + S1[i]; }
        l_run = l_run * alpha + ls;
#pragma unroll
        for (int et = 0; et < 4; ++et)
#pragma unroll
            for (int i = 0; i < 16; ++i) O[et][i] *= alpha;
        bf16x8 pf[4];
        { u32x4 w;
          w.x = pk2(S0[0], S0[1]); w.y = pk2(S0[2], S0[3]); w.z = pk2(S0[4], S0[5]); w.w = pk2(S0[6], S0[7]); pf[0] = __builtin_bit_cast(bf16x8, w);
          w.x = pk2(S0[8], S0[9]); w.y = pk2(S0[10], S0[11]); w.z = pk2(S0[12], S0[13]); w.w = pk2(S0[14], S0[15]); pf[1] = __builtin_bit_cast(bf16x8, w);
          w.x = pk2(S1[0], S1[1]); w.y = pk2(S1[2], S1[3]); w.z = pk2(S1[4], S1[5]); w.w = pk2(S1[6], S1[7]); pf[2] = __builtin_bit_cast(bf16x8, w);
          w.x = pk2(S1[8], S1[9]); w.y = pk2(S1[10], S1[11]); w.z = pk2(S1[12], S1[13]); w.w = pk2(S1[14], S1[15]); pf[3] = __builtin_bit_cast(bf16x8, w); }
#pragma unroll
        for (int et = 0; et < 4; ++et)
#pragma unroll
            for (int s = 0; s < 4; ++s) {
                const bf16x8 a = *(const LAS bf16x8*)(vb + (32 * et + r) * 128 + ((((unsigned)(2 * s + hh)) ^ swz) << 4));
                O[et] = MFMA32(a, pf[s], O[et]);
            }
        if (j + 1 < 32) {
            const int sn = ((j + 1) & 1) * 32768;
            *(LAS u32x4*)(lds + sn + kdst0) = kr0; *(LAS u32x4*)(lds + sn + 8192 + kdst0) = kr1; *(LAS u32x4*)(lds + sn + vdst0) = vr0; *(LAS u32x4*)(lds + sn + 8192 + vdst0) = vr1;
        }
        __syncthreads();
    }
    l_run += __shfl_xor(l_run, 32);
    const float inv = 1.f / l_run;
    LAS float* X = (LAS float*)(lds) + sub * 4096;
    if (m == 1) {
#pragma unroll
        for (int et = 0; et < 4; ++et)
#pragma unroll
            for (int i = 0; i < 16; ++i) X[(et * 16 + i) * 64 + lane] = O[et][i] * inv;
    }
    __syncthreads();
    if (m == 0) {
        float ss = 0.f;
#pragma unroll
        for (int et = 0; et < 4; ++et)
#pragma unroll
            for (int i = 0; i < 16; ++i) { const float d = O[et][i] * inv - lam * X[(et * 16 + i) * 64 + lane]; O[et][i] = d; ss += d * d; }
        ss += __shfl_xor(ss, 32);
        const float rinv = rsqrtf(ss * (1.f / 128.f) + 1e-6f) * (1.f - lam_init);
        const size_t tok = tokbase + q0w + r;
#pragma unroll
        for (int et = 0; et < 4; ++et)
#pragma unroll
            for (int g4 = 0; g4 < 4; ++g4) {
                const int e0 = 32 * et + 8 * g4 + 4 * hh;
                const f32x4 sg = *(const f32x4*)(p->da_subg + e_layer * 128 + e0);
                const u32x2 ga = *(const u32x2*)(P + tok * 2560 + 1024 + h * 128 + e0);
                const float v0 = O[et][4 * g4 + 0] * rinv * sg[0] * fsilu(bflo(ga.x)), v1 = O[et][4 * g4 + 1] * rinv * sg[1] * fsilu(bfhi(ga.x));
                const float v2 = O[et][4 * g4 + 2] * rinv * sg[2] * fsilu(bflo(ga.y)), v3 = O[et][4 * g4 + 3] * rinv * sg[3] * fsilu(bfhi(ga.y));
                u32x2 w; w.x = pk2(v0, v1); w.y = pk2(v2, v3);
                *(u32x2*)(mixed + tok * 1024 + h * 128 + e0) = w;
            }
    }
    __syncthreads();
}

__device__ __forceinline__ void lru_unit(KPC p, const Frame& F, int e_layer, int b, int n) {
    const int tid = F.tid, lane = F.lane, wave = F.wave;
    const bf16_t* P = (const bf16_t*)(p->ws + WS_PROJ); bf16_t* mixed = (bf16_t*)(p->ws + WS_MIXED); float* HF = (float*)(p->ws + WS_XG);
    const bf16_t* Wg = (const bf16_t*)(p->ws + WS_WG) + ((size_t)(e_layer * 8 + n)) * 256 * 64;
    LAS unsigned char* lds = F.lds;
    LAS float* XC = (LAS float*)(lds); LAS unsigned char* XA = lds + 17408; LAS f32x2_t* PH = (LAS f32x2_t*)(lds + 25600); LAS float* Cc = (LAS float*)(lds + 33792);
    const size_t tokbase = (size_t)b * 2048;
    const int ca = tid & 63, tq = tid >> 6;
    float cw[4]; { const float* cwp = p->conv_w + (size_t)e_layer * 4 * 512 + n * 64 + ca;
#pragma unroll
        for (int j = 0; j < 4; ++j) cw[j] = cwp[j * 512]; }
    const float cbv = p->conv_b[e_layer * 512 + n * 64 + ca];
    const int mt = wave & 3, jh = wave >> 2, col = lane & 15, kq = lane >> 4;
    const int seg = 4 * mt + kq;
    for (int dir = 0; dir < 2; ++dir) {
        bf16x8 wf[2][2][2];
        float ba[2], bx[2], sp[2];
#pragma unroll
        for (int jj = 0; jj < 2; ++jj) {
            const int ch = 16 * (2 * jh + jj) + col;
#pragma unroll
            for (int gs = 0; gs < 2; ++gs)
#pragma unroll
                for (int ks = 0; ks < 2; ++ks) wf[jj][gs][ks] = *(const bf16x8*)(Wg + (size_t)((2 * dir + gs) * 64 + ch) * 64 + 32 * ks + 8 * kq);
            ba[jj] = p->b_a[(e_layer * 2 + dir) * 512 + n * 64 + ch]; bx[jj] = p->b_x[(e_layer * 2 + dir) * 512 + n * 64 + ch];
            const float y = -p->lru_lam[(e_layer * 2 + dir) * 512 + n * 64 + ch]; sp[jj] = fmaxf(y, 0.f) + log1pf(expf(-fabsf(y)));
        }
        if (tid < 128) Cc[tid] = 0.f;
        for (int cc = 0; cc < 32; ++cc) {
            const int chunk = dir ? 31 - cc : cc; const int t0 = chunk * 64; const int par = cc & 1;
            { float xv[11];
#pragma unroll
              for (int k = 0; k < 11; ++k) { const int tt = t0 + tq * 8 - 2 + k; xv[k] = (tt >= 0 && tt < 2048) ? bf2f(P[(tokbase + tt) * 2560 + 1536 + n * 64 + ca]) : 0.f; }
#pragma unroll
              for (int i = 0; i < 8; ++i) { const int tl = tq * 8 + i; const float v = cbv + cw[0] * xv[i] + cw[1] * xv[i + 1] + cw[2] * xv[i + 2] + cw[3] * xv[i + 3];
                  XC[tl * 68 + ca] = v;
                  *(LAS bf16_t*)(XA + tl * 128 + ((((unsigned)(ca >> 3)) ^ ((unsigned)(tl >> 1) & 7u)) << 4) + (ca & 7) * 2) = (bf16_t)(pk2(v, 0.f) & 0xffffu); } }
            __syncthreads();
            f32x4 acc[2][2];
#pragma unroll
            for (int jj = 0; jj < 2; ++jj)
#pragma unroll
                for (int gs = 0; gs < 2; ++gs) acc[jj][gs] = (f32x4){0.f, 0.f, 0.f, 0.f};
#pragma unroll
            for (int ks = 0; ks < 2; ++ks) {
                const int row = 16 * mt + col;
                const bf16x8 a = *(const LAS bf16x8*)(XA + row * 128 + ((((unsigned)(4 * ks + kq)) ^ ((unsigned)(row >> 1) & 7u)) << 4));
#pragma unroll
                for (int jj = 0; jj < 2; ++jj)
#pragma unroll
                    for (int gs = 0; gs < 2; ++gs) acc[jj][gs] = MFMA16(a, wf[jj][gs][ks], acc[jj][gs]);
            }
            float hl[2][4], Pp[2][4];
#pragma unroll
            for (int jj = 0; jj < 2; ++jj) {
                const int ch = 16 * (2 * jh + jj) + col;
                float av[4], uv[4];
#pragma unroll
                for (int i = 0; i < 4; ++i) {
                    const int tl = 16 * mt + 4 * kq + i;
                    const float ga = fsigm(acc[jj][0][i] + ba[jj]), gx = fsigm(acc[jj][1][i] + bx[jj]);
                    const float log_a = -8.f * ga * sp[jj]; const float a = __expf(log_a); const float y2 = 2.f * log_a;
                    const float om = (y2 > -0.1f) ? -(y2 * (1.f + y2 * (0.5f + y2 * (0.16666667f + y2 * 0.041666668f)))) : 1.f - __expf(y2);
                    av[i] = a; uv[i] = sqrtf(om) * gx * XC[tl * 68 + ch];
                }
                if (!dir) { hl[jj][0] = uv[0]; Pp[jj][0] = av[0];
#pragma unroll
                    for (int i = 1; i < 4; ++i) { hl[jj][i] = av[i] * hl[jj][i - 1] + uv[i]; Pp[jj][i] = av[i] * Pp[jj][i - 1]; }
                    PH[seg * 64 + ch] = (f32x2_t){Pp[jj][3], hl[jj][3]};
                } else { hl[jj][3] = uv[3]; Pp[jj][3] = av[3];
#pragma unroll
                    for (int i = 2; i >= 0; --i) { hl[jj][i] = av[i] * hl[jj][i + 1] + uv[i]; Pp[jj][i] = av[i] * Pp[jj][i + 1]; }
                    PH[seg * 64 + ch] = (f32x2_t){Pp[jj][0], hl[jj][0]};
                }
            }
            __syncthreads();
            const int ord = dir ? 15 - seg : seg;
#pragma unroll
            for (int jj = 0; jj < 2; ++jj) {
                const int ch = 16 * (2 * jh + jj) + col;
                float cin = Cc[par * 64 + ch];
                for (int s = 0; s < ord; ++s) { const int sg = dir ? 15 - s : s; const f32x2_t ph = PH[sg * 64 + ch]; cin = ph.x * cin + ph.y; }
#pragma unroll
                for (int i = 0; i < 4; ++i) hl[jj][i] += Pp[jj][i] * cin;
                if (ord == 15) Cc[(par ^ 1) * 64 + ch] = dir ? hl[jj][0] : hl[jj][3];
#pragma unroll
                for (int i = 0; i < 4; ++i) {
                    const size_t tok = tokbase + t0 + 16 * mt + 4 * kq + i;
                    if (!dir) HF[tok * 512 + n * 64 + ch] = hl[jj][i];
                    else { const float hf = HF[tok * 512 + n * 64 + ch]; const float g = bf2f(P[tok * 2560 + 2048 + n * 64 + ch]);
                        mixed[tok * 1024 + 512 + n * 64 + ch] = (bf16_t)(pk2((hf + hl[jj][i]) * fsilu(g), 0.f) & 0xffffu); }
                }
            }
        }
        asm volatile("s_waitcnt vmcnt(0)" ::: "memory");
        __syncthreads();
    }
}

__device__ __forceinline__ void na_unit(KPC p, const Frame& F, int o_layer, int b, int h, int rp) {
    const int tid = F.tid, lane = F.lane, wave = F.wave;
    const bf16_t* P = (const bf16_t*)(p->ws + WS_PROJ); const bf16_t* VT = (const bf16_t*)(p->ws + WS_VT); bf16_t* mixed = (bf16_t*)(p->ws + WS_MIXED);
    LAS unsigned char* lds = F.lds; LAS unsigned char* KL = lds; LAS unsigned char* VTL = lds + 73728; LAS float* rpbs = (LAS float*)(lds + 148480);
    const size_t tokbase = (size_t)b * 2048;
    const int r0 = 2 * rp; int rb = r0 - 4; rb = rb < 0 ? 0 : (rb > 24 ? 24 : rb);
    const int nrows = (rb + 9 <= 32) ? 9 : 8; const int nchunk = nrows * 64 * 8;
    for (int id = tid; id < nchunk; id += 512) {
        const int key = id >> 3, ch = id & 7;
        *(LAS u32x4*)(KL + key * 128 + ((ch ^ ((key >> 1) & 7)) << 4)) = *(const u32x4*)(P + (tokbase + rb * 64 + key) * 3072 + 1024 + h * 64 + ch * 8);
    }
    { const int cpr = nrows * 8;
      for (int id = tid; id < 64 * cpr; id += 512) { const int e = id / cpr, ch = id % cpr;
          *(LAS u32x4*)(VTL + e * 1168 + ch * 16) = *(const u32x4*)(VT + ((size_t)(b * 1024 + h * 64 + e)) * 2048 + rb * 64 + ch * 8); } }
    if (tid < 465) rpbs[tid] = p->rpb[((size_t)o_layer * 16 + h) * 465 + tid] * LOG2E;
    __syncthreads();
    {
        const int rr = r0 + (wave >> 2), g = wave & 3, c0 = 16 * g, kc0 = (g == 0) ? 0 : (g == 1 ? 8 : (g == 2 ? 24 : 32));
        int rs = rr - 4; rs = rs < 0 ? 0 : (rs > 24 ? 24 : rs); const int li0 = rs - rb;
        const int q = lane & 15, kq = lane >> 4;
        const size_t tok = tokbase + rr * 64 + c0 + q;
        bf16x8 qf[2];
#pragma unroll
        for (int ks = 0; ks < 2; ++ks) qf[ks] = *(const bf16x8*)(P + tok * 3072 + h * 64 + 32 * ks + 8 * kq);
        f32x4 S[8][2];
#pragma unroll
        for (int i = 0; i < 8; ++i)
#pragma unroll
            for (int a = 0; a < 2; ++a) {
                const int keyl = (li0 + i) * 64 + kc0 + 16 * a + q;
                f32x4 acc = (f32x4){0.f, 0.f, 0.f, 0.f};
#pragma unroll
                for (int ks = 0; ks < 2; ++ks) {
                    const bf16x8 A = *(const LAS bf16x8*)(KL + keyl * 128 + ((((unsigned)(4 * ks + kq)) ^ ((unsigned)(keyl >> 1) & 7u)) << 4));
                    acc = MFMA16(A, qf[ks], acc);
                }
                S[i][a] = acc;
            }
        const int c = c0 + q; int cs = c - 8; cs = cs < 0 ? 0 : (cs > 48 ? 48 : cs);
        float mx = -1e30f;
#pragma unroll
        for (int i = 0; i < 8; ++i)
#pragma unroll
            for (int a = 0; a < 2; ++a)
#pragma unroll
                for (int j = 0; j < 4; ++j) {
                    const int kc = kc0 + 16 * a + 4 * kq + j; const bool valid = (kc >= cs) && (kc < cs + 16);
                    int dc = kc - c + 15; dc = dc < 0 ? 0 : (dc > 30 ? 30 : dc);
                    const float bias = rpbs[(rs + i - rr + 7) * 31 + dc];
                    const float s = valid ? S[i][a][j] + bias : -1e30f;
                    S[i][a][j] = s; mx = fmaxf(mx, s);
                }
        mx = fmaxf(mx, __shfl_xor(mx, 16)); mx = fmaxf(mx, __shfl_xor(mx, 32));
        float l = 0.f;
#pragma unroll
        for (int i = 0; i < 8; ++i)
#pragma unroll
            for (int a = 0; a < 2; ++a)
#pragma unroll
                for (int j = 0; j < 4; ++j) { const float e = ex2(S[i][a][j] - mx); S[i][a][j] = e; l += e; }
        l += __shfl_xor(l, 16); l += __shfl_xor(l, 32);
        f32x4 O[4];
#pragma unroll
        for (int et = 0; et < 4; ++et) O[et] = (f32x4){0.f, 0.f, 0.f, 0.f};
#pragma unroll
        for (int i = 0; i < 8; ++i) {
            u32x4 w; w.x = pk2(S[i][0][0], S[i][0][1]); w.y = pk2(S[i][0][2], S[i][0][3]); w.z = pk2(S[i][1][0], S[i][1][1]); w.w = pk2(S[i][1][2], S[i][1][3]);
            const bf16x8 pf = __builtin_bit_cast(bf16x8, w);
#pragma unroll
            for (int et = 0; et < 4; ++et) {
                const LAS unsigned char* vp = VTL + (16 * et + q) * 1168 + ((li0 + i) * 64 + kc0 + 4 * kq) * 2;
                const u32x2 lo = *(const LAS u32x2*)(vp), hi = *(const LAS u32x2*)(vp + 32);
                u32x4 av; av.x = lo.x; av.y = lo.y; av.z = hi.x; av.w = hi.y;
                O[et] = MFMA16(__builtin_bit_cast(bf16x8, av), pf, O[et]);
            }
        }
        const float inv = 1.f / l;
#pragma unroll
        for (int et = 0; et < 4; ++et) {
            const int e0 = 16 * et + 4 * kq;
            const u32x2 ga = *(const u32x2*)(P + tok * 3072 + 2048 + h * 64 + e0);
            u32x2 w; w.x = pk2(O[et][0] * inv * fsilu(bflo(ga.x)), O[et][1] * inv * fsilu(bfhi(ga.x))); w.y = pk2(O[et][2] * inv * fsilu(bflo(ga.y)), O[et][3] * inv * fsilu(bfhi(ga.y)));
            *(u32x2*)(mixed + tok * 1024 + h * 64 + e0) = w;
        }
    }
    __syncthreads();
}
constexpr int N_PHASES = 15;
__device__ __forceinline__ void run_phase(KPC p, const Frame& F, int ph) {
    unsigned char* ws = p->ws;
    if (ph == 0) { phase_p0a(p, F); return; }
    if (ph == 1) { phase_p0b(p, F); return; }
    if (ph == 14) { phase_final(p, F); return; }
    const int l = (ph - 2) / 3, k = (ph - 2) % 3, odd = l & 1, ei = l >> 1;
    bf16_t* xg = (bf16_t*)(ws + WS_XG); bf16_t* mixed = (bf16_t*)(ws + WS_MIXED); bf16_t* proj = (bf16_t*)(ws + WS_PROJ); bf16_t* VT = (bf16_t*)(ws + WS_VT);
    float* ssq = (float*)(ws + WS_SSQ); const float* sW = (const float*)(ws + WS_SW) + (size_t)l * 16 * 4096; const float* mod = (const float*)(ws + WS_MOD);
    if (k == 0) {
        const int N1 = odd ? 3072 : 2560, NV = odd ? 1024 : 512;
        const bf16_t* Wt = odd ? (const bf16_t*)(ws + WS_WTO) + (size_t)ei * 4096 * 1024 : (const bf16_t*)(ws + WS_WTE) + (size_t)ei * 3072 * 1024;
        { pg8::Gemm g{xg, Wt, MTOK, N1, 1024}; pg8::StaticOrder S; S.init(MTOK, N1, F.G, F.bx);
          EpiProj E{proj, N1, ssq, sW, odd ? 1024 : 512};
          pg8::gemm_phase<EpiProj, pg8::StaticOrder, true, true>(F.lds, g, S, E, F.tid); }
        { pg8::Gemm g{Wt + (size_t)N1 * 1024, xg, NV, MTOK, 1024}; pg8::StaticOrder S; S.init(NV, MTOK, F.G, F.bx);
          EpiProjT E{VT, NV, ssq, sW + N1, odd ? 0 : 1};
          pg8::gemm_phase<EpiProjT, pg8::StaticOrder, true, true>(F.lds, g, S, E, F.tid); }
    } else if (k == 1) {
        if (!odd) {
            const float* scal = (const float*)(ws + WS_SCAL); const float lam = scal[ei * 4 + 0], lam_init = scal[ei * 4 + 1];
            for (int u = F.vcu; u < 1152; u += F.G) {
                Frame Fu = F; asm volatile("" : "+v"(Fu.tid)); Fu.lane = Fu.tid & 63;
                if (u < 128) lru_unit(p, Fu, ei, u >> 3, u & 7);
                else { const int a = u - 128, bh = a >> 4; attn_unit(p, Fu, ei, bh >> 2, bh & 3, a & 15, lam, lam_init); }
            }
        } else {
            for (int u = F.vcu; u < 4096; u += F.G) { Frame Fu = F; asm volatile("" : "+v"(Fu.tid)); Fu.lane = Fu.tid & 63;
                const int bh = u >> 4; na_unit(p, Fu, ei, bh >> 4, bh & 15, u & 15); }
        }
    } else {
        pg8::Gemm g{mixed, (const bf16_t*)(ws + WS_WTOUT) + (size_t)l * 1024 * 1024, MTOK, 1024, 1024}; pg8::StaticOrder S; S.init(MTOK, 1024, F.G, F.bx);
        EpiOut E{l == 0 ? p->x : p->out, p->out, xg, ssq, mod + (size_t)l * 16 * 3072 + 2048, p->norm_g + (l < 3 ? (l + 1) * 1024 : 0), mod + (size_t)(l < 3 ? l + 1 : 0) * 16 * 3072 + 1024, l < 3 ? 1 : 0};
        pg8::gemm_phase<EpiOut, pg8::StaticOrder, true, true>(F.lds, g, S, E, F.tid);
    }
}

__global__ void __launch_bounds__(512, 2) mega(KP p) {
    extern __shared__ __attribute__((aligned(16))) unsigned char lds_raw[];
    for (int ph = p.ph_lo; ph < p.ph_hi; ++ph) {
        if (ph > p.ph_lo) cooperative_groups::this_grid().sync();
        KPC pp = (KPC)__builtin_amdgcn_kernarg_segment_ptr(); asm volatile("" : "+s"(pp));
        int tid = threadIdx.x; asm volatile("" : "+v"(tid));
        int bx = blockIdx.x; asm volatile("" : "+s"(bx));
        Frame F; F.lds = (LAS unsigned char*)lds_raw; F.tid = tid; F.lane = tid & 63; F.wave = __builtin_amdgcn_readfirstlane(tid >> 6);
        F.G = gridDim.x; F.bx = bx; F.vcu = (F.G % 8 == 0) ? (bx % 8) * (F.G / 8) + bx / 8 : bx;
        run_phase(pp, F, ph);
    }
}

#ifndef MK_PER_PHASE
#define MK_PER_PHASE 0
#endif
#ifndef MK_DBG
#define MK_DBG 0
#endif
#if MK_DBG
#endif

static void fill_kp(KP& p, void* const* d_in, void* d_out, void* d_ws) {
    const float** f = (const float**)&p;
    for (int i = 0; i < 21; ++i) f[i] = (const float*)d_in[i];
    p.out = (float*)d_out; p.ws = (unsigned char*)d_ws;
}

extern "C" void kernel_launch(void* const* d_in, const int* in_sizes, int n_in, void* d_out, int out_size, void* d_ws, size_t ws_size, hipStream_t stream) {
    static int grid = 0;
    if (grid == 0) {
        int dev = 0, cus = 0, per_cu = 0;
        if (n_in != 21 || out_size != MTOK * DM || ws_size < WS_END) { fprintf(stderr, "kernel_launch: unexpected shapes (n_in %d out %d ws %zu)\n", n_in, out_size, ws_size); grid = -1; return; }
        (void)hipGetDevice(&dev); (void)hipDeviceGetAttribute(&cus, hipDeviceAttributeMultiprocessorCount, dev);
        if (hipFuncSetAttribute((const void*)mega, hipFuncAttributeMaxDynamicSharedMemorySize, LDS_BYTES) != hipSuccess) { fprintf(stderr, "kernel_launch: hipFuncSetAttribute failed\n"); grid = -1; return; }
        if (hipOccupancyMaxActiveBlocksPerMultiprocessor(&per_cu, (const void*)mega, 512, LDS_BYTES) != hipSuccess || per_cu < 1) { fprintf(stderr, "kernel_launch: occupancy query says %d\n", per_cu); per_cu = 1; }
        (void)hipGetLastError();
        grid = cus * 1;
        if (grid % 8 != 0 || grid < 8) grid = 256;
    }
    if (grid < 0) return;
    KP p{}; fill_kp(p, d_in, d_out, d_ws);
#if MK_DBG
    dbg_forward(p, grid, stream);
#elif MK_PER_PHASE
    for (int ph = 0; ph < N_PHASES; ++ph) { p.ph_lo = ph; p.ph_hi = ph + 1; hipLaunchKernelGGL(mega, dim3(grid), dim3(512), LDS_BYTES, stream, p); }
#else
    p.ph_lo = 0; p.ph_hi = N_PHASES;
    void* args[] = {&p};
    hipError_t e = hipLaunchCooperativeKernel((const void*)mega, dim3(grid), dim3(512), args, LDS_BYTES, stream);
    if (e != hipSuccess) fprintf(stderr, "cooperative launch failed: %s (grid %d)\n", hipGetErrorString(e), grid);
#endif
}
```

```cpp
#include <hip/hip_runtime.h>
#include <hip/hip_cooperative_groups.h>
#include <cstdio>
#include <cstdint>
#include <cmath>

#define LAS __attribute__((address_space(3)))
typedef unsigned short bf16_t;
typedef short bf16x8 __attribute__((ext_vector_type(8)));
typedef float f32x4 __attribute__((ext_vector_type(4)));
typedef float f32x16 __attribute__((ext_vector_type(16)));
typedef unsigned u32x4 __attribute__((ext_vector_type(4)));
typedef unsigned u32x2 __attribute__((ext_vector_type(2)));
typedef float f32x2_t __attribute__((ext_vector_type(2)));
typedef __bf16 bf16x2_t __attribute__((ext_vector_type(2)));

__device__ __forceinline__ unsigned pk2(float lo, float hi) { f32x2_t v = {lo, hi}; bf16x2_t b = __builtin_convertvector(v, bf16x2_t); return __builtin_bit_cast(unsigned, b); }
__device__ __forceinline__ float bflo(unsigned w) { return __uint_as_float(w << 16); }
__device__ __forceinline__ float bfhi(unsigned w) { return __uint_as_float(w & 0xffff0000u); }
__device__ __forceinline__ float bf2f(bf16_t h) { return __uint_as_float((unsigned)h << 16); }
__device__ __forceinline__ float fsilu(float v) { return v / (1.f + __expf(-v)); }
__device__ __forceinline__ float fsigm(float v) { return 1.f / (1.f + __expf(-v)); }
__device__ __forceinline__ float ex2(float v) { return __builtin_amdgcn_exp2f(v); }
__device__ __forceinline__ float wave_sum(float v) {
#pragma unroll
    for (int o = 1; o < 64; o <<= 1) v += __shfl_xor(v, o);
    return v;
}
__device__ __forceinline__ int t5_bucket(int rel) {
    const int n = rel < 0 ? -rel : rel; const int ret = rel > 0 ? 16 : 0;
    int v; if (n < 8) v = n; else { v = 33 - __clz(n * n); if (v > 15) v = 15; }
    return ret + v;
}
#define LDS_WAIT() asm volatile("s_waitcnt lgkmcnt(0)" ::: "memory")
constexpr float LOG2E = 1.4426950408889634f;
constexpr float QSCALE = 0.125f * 1.4426950408889634f;

constexpr int DM = 1024, SEQ = 2048, NBATCH = 16, MTOK = NBATCH * SEQ;
constexpr size_t MiB = 1u << 20;
constexpr size_t WS_CTL = 0, WS_MOD = 1 * MiB, WS_SW = 2 * MiB, WS_SSQ = 3 * MiB, WS_SCAL = 5 * MiB, WS_WG = 5 * MiB + 65536;
constexpr size_t WS_WTE = 6 * MiB, WS_WTO = 18 * MiB, WS_WTOUT = 34 * MiB;
constexpr size_t WS_XG = 48 * MiB, WS_MIXED = 112 * MiB, WS_PROJ = 176 * MiB, WS_VT = 368 * MiB, WS_END = 432 * MiB;
constexpr int LDS_BYTES = 163840;
constexpr int LDS_SPARE = 131072;

struct KP {
    const float *x, *c, *ada_w, *ada_b, *norm_g, *final_g, *t5, *even_w_in, *even_w_out, *da_lam, *da_subg, *conv_w, *conv_b, *w_a, *b_a, *w_x, *b_x, *lru_lam, *odd_w_in, *odd_w_out, *rpb;
    float* out; unsigned char* ws; int ph_lo, ph_hi;
};
typedef const __attribute__((address_space(4))) KP* KPC;
struct Frame { LAS unsigned char* lds; int tid, lane, wave, vcu, G, bx; };

namespace pg8 {
constexpr int BM = 256, BK = 64, HALF = 128, HTB = HALF * BK * 2, STAGE_BYTES = 8 * HTB, NXCD = 8, WGM = 8;
__host__ __device__ __forceinline__ int lds_byte(int r, int c) { const int st = (r >> 4) * 2 + (c >> 5), rr = r & 15, cc = c & 31, ob = rr * 64 + cc * 2; return st * 1024 + (ob ^ (((ob >> 9) & 1) << 5)); }
__host__ __device__ __forceinline__ void stage_rc(int b, int& R, int& C) { const int st = b / 1024, sb = b % 1024, swz = sb ^ (((sb >> 9) & 1) << 5); R = (st >> 1) * 16 + swz / 64; C = (st & 1) * 32 + (swz % 64) / 2; }
__host__ __device__ __forceinline__ int perm32(int rho) { const int n = rho >> 4, i = rho & 15; return 8 * (i >> 2) + 4 * n + (i & 3); }
struct Unit { int pm, pn; };
struct Gemm { const bf16_t* A; const bf16_t* Bt; int M, N, K; };
struct StaticOrder {
    int nM, nN, nwg, G, c;
    __host__ __device__ void init(int M, int N, int G_, int c_) { nM = M / BM; nN = N / BM; nwg = nM * nN; G = G_; c = c_; }
    __host__ __device__ bool next(int i, Unit& u) const {
        const long L = (long)i * G + c; if (L >= nwg) return false;
        int wgid = (int)L; { const int q = nwg / NXCD, r = nwg % NXCD, xcd = wgid % NXCD, off = wgid / NXCD; wgid = (xcd < r ? xcd * (q + 1) : r * (q + 1) + (xcd - r) * q) + off; }
        const int nig = WGM * nN, gid = wgid / nig, fm = gid * WGM, gsz = (nM - fm) < WGM ? (nM - fm) : WGM;
        u.pm = fm + ((wgid % nig) % gsz); u.pn = (wgid % nig) / gsz; return true;
    }
};

template <class Epi, class Sched, bool ALIGN_EPI = false, bool SP2 = false>
__device__ __forceinline__ void gemm_phase(LAS unsigned char* lds, const Gemm g, const Sched& S, const Epi& E, const int tid) {
    const int wid = __builtin_amdgcn_readfirstlane(tid >> 6), lane = tid & 63, wr = wid >> 2, wc = wid & 3, fr = lane & 15, fq = lane >> 4;
    const int K = g.K, nt = K / BK;
    unsigned voffA[2], voffB[2];
#pragma unroll
    for (int i = 0; i < 2; ++i) { int R, C; stage_rc(tid * 16 + i * 8192, R, C); const int Rb = Epi::PERM ? ((R & ~31) + perm32(R & 31)) : R;
        voffA[i] = (unsigned)(R * K + C) * 2u; voffB[i] = (unsigned)(Rb * K + C) * 2u; }
    const size_t kstep = (size_t)(BK * 2);
    const size_t hstep = (size_t)HALF * K * 2;
    const size_t tstep = 2 * hstep;
    const unsigned ldsw = (unsigned)wid * 1024u;
    const int aoff = lds_byte(wr * 64 + fr, fq * 8), boff = lds_byte(wc * 32 + fr, fq * 8);
#define PG8_SA(b, h) (((b) * 2 + (h)) * HTB)
#define PG8_SB(b, h) ((4 + (b) * 2 + (h)) * HTB)
#define PG8_STAGE(bufoff, gbase, voff) do { _Pragma("unroll") for (int _i = 0; _i < 2; ++_i) \
        __builtin_amdgcn_global_load_lds((const unsigned*)((const char*)(gbase) + (voff)[_i]), (LAS unsigned*)(lds + (bufoff) + ldsw + _i * 8192), 16, 0, 0); } while (0)
#define PG8_LDA(dst, b, h) do { _Pragma("unroll") for (int m = 0; m < 4; ++m) _Pragma("unroll") for (int k = 0; k < 2; ++k) dst[m][k] = *(const LAS bf16x8*)(lds + PG8_SA(b, h) + aoff + m * 2048 + k * 1024); } while (0)
#define PG8_LDB(dst, b, h) do { _Pragma("unroll") for (int n = 0; n < 2; ++n) _Pragma("unroll") for (int k = 0; k < 2; ++k) dst[n][k] = *(const LAS bf16x8*)(lds + PG8_SB(b, h) + boff + n * 2048 + k * 1024); } while (0)
#define PG8_MMA(ai, bj, At, Bt) do { __builtin_amdgcn_s_setprio(1); _Pragma("unroll") for (int m = 0; m < 4; ++m) _Pragma("unroll") for (int n = 0; n < 2; ++n) _Pragma("unroll") for (int k = 0; k < 2; ++k) \
        acc[ai][bj][m][n] = __builtin_amdgcn_mfma_f32_16x16x32_bf16(Bt[n][k], At[m][k], acc[ai][bj][m][n], 0, 0, 0); __builtin_amdgcn_s_setprio(0); } while (0)
#define PG8_WAIT_V(n) asm volatile("s_waitcnt vmcnt(" #n ")" ::: "memory")
#define PG8_WAIT_L(n) asm volatile("s_waitcnt lgkmcnt(" #n ")" ::: "memory")
#define PG8_BAR __builtin_amdgcn_s_barrier()
#define PG8_SCHED __builtin_amdgcn_sched_barrier(0)
    Unit cur, nxt; int ui = 0;
    if (!S.next(0, cur)) return;
    f32x4 acc[2][2][4][2];
#pragma unroll
    for (int a = 0; a < 2; ++a)
#pragma unroll
        for (int b = 0; b < 2; ++b)
#pragma unroll
            for (int m = 0; m < 4; ++m)
#pragma unroll
                for (int n = 0; n < 2; ++n) acc[a][b][m][n] = (f32x4){0.f, 0.f, 0.f, 0.f};
    bf16x8 At[4][2], B0[2][2], B1[2][2];
    const char* cA = (const char*)g.A + (size_t)cur.pm * tstep; const char* cB = (const char*)g.Bt + (size_t)cur.pn * tstep;
    if constexpr (SP2) {
        PG8_STAGE(PG8_SB(0, 0), cB, voffB); PG8_STAGE(PG8_SB(0, 1), cB + hstep, voffB); PG8_STAGE(PG8_SA(0, 0), cA, voffA); PG8_STAGE(PG8_SA(0, 1), cA + hstep, voffA);
        if (wr == 1) PG8_BAR;
        PG8_WAIT_V(2); PG8_BAR;
        PG8_STAGE(PG8_SB(1, 0), cB + kstep, voffB); PG8_STAGE(PG8_SA(1, 0), cA + kstep, voffA); PG8_STAGE(PG8_SB(1, 1), cB + hstep + kstep, voffB);
        PG8_WAIT_V(6); PG8_BAR;
    } else {
        PG8_STAGE(PG8_SB(0, 0), cB, voffB); PG8_STAGE(PG8_SA(0, 0), cA, voffA); PG8_STAGE(PG8_SB(0, 1), cB + hstep, voffB); PG8_STAGE(PG8_SA(0, 1), cA + hstep, voffA);
        if (wr == 1) PG8_BAR;
        PG8_WAIT_V(4); PG8_BAR;
        PG8_STAGE(PG8_SB(1, 0), cB + kstep, voffB); PG8_STAGE(PG8_SA(1, 0), cA + kstep, voffA); PG8_STAGE(PG8_SB(1, 1), cB + hstep + kstep, voffB);
        PG8_WAIT_V(6); PG8_BAR;
    }
    for (;;) {
        const bool has_next = S.next(ui + 1, nxt);
        const char* nA = has_next ? (const char*)g.A + (size_t)nxt.pm * tstep : cA; const char* nB = has_next ? (const char*)g.Bt + (size_t)nxt.pn * tstep : cB;
        for (int t = 0; t < nt; t += 2) {
            const bool last = (t == nt - 2);
            const char* a1 = cA + (size_t)(t + 1) * kstep;
            const char* a2 = last ? nA : cA + (size_t)(t + 2) * kstep; const char* b2 = last ? nB : cB + (size_t)(t + 2) * kstep;
            const char* a3 = a2 + kstep; const char* b3 = b2 + kstep;
            if constexpr (SP2) {
            PG8_LDB(B0, 0, 0); PG8_LDB(B1, 0, 1); PG8_SCHED; PG8_LDA(At, 0, 0); PG8_STAGE(PG8_SA(1, 1), a1 + hstep, voffA);
            PG8_WAIT_V(8); PG8_WAIT_L(0); PG8_BAR; PG8_MMA(0, 0, At, B0); PG8_MMA(0, 1, At, B1); PG8_BAR; PG8_SCHED;
            PG8_LDA(At, 0, 1); PG8_STAGE(PG8_SB(0, 0), b2, voffB); PG8_STAGE(PG8_SB(0, 1), b2 + hstep, voffB); PG8_STAGE(PG8_SA(0, 0), a2, voffA);
            PG8_WAIT_V(8); PG8_WAIT_L(0); PG8_BAR; PG8_MMA(1, 0, At, B0); PG8_MMA(1, 1, At, B1); PG8_BAR; PG8_SCHED;
            PG8_LDB(B0, 1, 0); PG8_LDB(B1, 1, 1); PG8_SCHED; PG8_LDA(At, 1, 0); PG8_STAGE(PG8_SA(0, 1), a2 + hstep, voffA);
            PG8_WAIT_V(8); PG8_WAIT_L(0); PG8_BAR; PG8_MMA(0, 0, At, B0); PG8_MMA(0, 1, At, B1); PG8_BAR; PG8_SCHED;
            PG8_LDA(At, 1, 1); PG8_STAGE(PG8_SB(1, 0), b3, voffB); PG8_STAGE(PG8_SB(1, 1), b3 + hstep, voffB); PG8_STAGE(PG8_SA(1, 0), a3, voffA);
            PG8_WAIT_V(8); PG8_WAIT_L(0); PG8_BAR; PG8_MMA(1, 0, At, B0); PG8_MMA(1, 1, At, B1); PG8_BAR; PG8_SCHED;
            } else {
            PG8_LDB(B0, 0, 0); PG8_SCHED; PG8_LDA(At, 0, 0); PG8_STAGE(PG8_SA(1, 1), a1 + hstep, voffA);
            PG8_WAIT_L(8); PG8_BAR; PG8_WAIT_L(0); PG8_MMA(0, 0, At, B0); PG8_BAR; PG8_SCHED;
            PG8_LDB(B1, 0, 1); PG8_STAGE(PG8_SB(0, 0), b2, voffB);
            PG8_BAR; PG8_WAIT_L(0); PG8_MMA(0, 1, At, B1); PG8_BAR;
            PG8_LDA(At, 0, 1); PG8_STAGE(PG8_SA(0, 0), a2, voffA);
            PG8_BAR; PG8_WAIT_L(0); PG8_MMA(1, 0, At, B0); PG8_BAR; PG8_SCHED;
            PG8_STAGE(PG8_SB(0, 1), b2 + hstep, voffB);
            PG8_WAIT_V(6); PG8_BAR; PG8_MMA(1, 1, At, B1); PG8_BAR;
            PG8_LDB(B0, 1, 0); PG8_SCHED; PG8_LDA(At, 1, 0); PG8_STAGE(PG8_SA(0, 1), a2 + hstep, voffA);
            PG8_WAIT_L(8); PG8_BAR; PG8_WAIT_L(0); PG8_MMA(0, 0, At, B0); PG8_BAR; PG8_SCHED;
            PG8_LDB(B1, 1, 1); PG8_STAGE(PG8_SB(1, 0), b3, voffB);
            PG8_BAR; PG8_WAIT_L(0); PG8_MMA(0, 1, At, B1); PG8_BAR;
            PG8_LDA(At, 1, 1); PG8_STAGE(PG8_SA(1, 0), a3, voffA);
            PG8_BAR; PG8_WAIT_L(0); PG8_MMA(1, 0, At, B0); PG8_BAR; PG8_SCHED;
            PG8_STAGE(PG8_SB(1, 1), b3 + hstep, voffB);
            PG8_WAIT_V(6); PG8_BAR; PG8_MMA(1, 1, At, B1); PG8_BAR;
            }
        }
        if constexpr (ALIGN_EPI) { if (wr == 0) PG8_BAR; }
        E(acc, cur, wr, wc, fr, fq);
        if (!has_next) break;
#pragma unroll
        for (int a = 0; a < 2; ++a)
#pragma unroll
            for (int b = 0; b < 2; ++b)
#pragma unroll
                for (int m = 0; m < 4; ++m)
#pragma unroll
                    for (int n = 0; n < 2; ++n) acc[a][b][m][n] = (f32x4){0.f, 0.f, 0.f, 0.f};
        cur = nxt; cA = nA; cB = nB; ++ui;
        if constexpr (ALIGN_EPI) { if (wr == 1) PG8_BAR; }
    }
    PG8_WAIT_V(0);
    if constexpr (!ALIGN_EPI) { if (wr == 0) PG8_BAR; }
    PG8_BAR;
#undef PG8_SA
#undef PG8_SB
#undef PG8_STAGE
#undef PG8_LDA
#undef PG8_LDB
#undef PG8_MMA
#undef PG8_WAIT_V
#undef PG8_WAIT_L
#undef PG8_BAR
#undef PG8_SCHED
}
}
__device__ __forceinline__ float ssq_rinv(const float* ssq, int row) {
    const f32x4* sp = (const f32x4*)(ssq + (size_t)row * 16);
    const f32x4 a = sp[0], b = sp[1], c = sp[2], d = sp[3];
    const float s = ((a[0] + a[1]) + (a[2] + a[3])) + ((b[0] + b[1]) + (b[2] + b[3])) + ((c[0] + c[1]) + (c[2] + c[3])) + ((d[0] + d[1]) + (d[2] + d[3]));
    return rsqrtf(s * (1.f / 1024.f) + 1e-6f);
}
struct EpiProj {
    static constexpr bool PERM = true;
    bf16_t* O; int ldc; const float* ssq; const float* sW; int qcols;
    __device__ __forceinline__ void operator()(const f32x4 (&acc)[2][2][4][2], const pg8::Unit& u, int wr, int wc, int fr, int fq) const {
        const int row0 = u.pm * 256 + wr * 64 + fr, colb = u.pn * 256 + wc * 32 + 8 * fq, b = (u.pm * 256) >> 11;
        const float* sWb = sW + (size_t)b * 4096;
        f32x4 bv[2][2];
#pragma unroll
        for (int bj = 0; bj < 2; ++bj)
#pragma unroll
            for (int n = 0; n < 2; ++n) bv[bj][n] = *(const f32x4*)(sWb + colb + bj * 128 + 4 * n);
#pragma unroll
        for (int ai = 0; ai < 2; ++ai)
#pragma unroll
            for (int m = 0; m < 4; ++m) {
                const int row = row0 + ai * 128 + m * 16; const float rt = ssq_rinv(ssq, row);
                bf16_t* rowp = O + (size_t)row * ldc + colb;
#pragma unroll
                for (int bj = 0; bj < 2; ++bj) {
                    const float sc = (u.pn * 256 + bj * 128 < qcols) ? QSCALE : 1.f;
                    const f32x4 v0 = (acc[ai][bj][m][0] * rt + bv[bj][0]) * sc, v1 = (acc[ai][bj][m][1] * rt + bv[bj][1]) * sc;
                    u32x4 w; w.x = pk2(v0[0], v0[1]); w.y = pk2(v0[2], v0[3]); w.z = pk2(v1[0], v1[1]); w.w = pk2(v1[2], v1[3]);
                    *(u32x4*)(rowp + bj * 128) = w;
                }
            }
    }
};
struct EpiProjT {
    static constexpr bool PERM = true;
    bf16_t* VT; int NV; const float* ssq; const float* sW;   int swap23;
    __device__ __forceinline__ void operator()(const f32x4 (&acc)[2][2][4][2], const pg8::Unit& u, int wr, int wc, int fr, int fq) const {
        const int tok0 = u.pn * 256, b = tok0 >> 11, t0 = tok0 & 2047;
        const int vrow0 = u.pm * 256 + wr * 64 + fr;
        const float* sWb = sW + (size_t)b * 4096;
        bf16_t* base = VT + (size_t)b * NV * 2048 + t0;
#pragma unroll
        for (int bj = 0; bj < 2; ++bj) {
            float rt[2][4];
#pragma unroll
            for (int n = 0; n < 2; ++n)
#pragma unroll
                for (int i = 0; i < 4; ++i) rt[n][i] = ssq_rinv(ssq, tok0 + bj * 128 + wc * 32 + 8 * fq + 4 * n + i);
            const int cl = bj * 128 + wc * 32;
#pragma unroll
            for (int ai = 0; ai < 2; ++ai)
#pragma unroll
                for (int m = 0; m < 4; ++m) {
                    const int vrow = vrow0 + ai * 128 + m * 16; const float bias = sWb[vrow];
                    bf16_t* rowp = base + (size_t)vrow * 2048 + cl;
                    const f32x4 a0 = acc[ai][bj][m][0], a1 = acc[ai][bj][m][1];
                    u32x2 w0, w1;
                    w0.x = pk2(a0[0] * rt[0][0] + bias, a0[1] * rt[0][1] + bias); w0.y = pk2(a0[2] * rt[0][2] + bias, a0[3] * rt[0][3] + bias);
                    w1.x = pk2(a1[0] * rt[1][0] + bias, a1[1] * rt[1][1] + bias); w1.y = pk2(a1[2] * rt[1][2] + bias, a1[3] * rt[1][3] + bias);
                    if (swap23) {
                        *(u32x2*)(rowp + 16 * (fq >> 1) + 4 * (fq & 1)) = w0;
                        *(u32x2*)(rowp + 16 * (fq >> 1) + 8 + 4 * (fq & 1)) = w1;
                    } else {
                        u32x4 w; w.x = w0.x; w.y = w0.y; w.z = w1.x; w.w = w1.y; *(u32x4*)(rowp + 8 * fq) = w;
                    }
                }
        }
    }
};
struct EpiOut {
    static constexpr bool PERM = true;
    const float* xin; float* xout; bf16_t* xg; float* ssq; const float* gate;   const float* gnext; const float* scnext;   int has_next;
    __device__ __forceinline__ void operator()(const f32x4 (&acc)[2][2][4][2], const pg8::Unit& u, int wr, int wc, int fr, int fq) const {
        const int row0 = u.pm * 256 + wr * 64 + fr, colb = u.pn * 256 + wc * 32 + 8 * fq, b = (u.pm * 256) >> 11;
        f32x4 gv[2][2], Gn[2][2];
#pragma unroll
        for (int bj = 0; bj < 2; ++bj)
#pragma unroll
            for (int n = 0; n < 2; ++n) {
                const int col = colb + bj * 128 + 4 * n;
                gv[bj][n] = *(const f32x4*)(gate + (size_t)b * 3072 + col);
                if (has_next) { const f32x4 g = *(const f32x4*)(gnext + col), s = *(const f32x4*)(scnext + (size_t)b * 3072 + col); Gn[bj][n] = g * (s + 1.f); }
                else Gn[bj][n] = (f32x4){0.f, 0.f, 0.f, 0.f};
            }
#pragma unroll
        for (int ai = 0; ai < 2; ++ai)
#pragma unroll
            for (int m = 0; m < 4; ++m) {
                const int row = row0 + ai * 128 + m * 16; float ps = 0.f;
#pragma unroll
                for (int bj = 0; bj < 2; ++bj) {
                    const size_t off = (size_t)row * 1024 + colb + bj * 128;
                    const f32x4 x0 = *(const f32x4*)(xin + off), x1 = *(const f32x4*)(xin + off + 4);
                    const f32x4 y0 = x0 + gv[bj][0] * acc[ai][bj][m][0], y1 = x1 + gv[bj][1] * acc[ai][bj][m][1];
                    *(f32x4*)(xout + off) = y0; *(f32x4*)(xout + off + 4) = y1;
                    ps += (y0[0] * y0[0] + y0[1] * y0[1]) + (y0[2] * y0[2] + y0[3] * y0[3]) + (y1[0] * y1[0] + y1[1] * y1[1]) + (y1[2] * y1[2] + y1[3] * y1[3]);
                    if (has_next) { const f32x4 z0 = y0 * Gn[bj][0], z1 = y1 * Gn[bj][1];
                        u32x4 w; w.x = pk2(z0[0], z0[1]); w.y = pk2(z0[2], z0[3]); w.z = pk2(z1[0], z1[1]); w.w = pk2(z1[2], z1[3]); *(u32x4*)(xg + off) = w; }
                }
                ps += __shfl_xor(ps, 16); ps += __shfl_xor(ps, 32);
                if (fq == 0) ssq[(size_t)row * 16 + u.pn * 4 + wc] = ps;
            }
    }
};

__device__ __forceinline__ int remap_col(int n, int mode) {
    if (mode == 1) return n < 1024 ? n : (n < 1536 ? n + 1536 : n - 512);
    if (mode == 2) return n < 2048 ? n : (n < 3072 ? n + 1024 : n - 1024);
    return n;
}
__device__ __forceinline__ int unmap_col(int c, int odd) {
    if (!odd) return c < 1024 ? c : (c < 2560 ? c + 512 : c - 1536);
    return c < 2048 ? c : (c < 3072 ? c + 1024 : c - 1024);
}
__device__ __forceinline__ void p0_transpose_item(const float* W, int K, int N, bf16_t* WT, int item, LAS float* scr, int lane, int mode) {
    const int nblk = N / 32, kb = item / nblk, nb = item % nblk, k0 = 64 * kb, n0 = 32 * nb;
#pragma unroll 8
    for (int i = 0; i < 32; ++i) { const int kk = 2 * i + (lane >> 5); scr[kk * 33 + (lane & 31)] = W[(size_t)(k0 + kk) * N + n0 + (lane & 31)]; }
    LDS_WAIT(); asm volatile("" ::: "memory");
    const int c = lane & 7;
#pragma unroll
    for (int j = 0; j < 4; ++j) { const int n = (lane >> 3) + 8 * j; const LAS float* s = scr + (8 * c) * 33 + n;
        u32x4 o; o.x = pk2(s[0 * 33], s[1 * 33]); o.y = pk2(s[2 * 33], s[3 * 33]); o.z = pk2(s[4 * 33], s[5 * 33]); o.w = pk2(s[6 * 33], s[7 * 33]);
        *(u32x4*)(WT + (size_t)remap_col(n0 + n, mode) * K + k0 + 8 * c) = o; }
    LDS_WAIT(); asm volatile("" ::: "memory");
}
__device__ __forceinline__ void gemv16_item(const LAS float* vec, const float* W, int ldw, int col0, float* out, int out_ld, int ocol0, const float* bias, int lane) {
    const int n = lane & 15, kq = lane >> 4;
    float acc[16];
#pragma unroll
    for (int b = 0; b < 16; ++b) acc[b] = 0.f;
    const float* wp = W + (size_t)(kq * 256) * ldw + col0 + n; const LAS float* vp = vec + kq * 256;
#pragma unroll 4
    for (int i = 0; i < 256; ++i) {
        const float w = wp[(size_t)i * ldw];
#pragma unroll
        for (int b = 0; b < 16; ++b) acc[b] += vp[b * 1024 + i] * w;
    }
#pragma unroll
    for (int b = 0; b < 16; ++b) { acc[b] += __shfl_xor(acc[b], 16); acc[b] += __shfl_xor(acc[b], 32); }
    if (kq == 0) { const float bs = bias ? bias[col0 + n] : 0.f;
#pragma unroll
        for (int b = 0; b < 16; ++b) out[(size_t)b * out_ld + ocol0 + n] = acc[b] + bs; }
}

__device__ __forceinline__ void phase_p0a(KPC p, const Frame& F) {
    unsigned char* ws = p->ws;
    bf16_t* WtE = (bf16_t*)(ws + WS_WTE); bf16_t* WtO = (bf16_t*)(ws + WS_WTO); bf16_t* WtOut = (bf16_t*)(ws + WS_WTOUT); bf16_t* Wg = (bf16_t*)(ws + WS_WG);
    float* mod = (float*)(ws + WS_MOD); float* scal = (float*)(ws + WS_SCAL);
    LAS float* scr = (LAS float*)(F.lds + F.wave * 8448);
    LAS float* vec = (LAS float*)(F.lds + 73728);
    const int gw = F.vcu * 8 + F.wave, NGW = F.G * 8;
    for (int i = F.tid; i < 16384; i += 512) vec[i] = fsilu(p->c[i]);
    for (int it = gw; it < 9216; it += NGW) {
        int r = it;
        if (r < 3072) { const int e = r / 1536; p0_transpose_item(p->even_w_in + (size_t)e * 1024 * 3072, 1024, 3072, WtE + (size_t)e * 3072 * 1024, r % 1536, scr, F.lane, 1); continue; }
        r -= 3072;
        if (r < 4096) { const int o = r / 2048; p0_transpose_item(p->odd_w_in + (size_t)o * 1024 * 4096, 1024, 4096, WtO + (size_t)o * 4096 * 1024, r % 2048, scr, F.lane, 2); continue; }
        r -= 4096;
        { const int j = r / 512; const int l = (j < 2) ? 2 * j : 2 * (j - 2) + 1; const float* src = (j < 2) ? p->even_w_out + (size_t)j * 1024 * 1024 : p->odd_w_out + (size_t)(j - 2) * 1024 * 1024;
          p0_transpose_item(src, 1024, 1024, WtOut + (size_t)l * 1024 * 1024, r % 512, scr, F.lane, 0); }
    }
    for (int idx = gw * 64 + F.lane; idx < 262144; idx += NGW * 64) {
        const int k = idx & 63, j = (idx >> 6) & 255, n = (idx >> 14) & 7, e = idx >> 17; const int set = j >> 6, d = j & 63, r = set >> 1;
        const float* src = (set & 1) ? p->w_x : p->w_a;
        const float v = src[((((size_t)e * 2 + r) * 8 + n) * 64 + k) * 64 + d];
        Wg[idx] = (bf16_t)(pk2(v, 0.f) & 0xffffu);
    }
    if (F.bx == 0 && F.tid < 2) {
        const int e = F.tid; const float* lp = p->da_lam + e * 256; float s01 = 0.f, s23 = 0.f;
        for (int i = 0; i < 64; ++i) { s01 += lp[i] * lp[64 + i]; s23 += lp[128 + i] * lp[192 + i]; }
        const float lam_init = (e == 0) ? 0.2f : 0.47071302f;
        scal[e * 4 + 0] = expf(s01) - expf(s23) + lam_init; scal[e * 4 + 1] = lam_init;
    }
    __syncthreads();
    for (int it = F.wave * F.G + F.vcu; it < 768; it += NGW) {
        const int l = it / 192, ch = it % 192;
        gemv16_item(vec, p->ada_w + (size_t)l * 1024 * 3072, 3072, ch * 16, mod + (size_t)l * 16 * 3072, 3072, ch * 16, p->ada_b + l * 3072, F.lane);
    }
}
__device__ __forceinline__ void phase_p0b(KPC p, const Frame& F) {
    unsigned char* ws = p->ws;
    const float* mod = (const float*)(ws + WS_MOD); float* sW = (float*)(ws + WS_SW); float* ssq = (float*)(ws + WS_SSQ); bf16_t* xg = (bf16_t*)(ws + WS_XG);
    LAS float* vec = (LAS float*)(F.lds);
    const int l = F.vcu & 3;
    for (int i = F.tid; i < 16384; i += 512) vec[i] = mod[((size_t)l * 16 + (i >> 10)) * 3072 + (i & 1023)];
    __syncthreads();
    {
        const int odd = l & 1, N = odd ? 4096 : 3072;
        const float* W = odd ? p->odd_w_in + (size_t)(l >> 1) * 1024 * 4096 : p->even_w_in + (size_t)(l >> 1) * 1024 * 3072;
        for (int it = (F.vcu >> 2) * 8 + F.wave; it < N / 16; it += (F.G >> 2) * 8)
            gemv16_item(vec, W, N, unmap_col(it * 16, odd), sW + (size_t)l * 16 * 4096, 4096, it * 16, nullptr, F.lane);
    }
    const int gw = F.vcu * 8 + F.wave, NGW = F.G * 8;
    for (int row = gw; row < MTOK; row += NGW) {
        const int b = row >> 11;
        const f32x4* xr = (const f32x4*)(p->x + (size_t)row * 1024) + F.lane;
        f32x4 v[4]; float s = 0.f;
#pragma unroll
        for (int j = 0; j < 4; ++j) { v[j] = xr[64 * j]; s += (v[j][0] * v[j][0] + v[j][1] * v[j][1]) + (v[j][2] * v[j][2] + v[j][3] * v[j][3]); }
        s = wave_sum(s);
        unsigned long long* o8 = (unsigned long long*)(xg + (size_t)row * 1024) + F.lane;
#pragma unroll
        for (int j = 0; j < 4; ++j) {
            const int k = 4 * F.lane + 256 * j;
            const f32x4 g = *(const f32x4*)(p->norm_g + k), sc = *(const f32x4*)(mod + (size_t)b * 3072 + 1024 + k);
            const f32x4 z = v[j] * g * (sc + 1.f);
            o8[64 * j] = (unsigned long long)pk2(z[0], z[1]) | ((unsigned long long)pk2(z[2], z[3]) << 32);
        }
        if (F.lane < 16) ssq[(size_t)row * 16 + F.lane] = (F.lane == 0) ? s : 0.f;
    }
}
__device__ __forceinline__ void phase_final(KPC p, const Frame& F) {
    const float* ssq = (const float*)(p->ws + WS_SSQ);
    const int gw = F.vcu * 8 + F.wave, NGW = F.G * 8;
    for (int row = gw; row < MTOK; row += NGW) {
        const float rt = ssq_rinv(ssq, row);
        f32x4* xr = (f32x4*)(p->out + (size_t)row * 1024) + F.lane;
#pragma unroll
        for (int j = 0; j < 4; ++j) { const f32x4 g = *(const f32x4*)(p->final_g + 4 * F.lane + 256 * j); xr[64 * j] = xr[64 * j] * rt * g; }
    }
}
#define MFMA32(a, b, c) __builtin_amdgcn_mfma_f32_32x32x16_bf16((a), (b), (c), 0, 0, 0)
#define MFMA16(a, b, c) __builtin_amdgcn_mfma_f32_16x16x32_bf16((a), (b), (c), 0, 0, 0)
__device__ __forceinline__ void attn_unit(KPC p, const Frame& F, int e_layer, int b, int h, int qb, float lam, float lam_init) {
    const int tid = F.tid, lane = F.lane, r = lane & 31, hh = lane >> 5, m = F.wave & 1, sub = F.wave >> 1;
    const bf16_t* P = (const bf16_t*)(p->ws + WS_PROJ); const bf16_t* VT = (const bf16_t*)(p->ws + WS_VT); bf16_t* mixed = (bf16_t*)(p->ws + WS_MIXED);
    LAS unsigned char* lds = F.lds;
    LAS float* lut = (LAS float*)(lds + 65536);
    const size_t tokbase = (size_t)b * 2048; const int q0w = qb * 128 + sub * 32;
    if (tid < 511) lut[tid] = p->t5[h * 32 + t5_bucket(tid - 255)] * LOG2E;
    const float cL = p->t5[h * 32 + 15] * LOG2E, cR = p->t5[h * 32 + 31] * LOG2E;
    bf16x8 qf[4];
    { const bf16_t* qp = P + (tokbase + q0w + r) * 2560 + h * 128 + m * 64 + hh * 8;
#pragma unroll
      for (int s = 0; s < 4; ++s) qf[s] = *(const bf16x8*)(qp + 16 * s); }
    const int skey = (tid >> 3) & 63, sch = tid & 7;
    const bf16_t* ksrc0 = P + (tokbase + skey) * 2560 + 512 + h * 128 + sch * 8;
    const unsigned kdst0 = (unsigned)(skey * 128 + ((sch ^ ((skey >> 1) & 7)) << 4));
    const int ve0 = tid >> 3;
    const bf16_t* vsrc0 = VT + ((size_t)(b * 512 + h * 128 + ve0)) * 2048 + sch * 8;
    const unsigned vdst0 = (unsigned)(16384 + ve0 * 128 + ((sch ^ ((ve0 >> 1) & 7)) << 4));
    u32x4 kr0, kr1, vr0, vr1;
    kr0 = *(const u32x4*)(ksrc0); kr1 = *(const u32x4*)(ksrc0 + 64); vr0 = *(const u32x4*)(vsrc0); vr1 = *(const u32x4*)(vsrc0 + (size_t)64 * 2048);
    *(LAS u32x4*)(lds + kdst0) = kr0; *(LAS u32x4*)(lds + 8192 + kdst0) = kr1; *(LAS u32x4*)(lds + vdst0) = vr0; *(LAS u32x4*)(lds + 8192 + vdst0) = vr1;
    __syncthreads();
    f32x16 O[4];
#pragma unroll
    for (int et = 0; et < 4; ++et)
#pragma unroll
        for (int i = 0; i < 16; ++i) O[et][i] = 0.f;
    float m_run = -INFINITY, l_run = 0.f;
    const unsigned swz = (unsigned)((r >> 1) & 7);
    for (int j = 0; j < 32; ++j) {
        const int st = (j & 1) * 32768;
        if (j + 1 < 32) {
            const bf16_t* ks = ksrc0 + (size_t)(j + 1) * 64 * 2560; const bf16_t* vs = vsrc0 + (j + 1) * 64;
            kr0 = *(const u32x4*)(ks); kr1 = *(const u32x4*)(ks + 64); vr0 = *(const u32x4*)(vs); vr1 = *(const u32x4*)(vs + (size_t)64 * 2048);
        }
        const LAS unsigned char* kb = lds + st + m * 8192; const LAS unsigned char* vb = lds + st + 16384;
        f32x16 S0, S1;
        { const int rel_max = 64 * j + 63 - q0w, rel_min = 64 * j - (q0w + 31);
          if (rel_max <= -91) {
#pragma unroll
              for (int i = 0; i < 16; ++i) { S0[i] = cL; S1[i] = cL; }
          } else if (rel_min >= 91) {
#pragma unroll
              for (int i = 0; i < 16; ++i) { S0[i] = cR; S1[i] = cR; }
          } else {
              const int ib = 64 * j + 4 * hh - (q0w + r) + 255;
#pragma unroll
              for (int i = 0; i < 16; ++i) { const int idx = ib + (i & 3) + 8 * (i >> 2); S0[i] = lut[idx]; S1[i] = lut[idx + 32]; }
          } }
#pragma unroll
        for (int s = 0; s < 4; ++s) {
            const unsigned co = (((unsigned)(2 * s + hh)) ^ swz) << 4;
            const bf16x8 a0 = *(const LAS bf16x8*)(kb + r * 128 + co);
            const bf16x8 a1 = *(const LAS bf16x8*)(kb + (32 + r) * 128 + co);
            S0 = MFMA32(a0, qf[s], S0); S1 = MFMA32(a1, qf[s], S1);
        }
        float mx = fmaxf(S0[0], S1[0]);
#pragma unroll
        for (int i = 1; i < 16; ++i) mx = fmaxf(mx, fmaxf(S0[i], S1[i]));
        mx = fmaxf(mx, __shfl_xor(mx, 32));
        const float m_new = fmaxf(m_run, mx); const float alpha = ex2(m_run - m_new); m_run = m_new;
        float ls = 0.f;
#pragma unroll
        for (int i = 0; i < 16; ++i) { S0[i] = ex2(S0[i] - m_new); S1[i] = ex2(S1[i] - m_new); ls += S0[i] + S1[i]; }
        l_run = l_run * alpha + ls;
#pragma unroll
        for (int et = 0; et < 4; ++et)
#pragma unroll
            for (int i = 0; i < 16; ++i) O[et][i] *= alpha;
        bf16x8 pf[4];
        { u32x4 w;
          w.x = pk2(S0[0], S0[1]); w.y = pk2(S0[2], S0[3]); w.z = pk2(S0[4], S0[5]); w.w = pk2(S0[6], S0[7]); pf[0] = __builtin_bit_cast(bf16x8, w);
          w.x = pk2(S0[8], S0[9]); w.y = pk2(S0[10], S0[11]); w.z = pk2(S0[12], S0[13]); w.w = pk2(S0[14], S0[15]); pf[1] = __builtin_bit_cast(bf16x8, w);
          w.x = pk2(S1[0], S1[1]); w.y = pk2(S1[2], S1[3]); w.z = pk2(S1[4], S1[5]); w.w = pk2(S1[6], S1[7]); pf[2] = __builtin_bit_cast(bf16x8, w);
          w.x = pk2(S1[8], S1[9]); w.y = pk2(S1[10], S1[11]); w.z = pk2(S1[12], S1[13]); w.w = pk2(S1[14], S1[15]); pf[3] = __builtin_bit_cast(bf16x8, w); }
#pragma unroll
        for (int et = 0; et < 4; ++et)
#pragma unroll
            for (int s = 0; s < 4; ++s) {
                const bf16x8 a = *(const LAS bf16x8*)(vb + (32 * et + r) * 128 + ((((unsigned)(2 * s + hh)) ^ swz) << 4));
                O[et] = MFMA32(a, pf[s], O[et]);
            }
        if (j + 1 < 32) {
            const int sn = ((j + 1) & 1) * 32768;
            *(LAS u32x4*)(lds + sn + kdst0) = kr0; *(LAS u32x4*)(lds + sn + 8192 + kdst0) = kr1; *(LAS u32x4*)(lds + sn + vdst0) = vr0; *(LAS u32x4*)(lds + sn + 8192 + vdst0) = vr1;
        }
        __syncthreads();
    }
    l_run += __shfl_xor(l_run, 32);
    const float inv = 1.f / l_run;
    LAS float* X = (LAS float*)(lds) + sub * 4096;
    if (m == 1) {
#pragma unroll
        for (int et = 0; et < 4; ++et)
#pragma unroll
            for (int i = 0; i < 16; ++i) X[(et * 16 + i) * 64 + lane] = O[et][i] * inv;
    }
    __syncthreads();
    if (m == 0) {
        float ss = 0.f;
#pragma unroll
        for (int et = 0; et < 4; ++et)
#pragma unroll
            for (int i = 0; i < 16; ++i) { const float d = O[et][i] * inv - lam * X[(et * 16 + i) * 64 + lane]; O[et][i] = d; ss += d * d; }
        ss += __shfl_xor(ss, 32);
        const float rinv = rsqrtf(ss * (1.f / 128.f) + 1e-6f) * (1.f - lam_init);
        const size_t tok = tokbase + q0w + r;
#pragma unroll
        for (int et = 0; et < 4; ++et)
#pragma unroll
            for (int g4 = 0; g4 < 4; ++g4) {
                const int e0 = 32 * et + 8 * g4 + 4 * hh;
                const f32x4 sg = *(const f32x4*)(p->da_subg + e_layer * 128 + e0);
                const u32x2 ga = *(const u32x2*)(P + tok * 2560 + 1024 + h * 128 + e0);
                const float v0 = O[et][4 * g4 + 0] * rinv * sg[0] * fsilu(bflo(ga.x)), v1 = O[et][4 * g4 + 1] * rinv * sg[1] * fsilu(bfhi(ga.x));
                const float v2 = O[et][4 * g4 + 2] * rinv * sg[2] * fsilu(bflo(ga.y)), v3 = O[et][4 * g4 + 3] * rinv * sg[3] * fsilu(bfhi(ga.y));
                u32x2 w; w.x = pk2(v0, v1); w.y = pk2(v2, v3);
                *(u32x2*)(mixed + tok * 1024 + h * 128 + e0) = w;
            }
    }
    __syncthreads();
}

__device__ __forceinline__ void lru_unit(KPC p, const Frame& F, int e_layer, int b, int n) {
    const int tid = F.tid, lane = F.lane, wave = F.wave;
    const bf16_t* P = (const bf16_t*)(p->ws + WS_PROJ); bf16_t* mixed = (bf16_t*)(p->ws + WS_MIXED); float* HF = (float*)(p->ws + WS_XG);
    const bf16_t* Wg = (const bf16_t*)(p->ws + WS_WG) + ((size_t)(e_layer * 8 + n)) * 256 * 64;
    LAS unsigned char* lds = F.lds;
    LAS float* XC = (LAS float*)(lds); LAS unsigned char* XA = lds + 17408; LAS f32x2_t* PH = (LAS f32x2_t*)(lds + 25600); LAS float* Cc = (LAS float*)(lds + 33792);
    const size_t tokbase = (size_t)b * 2048;
    const int ca = tid & 63, tq = tid >> 6;
    float cw[4]; { const float* cwp = p->conv_w + (size_t)e_layer * 4 * 512 + n * 64 + ca;
#pragma unroll
        for (int j = 0; j < 4; ++j) cw[j] = cwp[j * 512]; }
    const float cbv = p->conv_b[e_layer * 512 + n * 64 + ca];
    const int mt = wave & 3, jh = wave >> 2, col = lane & 15, kq = lane >> 4;
    const int seg = 4 * mt + kq;
    for (int dir = 0; dir < 2; ++dir) {
        bf16x8 wf[2][2][2];
        float ba[2], bx[2], sp[2];
#pragma unroll
        for (int jj = 0; jj < 2; ++jj) {
            const int ch = 16 * (2 * jh + jj) + col;
#pragma unroll
            for (int gs = 0; gs < 2; ++gs)
#pragma unroll
                for (int ks = 0; ks < 2; ++ks) wf[jj][gs][ks] = *(const bf16x8*)(Wg + (size_t)((2 * dir + gs) * 64 + ch) * 64 + 32 * ks + 8 * kq);
            ba[jj] = p->b_a[(e_layer * 2 + dir) * 512 + n * 64 + ch]; bx[jj] = p->b_x[(e_layer * 2 + dir) * 512 + n * 64 + ch];
            const float y = -p->lru_lam[(e_layer * 2 + dir) * 512 + n * 64 + ch]; sp[jj] = fmaxf(y, 0.f) + log1pf(expf(-fabsf(y)));
        }
        if (tid < 128) Cc[tid] = 0.f;
        for (int cc = 0; cc < 32; ++cc) {
            const int chunk = dir ? 31 - cc : cc; const int t0 = chunk * 64; const int par = cc & 1;
            { float xv[11];
#pragma unroll
              for (int k = 0; k < 11; ++k) { const int tt = t0 + tq * 8 - 2 + k; xv[k] = (tt >= 0 && tt < 2048) ? bf2f(P[(tokbase + tt) * 2560 + 1536 + n * 64 + ca]) : 0.f; }
#pragma unroll
              for (int i = 0; i < 8; ++i) { const int tl = tq * 8 + i; const float v = cbv + cw[0] * xv[i] + cw[1] * xv[i + 1] + cw[2] * xv[i + 2] + cw[3] * xv[i + 3];
                  XC[tl * 68 + ca] = v;
                  *(LAS bf16_t*)(XA + tl * 128 + ((((unsigned)(ca >> 3)) ^ ((unsigned)(tl >> 1) & 7u)) << 4) + (ca & 7) * 2) = (bf16_t)(pk2(v, 0.f) & 0xffffu); } }
            __syncthreads();
            f32x4 acc[2][2];
#pragma unroll
            for (int jj = 0; jj < 2; ++jj)
#pragma unroll
                for (int gs = 0; gs < 2; ++gs) acc[jj][gs] = (f32x4){0.f, 0.f, 0.f, 0.f};
#pragma unroll
            for (int ks = 0; ks < 2; ++ks) {
                const int row = 16 * mt + col;
                const bf16x8 a = *(const LAS bf16x8*)(XA + row * 128 + ((((unsigned)(4 * ks + kq)) ^ ((unsigned)(row >> 1) & 7u)) << 4));
#pragma unroll
                for (int jj = 0; jj < 2; ++jj)
#pragma unroll
                    for (int gs = 0; gs < 2; ++gs) acc[jj][gs] = MFMA16(a, wf[jj][gs][ks], acc[jj][gs]);
            }
            float hl[2][4], Pp[2][4];
#pragma unroll
            for (int jj = 0; jj < 2; ++jj) {
                const int ch = 16 * (2 * jh + jj) + col;
                float av[4], uv[4];
#pragma unroll
                for (int i = 0; i < 4; ++i) {
                    const int tl = 16 * mt + 4 * kq + i;
                    const float ga = fsigm(acc[jj][0][i] + ba[jj]), gx = fsigm(acc[jj][1][i] + bx[jj]);
                    const float log_a = -8.f * ga * sp[jj]; const float a = __expf(log_a); const float y2 = 2.f * log_a;
                    const float om = (y2 > -0.1f) ? -(y2 * (1.f + y2 * (0.5f + y2 * (0.16666667f + y2 * 0.041666668f)))) : 1.f - __expf(y2);
                    av[i] = a; uv[i] = sqrtf(om) * gx * XC[tl * 68 + ch];
                }
                if (!dir) { hl[jj][0] = uv[0]; Pp[jj][0] = av[0];
#pragma unroll
                    for (int i = 1; i < 4; ++i) { hl[jj][i] = av[i] * hl[jj][i - 1] + uv[i]; Pp[jj][i] = av[i] * Pp[jj][i - 1]; }
                    PH[seg * 64 + ch] = (f32x2_t){Pp[jj][3], hl[jj][3]};
                } else { hl[jj][3] = uv[3]; Pp[jj][3] = av[3];
#pragma unroll
                    for (int i = 2; i >= 0; --i) { hl[jj][i] = av[i] * hl[jj][i + 1] + uv[i]; Pp[jj][i] = av[i] * Pp[jj][i + 1]; }
                    PH[seg * 64 + ch] = (f32x2_t){Pp[jj][0], hl[jj][0]};
                }
            }
            __syncthreads();
            const int ord = dir ? 15 - seg : seg;
#pragma unroll
            for (int jj = 0; jj < 2; ++jj) {
                const int ch = 16 * (2 * jh + jj) + col;
                float cin = Cc[par * 64 + ch];
                for (int s = 0; s < ord; ++s) { const int sg = dir ? 15 - s : s; const f32x2_t ph = PH[sg * 64 + ch]; cin = ph.x * cin + ph.y; }
#pragma unroll
                for (int i = 0; i < 4; ++i) hl[jj][i] += Pp[jj][i] * cin;
                if (ord == 15) Cc[(par ^ 1) * 64 + ch] = dir ? hl[jj][0] : hl[jj][3];
#pragma unroll
                for (int i = 0; i < 4; ++i) {
                    const size_t tok = tokbase + t0 + 16 * mt + 4 * kq + i;
                    if (!dir) HF[tok * 512 + n * 64 + ch] = hl[jj][i];
                    else { const float hf = HF[tok * 512 + n * 64 + ch]; const float g = bf2f(P[tok * 2560 + 2048 + n * 64 + ch]);
                        mixed[tok * 1024 + 512 + n * 64 + ch] = (bf16_t)(pk2((hf + hl[jj][i]) * fsilu(g), 0.f) & 0xffffu); }
                }
            }
        }
        asm volatile("s_waitcnt vmcnt(0)" ::: "memory");
        __syncthreads();
    }
}

__device__ __forceinline__ void na_unit(KPC p, const Frame& F, int o_layer, int b, int h, int rp) {
    const int tid = F.tid, lane = F.lane, wave = F.wave;
    const bf16_t* P = (const bf16_t*)(p->ws + WS_PROJ); const bf16_t* VT = (const bf16_t*)(p->ws + WS_VT); bf16_t* mixed = (bf16_t*)(p->ws + WS_MIXED);
    LAS unsigned char* lds = F.lds; LAS unsigned char* KL = lds; LAS unsigned char* VTL = lds + 73728; LAS float* rpbs = (LAS float*)(lds + 148480);
    const size_t tokbase = (size_t)b * 2048;
    const int r0 = 2 * rp; int rb = r0 - 4; rb = rb < 0 ? 0 : (rb > 24 ? 24 : rb);
    const int nrows = (rb + 9 <= 32) ? 9 : 8; const int nchunk = nrows * 64 * 8;
    for (int id = tid; id < nchunk; id += 512) {
        const int key = id >> 3, ch = id & 7;
        *(LAS u32x4*)(KL + key * 128 + ((ch ^ ((key >> 1) & 7)) << 4)) = *(const u32x4*)(P + (tokbase + rb * 64 + key) * 3072 + 1024 + h * 64 + ch * 8);
    }
    { const int cpr = nrows * 8;
      for (int id = tid; id < 64 * cpr; id += 512) { const int e = id / cpr, ch = id % cpr;
          *(LAS u32x4*)(VTL + e * 1168 + ch * 16) = *(const u32x4*)(VT + ((size_t)(b * 1024 + h * 64 + e)) * 2048 + rb * 64 + ch * 8); } }
    if (tid < 465) rpbs[tid] = p->rpb[((size_t)o_layer * 16 + h) * 465 + tid] * LOG2E;
    __syncthreads();
    {
        const int rr = r0 + (wave >> 2), g = wave & 3, c0 = 16 * g, kc0 = (g == 0) ? 0 : (g == 1 ? 8 : (g == 2 ? 24 : 32));
        int rs = rr - 4; rs = rs < 0 ? 0 : (rs > 24 ? 24 : rs); const int li0 = rs - rb;
        const int q = lane & 15, kq = lane >> 4;
        const size_t tok = tokbase + rr * 64 + c0 + q;
        bf16x8 qf[2];
#pragma unroll
        for (int ks = 0; ks < 2; ++ks) qf[ks] = *(const bf16x8*)(P + tok * 3072 + h * 64 + 32 * ks + 8 * kq);
        f32x4 S[8][2];
#pragma unroll
        for (int i = 0; i < 8; ++i)
#pragma unroll
            for (int a = 0; a < 2; ++a) {
                const int keyl = (li0 + i) * 64 + kc0 + 16 * a + q;
                f32x4 acc = (f32x4){0.f, 0.f, 0.f, 0.f};
#pragma unroll
                for (int ks = 0; ks < 2; ++ks) {
                    const bf16x8 A = *(const LAS bf16x8*)(KL + keyl * 128 + ((((unsigned)(4 * ks + kq)) ^ ((unsigned)(keyl >> 1) & 7u)) << 4));
                    acc = MFMA16(A, qf[ks], acc);
                }
                S[i][a] = acc;
            }
        const int c = c0 + q; int cs = c - 8; cs = cs < 0 ? 0 : (cs > 48 ? 48 : cs);
        float mx = -1e30f;
#pragma unroll
        for (int i = 0; i < 8; ++i)
#pragma unroll
            for (int a = 0; a < 2; ++a)
#pragma unroll
                for (int j = 0; j < 4; ++j) {
                    const int kc = kc0 + 16 * a + 4 * kq + j; const bool valid = (kc >= cs) && (kc < cs + 16);
                    int dc = kc - c + 15; dc = dc < 0 ? 0 : (dc > 30 ? 30 : dc);
                    const float bias = rpbs[(rs + i - rr + 7) * 31 + dc];
                    const float s = valid ? S[i][a][j] + bias : -1e30f;
                    S[i][a][j] = s; mx = fmaxf(mx, s);
                }
        mx = fmaxf(mx, __shfl_xor(mx, 16)); mx = fmaxf(mx, __shfl_xor(mx, 32));
        float l = 0.f;
#pragma unroll
        for (int i = 0; i < 8; ++i)
#pragma unroll
            for (int a = 0; a < 2; ++a)
#pragma unroll
                for (int j = 0; j < 4; ++j) { const float e = ex2(S[i][a][j] - mx); S[i][a][j] = e; l += e; }
        l += __shfl_xor(l, 16); l += __shfl_xor(l, 32);
        f32x4 O[4];
#pragma unroll
        for (int et = 0; et < 4; ++et) O[et] = (f32x4){0.f, 0.f, 0.f, 0.f};
#pragma unroll
        for (int i = 0; i < 8; ++i) {
            u32x4 w; w.x = pk2(S[i][0][0], S[i][0][1]); w.y = pk2(S[i][0][2], S[i][0][3]); w.z = pk2(S[i][1][0], S[i][1][1]); w.w = pk2(S[i][1][2], S[i][1][3]);
            const bf16x8 pf = __builtin_bit_cast(bf16x8, w);
#pragma unroll
            for (int et = 0; et < 4; ++et) {
                const LAS unsigned char* vp = VTL + (16 * et + q) * 1168 + ((li0 + i) * 64 + kc0 + 4 * kq) * 2;
                const u32x2 lo = *(const LAS u32x2*)(vp), hi = *(const LAS u32x2*)(vp + 32);
                u32x4 av; av.x = lo.x; av.y = lo.y; av.z = hi.x; av.w = hi.y;
                O[et] = MFMA16(__builtin_bit_cast(bf16x8, av), pf, O[et]);
            }
        }
        const float inv = 1.f / l;
#pragma unroll
        for (int et = 0; et < 4; ++et) {
            const int e0 = 16 * et + 4 * kq;
            const u32x2 ga = *(const u32x2*)(P + tok * 3072 + 2048 + h * 64 + e0);
            u32x2 w; w.x = pk2(O[et][0] * inv * fsilu(bflo(ga.x)), O[et][1] * inv * fsilu(bfhi(ga.x))); w.y = pk2(O[et][2] * inv * fsilu(bflo(ga.y)), O[et][3] * inv * fsilu(bfhi(ga.y)));
            *(u32x2*)(mixed + tok * 1024 + h * 64 + e0) = w;
        }
    }
    __syncthreads();
}
constexpr int N_PHASES = 15;
__device__ __forceinline__ void run_phase(KPC p, const Frame& F, int ph) {
    unsigned char* ws = p->ws;
    if (ph == 0) { phase_p0a(p, F); return; }
    if (ph == 1) { phase_p0b(p, F); return; }
    if (ph == 14) { phase_final(p, F); return; }
    const int l = (ph - 2) / 3, k = (ph - 2) % 3, odd = l & 1, ei = l >> 1;
    bf16_t* xg = (bf16_t*)(ws + WS_XG); bf16_t* mixed = (bf16_t*)(ws + WS_MIXED); bf16_t* proj = (bf16_t*)(ws + WS_PROJ); bf16_t* VT = (bf16_t*)(ws + WS_VT);
    float* ssq = (float*)(ws + WS_SSQ); const float* sW = (const float*)(ws + WS_SW) + (size_t)l * 16 * 4096; const float* mod = (const float*)(ws + WS_MOD);
    if (k == 0) {
        const int N1 = odd ? 3072 : 2560, NV = odd ? 1024 : 512;
        const bf16_t* Wt = odd ? (const bf16_t*)(ws + WS_WTO) + (size_t)ei * 4096 * 1024 : (const bf16_t*)(ws + WS_WTE) + (size_t)ei * 3072 * 1024;
        { pg8::Gemm g{xg, Wt, MTOK, N1, 1024}; pg8::StaticOrder S; S.init(MTOK, N1, F.G, F.bx);
          EpiProj E{proj, N1, ssq, sW, odd ? 1024 : 512};
          pg8::gemm_phase<EpiProj, pg8::StaticOrder, true, true>(F.lds, g, S, E, F.tid); }
        { pg8::Gemm g{Wt + (size_t)N1 * 1024, xg, NV, MTOK, 1024}; pg8::StaticOrder S; S.init(NV, MTOK, F.G, F.bx);
          EpiProjT E{VT, NV, ssq, sW + N1, odd ? 0 : 1};
          pg8::gemm_phase<EpiProjT, pg8::StaticOrder, true, true>(F.lds, g, S, E, F.tid); }
    } else if (k == 1) {
        if (!odd) {
            const float* scal = (const float*)(ws + WS_SCAL); const float lam = scal[ei * 4 + 0], lam_init = scal[ei * 4 + 1];
            for (int u = F.vcu; u < 1152; u += F.G) {
                Frame Fu = F; asm volatile("" : "+v"(Fu.tid)); Fu.lane = Fu.tid & 63;
                if (u < 128) lru_unit(p, Fu, ei, u >> 3, u & 7);
                else { const int a = u - 128, bh = a >> 4; attn_unit(p, Fu, ei, bh >> 2, bh & 3, a & 15, lam, lam_init); }
            }
        } else {
            for (int u = F.vcu; u < 4096; u += F.G) { Frame Fu = F; asm volatile("" : "+v"(Fu.tid)); Fu.lane = Fu.tid & 63;
                const int bh = u >> 4; na_unit(p, Fu, ei, bh >> 4, bh & 15, u & 15); }
        }
    } else {
        pg8::Gemm g{mixed, (const bf16_t*)(ws + WS_WTOUT) + (size_t)l * 1024 * 1024, MTOK, 1024, 1024}; pg8::StaticOrder S; S.init(MTOK, 1024, F.G, F.bx);
        EpiOut E{l == 0 ? p->x : p->out, p->out, xg, ssq, mod + (size_t)l * 16 * 3072 + 2048, p->norm_g + (l < 3 ? (l + 1) * 1024 : 0), mod + (size_t)(l < 3 ? l + 1 : 0) * 16 * 3072 + 1024, l < 3 ? 1 : 0};
        pg8::gemm_phase<EpiOut, pg8::StaticOrder, true, true>(F.lds, g, S, E, F.tid);
    }
}

__global__ void __launch_bounds__(512, 2) mega(KP p) {
    extern __shared__ __attribute__((aligned(16))) unsigned char lds_raw[];
    for (int ph = p.ph_lo; ph < p.ph_hi; ++ph) {
        if (ph > p.ph_lo) cooperative_groups::this_grid().sync();
        KPC pp = (KPC)__builtin_amdgcn_kernarg_segment_ptr(); asm volatile("" : "+s"(pp));
        int tid = threadIdx.x; asm volatile("" : "+v"(tid));
        int bx = blockIdx.x; asm volatile("" : "+s"(bx));
        Frame F; F.lds = (LAS unsigned char*)lds_raw; F.tid = tid; F.lane = tid & 63; F.wave = __builtin_amdgcn_readfirstlane(tid >> 6);
        F.G = gridDim.x; F.bx = bx; F.vcu = (F.G % 8 == 0) ? (bx % 8) * (F.G / 8) + bx / 8 : bx;
        run_phase(pp, F, ph);
    }
}

#ifndef MK_PER_PHASE
#define MK_PER_PHASE 0
#endif
#ifndef MK_DBG
#define MK_DBG 0
#endif
#if MK_DBG
#endif

static void fill_kp(KP& p, void* const* d_in, void* d_out, void* d_ws) {
    const float** f = (const float**)&p;
    for (int i = 0; i < 21; ++i) f[i] = (const float*)d_in[i];
    p.out = (float*)d_out; p.ws = (unsigned char*)d_ws;
}

extern "C" void kernel_launch(void* const* d_in, const int* in_sizes, int n_in, void* d_out, int out_size, void* d_ws, size_t ws_size, hipStream_t stream) {
    static int grid = 0;
    if (grid == 0) {
        int dev = 0, cus = 0, per_cu = 0;
        if (n_in != 21 || out_size != MTOK * DM || ws_size < WS_END) { fprintf(stderr, "kernel_launch: unexpected shapes (n_in %d out %d ws %zu)\n", n_in, out_size, ws_size); grid = -1; return; }
        (void)hipGetDevice(&dev); (void)hipDeviceGetAttribute(&cus, hipDeviceAttributeMultiprocessorCount, dev);
        if (hipFuncSetAttribute((const void*)mega, hipFuncAttributeMaxDynamicSharedMemorySize, LDS_BYTES) != hipSuccess) { fprintf(stderr, "kernel_launch: hipFuncSetAttribute failed\n"); grid = -1; return; }
        if (hipOccupancyMaxActiveBlocksPerMultiprocessor(&per_cu, (const void*)mega, 512, LDS_BYTES) != hipSuccess || per_cu < 1) { fprintf(stderr, "kernel_launch: occupancy query says %d\n", per_cu); per_cu = 1; }
        (void)hipGetLastError();
        grid = cus * 1;
        if (grid % 8 != 0 || grid < 8) grid = 256;
    }
    if (grid < 0) return;
    KP p{}; fill_kp(p, d_in, d_out, d_ws);
#if MK_DBG
    dbg_forward(p, grid, stream);
#elif MK_PER_PHASE
    for (int ph = 0; ph < N_PHASES; ++ph) { p.ph_lo = ph; p.ph_hi = ph + 1; hipLaunchKernelGGL(mega, dim3(grid), dim3(512), LDS_BYTES, stream, p); }
#else
    p.ph_lo = 0; p.ph_hi = N_PHASES;
    void* args[] = {&p};
    hipError_t e = hipLaunchCooperativeKernel((const void*)mega, dim3(grid), dim3(512), args, LDS_BYTES, stream);
    if (e != hipSuccess) fprintf(stderr, "cooperative launch failed: %s (grid %d)\n", hipGetErrorString(e), grid);
#endif
}
```

```cpp
#include <hip/hip_runtime.h>
#include <hip/hip_cooperative_groups.h>
#include <cstdio>
#include <cstdint>
#include <cmath>

#define LAS __attribute__((address_space(3)))
typedef unsigned short bf16_t;
typedef short bf16x8 __attribute__((ext_vector_type(8)));
typedef float f32x4 __attribute__((ext_vector_type(4)));
typedef float f32x16 __attribute__((ext_vector_type(16)));
typedef unsigned u32x4 __attribute__((ext_vector_type(4)));
typedef unsigned u32x2 __attribute__((ext_vector_type(2)));
typedef float f32x2_t __attribute__((ext_vector_type(2)));
typedef __bf16 bf16x2_t __attribute__((ext_vector_type(2)));

__device__ __forceinline__ unsigned pk2(float lo, float hi) { f32x2_t v = {lo, hi}; bf16x2_t b = __builtin_convertvector(v, bf16x2_t); return __builtin_bit_cast(unsigned, b); }
__device__ __forceinline__ float bflo(unsigned w) { return __uint_as_float(w << 16); }
__device__ __forceinline__ float bfhi(unsigned w) { return __uint_as_float(w & 0xffff0000u); }
__device__ __forceinline__ float bf2f(bf16_t h) { return __uint_as_float((unsigned)h << 16); }
__device__ __forceinline__ float fsilu(float v) { return v / (1.f + __expf(-v)); }
__device__ __forceinline__ float fsigm(float v) { return 1.f / (1.f + __expf(-v)); }
__device__ __forceinline__ float ex2(float v) { return __builtin_amdgcn_exp2f(v); }
__device__ __forceinline__ float wave_sum(float v) {
#pragma unroll
    for (int o = 1; o < 64; o <<= 1) v += __shfl_xor(v, o);
    return v;
}
__device__ __forceinline__ int t5_bucket(int rel) {
    const int n = rel < 0 ? -rel : rel; const int ret = rel > 0 ? 16 : 0;
    int v; if (n < 8) v = n; else { v = 33 - __clz(n * n); if (v > 15) v = 15; }
    return ret + v;
}
#define LDS_WAIT() asm volatile("s_waitcnt lgkmcnt(0)" ::: "memory")
constexpr float LOG2E = 1.4426950408889634f;
constexpr float QSCALE = 0.125f * 1.4426950408889634f;

constexpr int DM = 1024, SEQ = 2048, NBATCH = 16, MTOK = NBATCH * SEQ;
constexpr size_t MiB = 1u << 20;
constexpr size_t WS_CTL = 0, WS_MOD = 1 * MiB, WS_SW = 2 * MiB, WS_SSQ = 3 * MiB, WS_SCAL = 5 * MiB, WS_WG = 5 * MiB + 65536;
constexpr size_t WS_WTE = 6 * MiB, WS_WTO = 18 * MiB, WS_WTOUT = 34 * MiB;
constexpr size_t WS_XG = 48 * MiB, WS_MIXED = 112 * MiB, WS_PROJ = 176 * MiB, WS_VT = 368 * MiB, WS_END = 432 * MiB;
constexpr int LDS_BYTES = 163840;
constexpr int LDS_SPARE = 131072;

struct KP {
    const float *x, *c, *ada_w, *ada_b, *norm_g, *final_g, *t5, *even_w_in, *even_w_out, *da_lam, *da_subg, *conv_w, *conv_b, *w_a, *b_a, *w_x, *b_x, *lru_lam, *odd_w_in, *odd_w_out, *rpb;
    float* out; unsigned char* ws; int ph_lo, ph_hi;
};
typedef const __attribute__((address_space(4))) KP* KPC;
struct Frame { LAS unsigned char* lds; int tid, lane, wave, vcu, G, bx; };

namespace pg8 {
constexpr int BM = 256, BK = 64, HALF = 128, HTB = HALF * BK * 2, STAGE_BYTES = 8 * HTB, NXCD = 8, WGM = 8;
__host__ __device__ __forceinline__ int lds_byte(int r, int c) { const int st = (r >> 4) * 2 + (c >> 5), rr = r & 15, cc = c & 31, ob = rr * 64 + cc * 2; return st * 1024 + (ob ^ (((ob >> 9) & 1) << 5)); }
__host__ __device__ __forceinline__ void stage_rc(int b, int& R, int& C) { const int st = b / 1024, sb = b % 1024, swz = sb ^ (((sb >> 9) & 1) << 5); R = (st >> 1) * 16 + swz / 64; C = (st & 1) * 32 + (swz % 64) / 2; }
__host__ __device__ __forceinline__ int perm32(int rho) { const int n = rho >> 4, i = rho & 15; return 8 * (i >> 2) + 4 * n + (i & 3); }
struct Unit { int pm, pn; };
struct Gemm { const bf16_t* A; const bf16_t* Bt; int M, N, K; };
struct StaticOrder {
    int nM, nN, nwg, G, c;
    __host__ __device__ void init(int M, int N, int G_, int c_) { nM = M / BM; nN = N / BM; nwg = nM * nN; G = G_; c = c_; }
    __host__ __device__ bool next(int i, Unit& u) const {
        const long L = (long)i * G + c; if (L >= nwg) return false;
        int wgid = (int)L; { const int q = nwg / NXCD, r = nwg % NXCD, xcd = wgid % NXCD, off = wgid / NXCD; wgid = (xcd < r ? xcd * (q + 1) : r * (q + 1) + (xcd - r) * q) + off; }
        const int nig = WGM * nN, gid = wgid / nig, fm = gid * WGM, gsz = (nM - fm) < WGM ? (nM - fm) : WGM;
        u.pm = fm + ((wgid % nig) % gsz); u.pn = (wgid % nig) / gsz; return true;
    }
};

template <class Epi, class Sched, bool ALIGN_EPI = false, bool SP2 = false>
__device__ __forceinline__ void gemm_phase(LAS unsigned char* lds, const Gemm g, const Sched& S, const Epi& E, const int tid) {
    const int wid = __builtin_amdgcn_readfirstlane(tid >> 6), lane = tid & 63, wr = wid >> 2, wc = wid & 3, fr = lane & 15, fq = lane >> 4;
    const int K = g.K, nt = K / BK;
    unsigned voffA[2], voffB[2];
#pragma unroll
    for (int i = 0; i < 2; ++i) { int R, C; stage_rc(tid * 16 + i * 8192, R, C); const int Rb = Epi::PERM ? ((R & ~31) + perm32(R & 31)) : R;
        voffA[i] = (unsigned)(R * K + C) * 2u; voffB[i] = (unsigned)(Rb * K + C) * 2u; }
    const size_t kstep = (size_t)(BK * 2);
    const size_t hstep = (size_t)HALF * K * 2;
    const size_t tstep = 2 * hstep;
    const unsigned ldsw = (unsigned)wid * 1024u;
    const int aoff = lds_byte(wr * 64 + fr, fq * 8), boff = lds_byte(wc * 32 + fr, fq * 8);
#define PG8_SA(b, h) (((b) * 2 + (h)) * HTB)
#define PG8_SB(b, h) ((4 + (b) * 2 + (h)) * HTB)
#define PG8_STAGE(bufoff, gbase, voff) do { _Pragma("unroll") for (int _i = 0; _i < 2; ++_i) \
        __builtin_amdgcn_global_load_lds((const unsigned*)((const char*)(gbase) + (voff)[_i]), (LAS unsigned*)(lds + (bufoff) + ldsw + _i * 8192), 16, 0, 0); } while (0)
#define PG8_LDA(dst, b, h) do { _Pragma("unroll") for (int m = 0; m < 4; ++m) _Pragma("unroll") for (int k = 0; k < 2; ++k) dst[m][k] = *(const LAS bf16x8*)(lds + PG8_SA(b, h) + aoff + m * 2048 + k * 1024); } while (0)
#define PG8_LDB(dst, b, h) do { _Pragma("unroll") for (int n = 0; n < 2; ++n) _Pragma("unroll") for (int k = 0; k < 2; ++k) dst[n][k] = *(const LAS bf16x8*)(lds + PG8_SB(b, h) + boff + n * 2048 + k * 1024); } while (0)
#define PG8_MMA(ai, bj, At, Bt) do { __builtin_amdgcn_s_setprio(1); _Pragma("unroll") for (int m = 0; m < 4; ++m) _Pragma("unroll") for (int n = 0; n < 2; ++n) _Pragma("unroll") for (int k = 0; k < 2; ++k) \
        acc[ai][bj][m][n] = __builtin_amdgcn_mfma_f32_16x16x32_bf16(Bt[n][k], At[m][k], acc[ai][bj][m][n], 0, 0, 0); __builtin_amdgcn_s_setprio(0); } while (0)
#define PG8_WAIT_V(n) asm volatile("s_waitcnt vmcnt(" #n ")" ::: "memory")
#define PG8_WAIT_L(n) asm volatile("s_waitcnt lgkmcnt(" #n ")" ::: "memory")
#define PG8_BAR __builtin_amdgcn_s_barrier()
#define PG8_SCHED __builtin_amdgcn_sched_barrier(0)
    Unit cur, nxt; int ui = 0;
    if (!S.next(0, cur)) return;
    f32x4 acc[2][2][4][2];
#pragma unroll
    for (int a = 0; a < 2; ++a)
#pragma unroll
        for (int b = 0; b < 2; ++b)
#pragma unroll
            for (int m = 0; m < 4; ++m)
#pragma unroll
                for (int n = 0; n < 2; ++n) acc[a][b][m][n] = (f32x4){0.f, 0.f, 0.f, 0.f};
    bf16x8 At[4][2], B0[2][2], B1[2][2];
    const char* cA = (const char*)g.A + (size_t)cur.pm * tstep; const char* cB = (const char*)g.Bt + (size_t)cur.pn * tstep;
    if constexpr (SP2) {
        PG8_STAGE(PG8_SB(0, 0), cB, voffB); PG8_STAGE(PG8_SB(0, 1), cB + hstep, voffB); PG8_STAGE(PG8_SA(0, 0), cA, voffA); PG8_STAGE(PG8_SA(0, 1), cA + hstep, voffA);
        if (wr == 1) PG8_BAR;
        PG8_WAIT_V(2); PG8_BAR;
        PG8_STAGE(PG8_SB(1, 0), cB + kstep, voffB); PG8_STAGE(PG8_SA(1, 0), cA + kstep, voffA); PG8_STAGE(PG8_SB(1, 1), cB + hstep + kstep, voffB);
        PG8_WAIT_V(6); PG8_BAR;
    } else {
        PG8_STAGE(PG8_SB(0, 0), cB, voffB); PG8_STAGE(PG8_SA(0, 0), cA, voffA); PG8_STAGE(PG8_SB(0, 1), cB + hstep, voffB); PG8_STAGE(PG8_SA(0, 1), cA + hstep, voffA);
        if (wr == 1) PG8_BAR;
        PG8_WAIT_V(4); PG8_BAR;
        PG8_STAGE(PG8_SB(1, 0), cB + kstep, voffB); PG8_STAGE(PG8_SA(1, 0), cA + kstep, voffA); PG8_STAGE(PG8_SB(1, 1), cB + hstep + kstep, voffB);
        PG8_WAIT_V(6); PG8_BAR;
    }
    for (;;) {
        const bool has_next = S.next(ui + 1, nxt);
        const char* nA = has_next ? (const char*)g.A + (size_t)nxt.pm * tstep : cA; const char* nB = has_next ? (const char*)g.Bt + (size_t)nxt.pn * tstep : cB;
        for (int t = 0; t < nt; t += 2) {
            const bool last = (t == nt - 2);
            const char* a1 = cA + (size_t)(t + 1) * kstep;
            const char* a2 = last ? nA : cA + (size_t)(t + 2) * kstep; const char* b2 = last ? nB : cB + (size_t)(t + 2) * kstep;
            const char* a3 = a2 + kstep; const char* b3 = b2 + kstep;
            if constexpr (SP2) {
            PG8_LDB(B0, 0, 0); PG8_LDB(B1, 0, 1); PG8_SCHED; PG8_LDA(At, 0, 0); PG8_STAGE(PG8_SA(1, 1), a1 + hstep, voffA);
            PG8_WAIT_V(8); PG8_WAIT_L(0); PG8_BAR; PG8_MMA(0, 0, At, B0); PG8_MMA(0, 1, At, B1); PG8_BAR; PG8_SCHED;
            PG8_LDA(At, 0, 1); PG8_STAGE(PG8_SB(0, 0), b2, voffB); PG8_STAGE(PG8_SB(0, 1), b2 + hstep, voffB); PG8_STAGE(PG8_SA(0, 0), a2, voffA);
            PG8_WAIT_V(8); PG8_WAIT_L(0); PG8_BAR; PG8_MMA(1, 0, At, B0); PG8_MMA(1, 1, At, B1); PG8_BAR; PG8_SCHED;
            PG8_LDB(B0, 1, 0); PG8_LDB(B1, 1, 1); PG8_SCHED; PG8_LDA(At, 1, 0); PG8_STAGE(PG8_SA(0, 1), a2 + hstep, voffA);
            PG8_WAIT_V(8); PG8_WAIT_L(0); PG8_BAR; PG8_MMA(0, 0, At, B0); PG8_MMA(0, 1, At, B1); PG8_BAR; PG8_SCHED;
            PG8_LDA(At, 1, 1); PG8_STAGE(PG8_SB(1, 0), b3, voffB); PG8_STAGE(PG8_SB(1, 1), b3 + hstep, voffB); PG8_STAGE(PG8_SA(1, 0), a3, voffA);
            PG8_WAIT_V(8); PG8_WAIT_L(0); PG8_BAR; PG8_MMA(1, 0, At, B0); PG8_MMA(1, 1, At, B1); PG8_BAR; PG8_SCHED;
            } else {
            PG8_LDB(B0, 0, 0); PG8_SCHED; PG8_LDA(At, 0, 0); PG8_STAGE(PG8_SA(1, 1), a1 + hstep, voffA);
            PG8_WAIT_L(8); PG8_BAR; PG8_WAIT_L(0); PG8_MMA(0, 0, At, B0); PG8_BAR; PG8_SCHED;
            PG8_LDB(B1, 0, 1); PG8_STAGE(PG8_SB(0, 0), b2, voffB);
            PG8_BAR; PG8_WAIT_L(0); PG8_MMA(0, 1, At, B1); PG8_BAR;
            PG8_LDA(At, 0, 1); PG8_STAGE(PG8_SA(0, 0), a2, voffA);
            PG8_BAR; PG8_WAIT_L(0); PG8_MMA(1, 0, At, B0); PG8_BAR; PG8_SCHED;
            PG8_STAGE(PG8_SB(0, 1), b2 + hstep, voffB);
            PG8_WAIT_V(6); PG8_BAR; PG8_MMA(1, 1, At, B1); PG8_BAR;
            PG8_LDB(B0, 1, 0); PG8_SCHED; PG8_LDA(At, 1, 0); PG8_STAGE(PG8_SA(0, 1), a2 + hstep, voffA);
            PG8_WAIT_L(8); PG8_BAR; PG8_WAIT_L(0); PG8_MMA(0, 0, At, B0); PG8_BAR; PG8_SCHED;
            PG8_LDB(B1, 1, 1); PG8_STAGE(PG8_SB(1, 0), b3, voffB);
            PG8_BAR; PG8_WAIT_L(0); PG8_MMA(0, 1, At, B1); PG8_BAR;
            PG8_LDA(At, 1, 1); PG8_STAGE(PG8_SA(1, 0), a3, voffA);
            PG8_BAR; PG8_WAIT_L(0); PG8_MMA(1, 0, At, B0); PG8_BAR; PG8_SCHED;
            PG8_STAGE(PG8_SB(1, 1), b3 + hstep, voffB);
            PG8_WAIT_V(6); PG8_BAR; PG8_MMA(1, 1, At, B1); PG8_BAR;
            }
        }
        if constexpr (ALIGN_EPI) { if (wr == 0) PG8_BAR; }
        E(acc, cur, wr, wc, fr, fq);
        if (!has_next) break;
#pragma unroll
        for (int a = 0; a < 2; ++a)
#pragma unroll
            for (int b = 0; b < 2; ++b)
#pragma unroll
                for (int m = 0; m < 4; ++m)
#pragma unroll
                    for (int n = 0; n < 2; ++n) acc[a][b][m][n] = (f32x4){0.f, 0.f, 0.f, 0.f};
        cur = nxt; cA = nA; cB = nB; ++ui;
        if constexpr (ALIGN_EPI) { if (wr == 1) PG8_BAR; }
    }
    PG8_WAIT_V(0);
    if constexpr (!ALIGN_EPI) { if (wr == 0) PG8_BAR; }
    PG8_BAR;
#undef PG8_SA
#undef PG8_SB
#undef PG8_STAGE
#undef PG8_LDA
#undef PG8_LDB
#undef PG8_MMA
#undef PG8_WAIT_V
#undef PG8_WAIT_L
#undef PG8_BAR
#undef PG8_SCHED
}
}
__device__ __forceinline__ float ssq_rinv(const float* ssq, int row) {
    const f32x4* sp = (const f32x4*)(ssq + (size_t)row * 16);
    const f32x4 a = sp[0], b = sp[1], c = sp[2], d = sp[3];
    const float s = ((a[0] + a[1]) + (a[2] + a[3])) + ((b[0] + b[1]) + (b[2] + b[3])) + ((c[0] + c[1]) + (c[2] + c[3])) + ((d[0] + d[1]) + (d[2] + d[3]));
    return rsqrtf(s * (1.f / 1024.f) + 1e-6f);
}
struct EpiProj {
    static constexpr bool PERM = true;
    bf16_t* O; int ldc; const float* ssq; const float* sW; int qcols;
    __device__ __forceinline__ void operator()(const f32x4 (&acc)[2][2][4][2], const pg8::Unit& u, int wr, int wc, int fr, int fq) const {
        const int row0 = u.pm * 256 + wr * 64 + fr, colb = u.pn * 256 + wc * 32 + 8 * fq, b = (u.pm * 256) >> 11;
        const float* sWb = sW + (size_t)b * 4096;
        f32x4 bv[2][2];
#pragma unroll
        for (int bj = 0; bj < 2; ++bj)
#pragma unroll
            for (int n = 0; n < 2; ++n) bv[bj][n] = *(const f32x4*)(sWb + colb + bj * 128 + 4 * n);
#pragma unroll
        for (int ai = 0; ai < 2; ++ai)
#pragma unroll
            for (int m = 0; m < 4; ++m) {
                const int row = row0 + ai * 128 + m * 16; const float rt = ssq_rinv(ssq, row);
                bf16_t* rowp = O + (size_t)row * ldc + colb;
#pragma unroll
                for (int bj = 0; bj < 2; ++bj) {
                    const float sc = (u.pn * 256 + bj * 128 < qcols) ? QSCALE : 1.f;
                    const f32x4 v0 = (acc[ai][bj][m][0] * rt + bv[bj][0]) * sc, v1 = (acc[ai][bj][m][1] * rt + bv[bj][1]) * sc;
                    u32x4 w; w.x = pk2(v0[0], v0[1]); w.y = pk2(v0[2], v0[3]); w.z = pk2(v1[0], v1[1]); w.w = pk2(v1[2], v1[3]);
                    *(u32x4*)(rowp + bj * 128) = w;
                }
            }
    }
};
struct EpiProjT {
    static constexpr bool PERM = true;
    bf16_t* VT; int NV; const float* ssq; const float* sW;   int swap23;
    __device__ __forceinline__ void operator()(const f32x4 (&acc)[2][2][4][2], const pg8::Unit& u, int wr, int wc, int fr, int fq) const {
        const int tok0 = u.pn * 256, b = tok0 >> 11, t0 = tok0 & 2047;
        const int vrow0 = u.pm * 256 + wr * 64 + fr;
        const float* sWb = sW + (size_t)b * 4096;
        bf16_t* base = VT + (size_t)b * NV * 2048 + t0;
#pragma unroll
        for (int bj = 0; bj < 2; ++bj) {
            float rt[2][4];
#pragma unroll
            for (int n = 0; n < 2; ++n)
#pragma unroll
                for (int i = 0; i < 4; ++i) rt[n][i] = ssq_rinv(ssq, tok0 + bj * 128 + wc * 32 + 8 * fq + 4 * n + i);
            const int cl = bj * 128 + wc * 32;
#pragma unroll
            for (int ai = 0; ai < 2; ++ai)
#pragma unroll
                for (int m = 0; m < 4; ++m) {
                    const int vrow = vrow0 + ai * 128 + m * 16; const float bias = sWb[vrow];
                    bf16_t* rowp = base + (size_t)vrow * 2048 + cl;
                    const f32x4 a0 = acc[ai][bj][m][0], a1 = acc[ai][bj][m][1];
                    u32x2 w0, w1;
                    w0.x = pk2(a0[0] * rt[0][0] + bias, a0[1] * rt[0][1] + bias); w0.y = pk2(a0[2] * rt[0][2] + bias, a0[3] * rt[0][3] + bias);
                    w1.x = pk2(a1[0] * rt[1][0] + bias, a1[1] * rt[1][1] + bias); w1.y = pk2(a1[2] * rt[1][2] + bias, a1[3] * rt[1][3] + bias);
                    if (swap23) {
                        *(u32x2*)(rowp + 16 * (fq >> 1) + 4 * (fq & 1)) = w0;
                        *(u32x2*)(rowp + 16 * (fq >> 1) + 8 + 4 * (fq & 1)) = w1;
                    } else {
                        u32x4 w; w.x = w0.x; w.y = w0.y; w.z = w1.x; w.w = w1.y; *(u32x4*)(rowp + 8 * fq) = w;
                    }
                }
        }
    }
};
struct EpiOut {
    static constexpr bool PERM = true;
    const float* xin; float* xout; bf16_t* xg; float* ssq; const float* gate;   const float* gnext; const float* scnext;   int has_next;
    __device__ __forceinline__ void operator()(const f32x4 (&acc)[2][2][4][2], const pg8::Unit& u, int wr, int wc, int fr, int fq) const {
        const int row0 = u.pm * 256 + wr * 64 + fr, colb = u.pn * 256 + wc * 32 + 8 * fq, b = (u.pm * 256) >> 11;
        f32x4 gv[2][2], Gn[2][2];
#pragma unroll
        for (int bj = 0; bj < 2; ++bj)
#pragma unroll
            for (int n = 0; n < 2; ++n) {
                const int col = colb + bj * 128 + 4 * n;
                gv[bj][n] = *(const f32x4*)(gate + (size_t)b * 3072 + col);
                if (has_next) { const f32x4 g = *(const f32x4*)(gnext + col), s = *(const f32x4*)(scnext + (size_t)b * 3072 + col); Gn[bj][n] = g * (s + 1.f); }
                else Gn[bj][n] = (f32x4){0.f, 0.f, 0.f, 0.f};
            }
#pragma unroll
        for (int ai = 0; ai < 2; ++ai)
#pragma unroll
            for (int m = 0; m < 4; ++m) {
                const int row = row0 + ai * 128 + m * 16; float ps = 0.f;
#pragma unroll
                for (int bj = 0; bj < 2; ++bj) {
                    const size_t off = (size_t)row * 1024 + colb + bj * 128;
                    const f32x4 x0 = *(const f32x4*)(xin + off), x1 = *(const f32x4*)(xin + off + 4);
                    const f32x4 y0 = x0 + gv[bj][0] * acc[ai][bj][m][0], y1 = x1 + gv[bj][1] * acc[ai][bj][m][1];
                    *(f32x4*)(xout + off) = y0; *(f32x4*)(xout + off + 4) = y1;
                    ps += (y0[0] * y0[0] + y0[1] * y0[1]) + (y0[2] * y0[2] + y0[3] * y0[3]) + (y1[0] * y1[0] + y1[1] * y1[1]) + (y1[2] * y1[2] + y1[3] * y1[3]);
                    if (has_next) { const f32x4 z0 = y0 * Gn[bj][0], z1 = y1 * Gn[bj][1];
                        u32x4 w; w.x = pk2(z0[0], z0[1]); w.y = pk2(z0[2], z0[3]); w.z = pk2(z1[0], z1[1]); w.w = pk2(z1[2], z1[3]); *(u32x4*)(xg + off) = w; }
                }
                ps += __shfl_xor(ps, 16); ps += __shfl_xor(ps, 32);
                if (fq == 0) ssq[(size_t)row * 16 + u.pn * 4 + wc] = ps;
            }
    }
};

__device__ __forceinline__ int remap_col(int n, int mode) {
    if (mode == 1) return n < 1024 ? n : (n < 1536 ? n + 1536 : n - 512);
    if (mode == 2) return n < 2048 ? n : (n < 3072 ? n + 1024 : n - 1024);
    return n;
}
__device__ __forceinline__ int unmap_col(int c, int odd) {
    if (!odd) return c < 1024 ? c : (c < 2560 ? c + 512 : c - 1536);
    return c < 2048 ? c : (c < 3072 ? c + 1024 : c - 1024);
}
__device__ __forceinline__ void p0_transpose_item(const float* W, int K, int N, bf16_t* WT, int item, LAS float* scr, int lane, int mode) {
    const int nblk = N / 32, kb = item / nblk, nb = item % nblk, k0 = 64 * kb, n0 = 32 * nb;
#pragma unroll 8
    for (int i = 0; i < 32; ++i) { const int kk = 2 * i + (lane >> 5); scr[kk * 33 + (lane & 31)] = W[(size_t)(k0 + kk) * N + n0 + (lane & 31)]; }
    LDS_WAIT(); asm volatile("" ::: "memory");
    const int c = lane & 7;
#pragma unroll
    for (int j = 0; j < 4; ++j) { const int n = (lane >> 3) + 8 * j; const LAS float* s = scr + (8 * c) * 33 + n;
        u32x4 o; o.x = pk2(s[0 * 33], s[1 * 33]); o.y = pk2(s[2 * 33], s[3 * 33]); o.z = pk2(s[4 * 33], s[5 * 33]); o.w = pk2(s[6 * 33], s[7 * 33]);
        *(u32x4*)(WT + (size_t)remap_col(n0 + n, mode) * K + k0 + 8 * c) = o; }
    LDS_WAIT(); asm volatile("" ::: "memory");
}
__device__ __forceinline__ void gemv16_item(const LAS float* vec, const float* W, int ldw, int col0, float* out, int out_ld, int ocol0, const float* bias, int lane) {
    const int n = lane & 15, kq = lane >> 4;
    float acc[16];
#pragma unroll
    for (int b = 0; b < 16; ++b) acc[b] = 0.f;
    const float* wp = W + (size_t)(kq * 256) * ldw + col0 + n; const LAS float* vp = vec + kq * 256;
#pragma unroll 4
    for (int i = 0; i < 256; ++i) {
        const float w = wp[(size_t)i * ldw];
#pragma unroll
        for (int b = 0; b < 16; ++b) acc[b] += vp[b * 1024 + i] * w;
    }
#pragma unroll
    for (int b = 0; b < 16; ++b) { acc[b] += __shfl_xor(acc[b], 16); acc[b] += __shfl_xor(acc[b], 32); }
    if (kq == 0) { const float bs = bias ? bias[col0 + n] : 0.f;
#pragma unroll
        for (int b = 0; b < 16; ++b) out[(size_t)b * out_ld + ocol0 + n] = acc[b] + bs; }
}

__device__ __forceinline__ void phase_p0a(KPC p, const Frame& F) {
    unsigned char* ws = p->ws;
    bf16_t* WtE = (bf16_t*)(ws + WS_WTE); bf16_t* WtO = (bf16_t*)(ws + WS_WTO); bf16_t* WtOut = (bf16_t*)(ws + WS_WTOUT); bf16_t* Wg = (bf16_t*)(ws + WS_WG);
    float* mod = (float*)(ws + WS_MOD); float* scal = (float*)(ws + WS_SCAL);
    LAS float* scr = (LAS float*)(F.lds + F.wave * 8448);
    LAS float* vec = (LAS float*)(F.lds + 73728);
    const int gw = F.vcu * 8 + F.wave, NGW = F.G * 8;
    for (int i = F.tid; i < 16384; i += 512) vec[i] = fsilu(p->c[i]);
    for (int it = gw; it < 9216; it += NGW) {
        int r = it;
        if (r < 3072) { const int e = r / 1536; p0_transpose_item(p->even_w_in + (size_t)e * 1024 * 3072, 1024, 3072, WtE + (size_t)e * 3072 * 1024, r % 1536, scr, F.lane, 1); continue; }
        r -= 3072;
        if (r < 4096) { const int o = r / 2048; p0_transpose_item(p->odd_w_in + (size_t)o * 1024 * 4096, 1024, 4096, WtO + (size_t)o * 4096 * 1024, r % 2048, scr, F.lane, 2); continue; }
        r -= 4096;
        { const int j = r / 512; const int l = (j < 2) ? 2 * j : 2 * (j - 2) + 1; const float* src = (j < 2) ? p->even_w_out + (size_t)j * 1024 * 1024 : p->odd_w_out + (size_t)(j - 2) * 1024 * 1024;
          p0_transpose_item(src, 1024, 1024, WtOut + (size_t)l * 1024 * 1024, r % 512, scr, F.lane, 0); }
    }
    for (int idx = gw * 64 + F.lane; idx < 262144; idx += NGW * 64) {
        const int k = idx & 63, j = (idx >> 6) & 255, n = (idx >> 14) & 7, e = idx >> 17; const int set = j >> 6, d = j & 63, r = set >> 1;
        const float* src = (set & 1) ? p->w_x : p->w_a;
        const float v = src[((((size_t)e * 2 + r) * 8 + n) * 64 + k) * 64 + d];
        Wg[idx] = (bf16_t)(pk2(v, 0.f) & 0xffffu);
    }
    if (F.bx == 0 && F.tid < 2) {
        const int e = F.tid; const float* lp = p->da_lam + e * 256; float s01 = 0.f, s23 = 0.f;
        for (int i = 0; i < 64; ++i) { s01 += lp[i] * lp[64 + i]; s23 += lp[128 + i] * lp[192 + i]; }
        const float lam_init = (e == 0) ? 0.2f : 0.47071302f;
        scal[e * 4 + 0] = expf(s01) - expf(s23) + lam_init; scal[e * 4 + 1] = lam_init;
    }
    __syncthreads();
    for (int it = F.wave * F.G + F.vcu; it < 768; it += NGW) {
        const int l = it / 192, ch = it % 192;
        gemv16_item(vec, p->ada_w + (size_t)l * 1024 * 3072, 3072, ch * 16, mod + (size_t)l * 16 * 3072, 3072, ch * 16, p->ada_b + l * 3072, F.lane);
    }
}
__device__ __forceinline__ void phase_p0b(KPC p, const Frame& F) {
    unsigned char* ws = p->ws;
    const float* mod = (const float*)(ws + WS_MOD); float* sW = (float*)(ws + WS_SW); float* ssq = (float*)(ws + WS_SSQ); bf16_t* xg = (bf16_t*)(ws + WS_XG);
    LAS float* vec = (LAS float*)(F.lds);
    const int l = F.vcu & 3;
    for (int i = F.tid; i < 16384; i += 512) vec[i] = mod[((size_t)l * 16 + (i >> 10)) * 3072 + (i & 1023)];
    __syncthreads();
    {
        const int odd = l & 1, N = odd ? 4096 : 3072;
        const float* W = odd ? p->odd_w_in + (size_t)(l >> 1) * 1024 * 4096 : p->even_w_in + (size_t)(l >> 1) * 1024 * 3072;
        for (int it = (F.vcu >> 2) * 8 + F.wave; it < N / 16; it += (F.G >> 2) * 8)
            gemv16_item(vec, W, N, unmap_col(it * 16, odd), sW + (size_t)l * 16 * 4096, 4096, it * 16, nullptr, F.lane);
    }
    const int gw = F.vcu * 8 + F.wave, NGW = F.G * 8;
    for (int row = gw; row < MTOK; row += NGW) {
        const int b = row >> 11;
        const f32x4* xr = (const f32x4*)(p->x + (size_t)row * 1024) + F.lane;
        f32x4 v[4]; float s = 0.f;
#pragma unroll
        for (int j = 0; j < 4; ++j) { v[j] = xr[64 * j]; s += (v[j][0] * v[j][0] + v[j][1] * v[j][1]) + (v[j][2] * v[j][2] + v[j][3] * v[j][3]); }
        s = wave_sum(s);
        unsigned long long* o8 = (unsigned long long*)(xg + (size_t)row * 1024) + F.lane;
#pragma unroll
        for (int j = 0; j < 4; ++j) {
            const int k = 4 * F.lane + 256 * j;
            const f32x4 g = *(const f32x4*)(p->norm_g + k), sc = *(const f32x4*)(mod + (size_t)b * 3072 + 1024 + k);
            const f32x4 z = v[j] * g * (sc + 1.f);
            o8[64 * j] = (unsigned long long)pk2(z[0], z[1]) | ((unsigned long long)pk2(z[2], z[3]) << 32);
        }
        if (F.lane < 16) ssq[(size_t)row * 16 + F.lane] = (F.lane == 0) ? s : 0.f;
    }
}
__device__ __forceinline__ void phase_final(KPC p, const Frame& F) {
    const float* ssq = (const float*)(p->ws + WS_SSQ);
    const int gw = F.vcu * 8 + F.wave, NGW = F.G * 8;
    for (int row = gw; row < MTOK; row += NGW) {
        const float rt = ssq_rinv(ssq, row);
        f32x4* xr = (f32x4*)(p->out + (size_t)row * 1024) + F.lane;
#pragma unroll
        for (int j = 0; j < 4; ++j) { const f32x4 g = *(const f32x4*)(p->final_g + 4 * F.lane + 256 * j); xr[64 * j] = xr[64 * j] * rt * g; }
    }
}
#define MFMA32(a, b, c) __builtin_amdgcn_mfma_f32_32x32x16_bf16((a), (b), (c), 0, 0, 0)
#define MFMA16(a, b, c) __builtin_amdgcn_mfma_f32_16x16x32_bf16((a), (b), (c), 0, 0, 0)
__device__ __forceinline__ void attn_unit(KPC p, const Frame& F, int e_layer, int b, int h, int qb, float lam, float lam_init) {
    const int tid = F.tid, lane = F.lane, r = lane & 31, hh = lane >> 5, m = F.wave & 1, sub = F.wave >> 1;
    const bf16_t* P = (const bf16_t*)(p->ws + WS_PROJ); const bf16_t* VT = (const bf16_t*)(p->ws + WS_VT); bf16_t* mixed = (bf16_t*)(p->ws + WS_MIXED);
    LAS unsigned char* lds = F.lds;
    LAS float* lut = (LAS float*)(lds + 65536);
    const size_t tokbase = (size_t)b * 2048; const int q0w = qb * 128 + sub * 32;
    if (tid < 511) lut[tid] = p->t5[h * 32 + t5_bucket(tid - 255)] * LOG2E;
    const float cL = p->t5[h * 32 + 15] * LOG2E, cR = p->t5[h * 32 + 31] * LOG2E;
    bf16x8 qf[4];
    { const bf16_t* qp = P + (tokbase + q0w + r) * 2560 + h * 128 + m * 64 + hh * 8;
#pragma unroll
      for (int s = 0; s < 4; ++s) qf[s] = *(const bf16x8*)(qp + 16 * s); }
    const int skey = (tid >> 3) & 63, sch = tid & 7;
    const bf16_t* ksrc0 = P + (tokbase + skey) * 2560 + 512 + h * 128 + sch * 8;
    const unsigned kdst0 = (unsigned)(skey * 128 + ((sch ^ ((skey >> 1) & 7)) << 4));
    const int ve0 = tid >> 3;
    const bf16_t* vsrc0 = VT + ((size_t)(b * 512 + h * 128 + ve0)) * 2048 + sch * 8;
    const unsigned vdst0 = (unsigned)(16384 + ve0 * 128 + ((sch ^ ((ve0 >> 1) & 7)) << 4));
    u32x4 kr0, kr1, vr0, vr1;
    kr0 = *(const u32x4*)(ksrc0); kr1 = *(const u32x4*)(ksrc0 + 64); vr0 = *(const u32x4*)(vsrc0); vr1 = *(const u32x4*)(vsrc0 + (size_t)64 * 2048);
    *(LAS u32x4*)(lds + kdst0) = kr0; *(LAS u32x4*)(lds + 8192 + kdst0) = kr1; *(LAS u32x4*)(lds + vdst0) = vr0; *(LAS u32x4*)(lds + 8192 + vdst0) = vr1;
    __syncthreads();
    f32x16 O[4];
#pragma unroll
    for (int et = 0; et < 4; ++et)
#pragma unroll
        for (int i = 0; i < 16; ++i) O[et][i] = 0.f;
    float m_run = -INFINITY, l_run = 0.f;
    const unsigned swz = (unsigned)((r >> 1) & 7);
    for (int j = 0; j < 32; ++j) {
        const int st = (j & 1) * 32768;
        if (j + 1 < 32) {
            const bf16_t* ks = ksrc0 + (size_t)(j + 1) * 64 * 2560; const bf16_t* vs = vsrc0 + (j + 1) * 64;
            kr0 = *(const u32x4*)(ks); kr1 = *(const u32x4*)(ks + 64); vr0 = *(const u32x4*)(vs); vr1 = *(const u32x4*)(vs + (size_t)64 * 2048);
        }
        const LAS unsigned char* kb = lds + st + m * 8192; const LAS unsigned char* vb = lds + st + 16384;
        f32x16 S0, S1;
        { const int rel_max = 64 * j + 63 - q0w, rel_min = 64 * j - (q0w + 31);
          if (rel_max <= -91) {
#pragma unroll
              for (int i = 0; i < 16; ++i) { S0[i] = cL; S1[i] = cL; }
          } else if (rel_min >= 91) {
#pragma unroll
              for (int i = 0; i < 16; ++i) { S0[i] = cR; S1[i] = cR; }
          } else {
              const int ib = 64 * j + 4 * hh - (q0w + r) + 255;
#pragma unroll
              for (int i = 0; i < 16; ++i) { const int idx = ib + (i & 3) + 8 * (i >> 2); S0[i] = lut[idx]; S1[i] = lut[idx + 32]; }
          } }
#pragma unroll
        for (int s = 0; s < 4; ++s) {
            const unsigned co = (((unsigned)(2 * s + hh)) ^ swz) << 4;
            const bf16x8 a0 = *(const LAS bf16x8*)(kb + r * 128 + co);
            const bf16x8 a1 = *(const LAS bf16x8*)(kb + (32 + r) * 128 + co);
            S0 = MFMA32(a0, qf[s], S0); S1 = MFMA32(a1, qf[s], S1);
        }
        float mx = fmaxf(S0[0], S1[0]);
#pragma unroll
        for (int i = 1; i < 16; ++i) mx = fmaxf(mx, fmaxf(S0[i], S1[i]));
        mx = fmaxf(mx, __shfl_xor(mx, 32));
        const float m_new = fmaxf(m_run, mx); const float alpha = ex2(m_run - m_new); m_run = m_new;
        float ls = 0.f;
#pragma unroll
        for (int i = 0; i < 16; ++i) { S0[i] = ex2(S0[i] - m_new); S1[i] = ex2(S1[i] - m_new); ls += S0[i] + S1[i]; }
        l_run = l_run * alpha + ls;
#pragma unroll
        for (int et = 0; et < 4; ++et)
#pragma unroll
            for (int i = 0; i < 16; ++i) O[et][i] *= alpha;
        bf16x8 pf[4];
        { u32x4 w;
          w.x = pk2(S0[0], S0[1]); w.y = pk2(S0[2], S0[3]); w.z = pk2(S0[4], S0[5]); w.w = pk2(S0[6], S0[7]); pf[0] = __builtin_bit_cast(bf16x8, w);
          w.x = pk2(S0[8], S0[9]); w.y = pk2(S0[10], S0[11]); w.z = pk2(S0[12], S0[13]); w.w = pk2(S0[14], S0[15]); pf[1] = __builtin_bit_cast(bf16x8, w);
          w.x = pk2(S1[0], S1[1]); w.y = pk2(S1[2], S1[3]); w.z = pk2(S1[4], S1[5]); w.w = pk2(S1[6], S1[7]); pf[2] = __builtin_bit_cast(bf16x8, w);
          w.x = pk2(S1[8], S1[9]); w.y = pk2(S1[10], S1[11]); w.z = pk2(S1[12], S1[13]); w.w = pk2(S1[14], S1[15]); pf[3] = __builtin_bit_cast(bf16x8, w); }
#pragma unroll
        for (int et = 0; et < 4; ++et)
#pragma unroll
            for (int s = 0; s < 4; ++s) {
                const bf16x8 a = *(const LAS bf16x8*)(vb + (32 * et + r) * 128 + ((((unsigned)(2 * s + hh)) ^ swz) << 4));
                O[et] = MFMA32(a, pf[s], O[et]);
            }
        if (j + 1 < 32) {
            const int sn = ((j + 1) & 1) * 32768;
            *(LAS u32x4*)(lds + sn + kdst0) = kr0; *(LAS u32x4*)(lds + sn + 8192 + kdst0) = kr1; *(LAS u32x4*)(lds + sn + vdst0) = vr0; *(LAS u32x4*)(lds + sn + 8192 + vdst0) = vr1;
        }
        __syncthreads();
    }
    l_run += __shfl_xor(l_run, 32);
    const float inv = 1.f / l_run;
    LAS float* X = (LAS float*)(lds) + sub * 4096;
    if (m == 1) {
#pragma unroll
        for (int et = 0; et < 4; ++et)
#pragma unroll
            for (int i = 0; i < 16; ++i) X[(et * 16 + i) * 64 + lane] = O[et][i] * inv;
    }
    __syncthreads();
    if (m == 0) {
        float ss = 0.f;
#pragma unroll
        for (int et = 0; et < 4; ++et)
#pragma unroll
            for (int i = 0; i < 16; ++i) { const float d = O[et][i] * inv - lam * X[(et * 16 + i) * 64 + lane]; O[et][i] = d; ss += d * d; }
        ss += __shfl_xor(ss, 32);
        const float rinv = rsqrtf(ss * (1.f / 128.f) + 1e-6f) * (1.f - lam_init);
        const size_t tok = tokbase + q0w + r;
#pragma unroll
        for (int et = 0; et < 4; ++et)
#pragma unroll
            for (int g4 = 0; g4 < 4; ++g4) {
                const int e0 = 32 * et + 8 * g4 + 4 * hh;
                const f32x4 sg = *(const f32x4*)(p->da_subg + e_layer * 128 + e0);
                const u32x2 ga = *(const u32x2*)(P + tok * 2560 + 1024 + h * 128 + e0);
                const float v0 = O[et][4 * g4 + 0] * rinv * sg[0] * fsilu(bflo(ga.x)), v1 = O[et][4 * g4 + 1] * rinv * sg[1] * fsilu(bfhi(ga.x));
                const float v2 = O[et][4 * g4 + 2] * rinv * sg[2] * fsilu(bflo(ga.y)), v3 = O[et][4 * g4 + 3] * rinv * sg[3] * fsilu(bfhi(ga.y));
                u32x2 w; w.x = pk2(v0, v1); w.y = pk2(v2, v3);
                *(u32x2*)(mixed + tok * 1024 + h * 128 + e0) = w;
            }
    }
    __syncthreads();
}

__device__ __forceinline__ float frcp(float v) { return __builtin_amdgcn_rcpf(v); }
__device__ __forceinline__ float fsigm_fast(float v) { return frcp(1.f + __expf(-v)); }
template <int dir> __device__ __forceinline__ void lru_pass(KPC p, const Frame& F, int e_layer, int b, int n, int hf) {
    const int tid = F.tid, lane = F.lane, wave = F.wave;
    const bf16_t* P = (const bf16_t*)(p->ws + WS_PROJ); bf16_t* mixed = (bf16_t*)(p->ws + WS_MIXED); float* HF = (float*)(p->ws + WS_XG);
    const bf16_t* Wg = (const bf16_t*)(p->ws + WS_WG) + ((size_t)(e_layer * 8 + n)) * 256 * 64;
    LAS unsigned char* lds = F.lds;
    LAS unsigned char* XA = lds; LAS float* XC = (LAS float*)(lds + 16384); LAS f32x2_t* PH = (LAS f32x2_t*)(lds + 34816); LAS float* Cc = (LAS float*)(lds + 36864);
    const size_t tokbase = (size_t)b * 2048;
    const int cg = tid & 7, tp = tid >> 3;
    f32x4 cwa[4], cwb[4], cba, cbb;
    { const float* cwp = p->conv_w + (size_t)e_layer * 4 * 512 + n * 64 + cg * 8;
#pragma unroll
      for (int j = 0; j < 4; ++j) { cwa[j] = *(const f32x4*)(cwp + j * 512); cwb[j] = *(const f32x4*)(cwp + j * 512 + 4); }
      const float* cbp = p->conv_b + e_layer * 512 + n * 64 + cg * 8; cba = *(const f32x4*)(cbp); cbb = *(const f32x4*)(cbp + 4); }
    const bf16_t* xcol = P + tokbase * 2560 + 1536 + n * 64 + cg * 8;
    const int mt = wave, col = lane & 15, kq = lane >> 4;
    const int kqo = dir ? 3 - kq : kq, wo = dir ? 7 - mt : mt;
    bf16x8 wf[2][2][2];
    float ba[2], bx[2], sp[2];
#pragma unroll
    for (int jj = 0; jj < 2; ++jj) {
        const int ch = 32 * hf + 16 * jj + col;
#pragma unroll
        for (int gs = 0; gs < 2; ++gs)
#pragma unroll
            for (int ks = 0; ks < 2; ++ks) wf[jj][gs][ks] = *(const bf16x8*)(Wg + (size_t)((2 * dir + gs) * 64 + ch) * 64 + 32 * ks + 8 * kq);
        ba[jj] = p->b_a[(e_layer * 2 + dir) * 512 + n * 64 + ch]; bx[jj] = p->b_x[(e_layer * 2 + dir) * 512 + n * 64 + ch];
        const float y = -p->lru_lam[(e_layer * 2 + dir) * 512 + n * 64 + ch]; sp[jj] = -8.f * (fmaxf(y, 0.f) + log1pf(expf(-fabsf(y))));
    }
    if (tid < 64) Cc[tid] = 0.f;
    u32x4 xr[5];
    { const int t0 = (dir ? 15 : 0) * 128;
#pragma unroll
      for (int k = 0; k < 5; ++k) { int tt = t0 + 2 * tp - 2 + k; tt = tt < 0 ? 0 : (tt > 2047 ? 2047 : tt); xr[k] = *(const u32x4*)(xcol + (size_t)tt * 2560); } }
    for (int cc = 0; cc < 16; ++cc) {
        const int chunk = dir ? 15 - cc : cc; const int t0 = chunk * 128; const int par = cc & 1;
        u32x4 xc5[5];
#pragma unroll
        for (int k = 0; k < 5; ++k) { const int tt = t0 + 2 * tp - 2 + k; const bool ok = (tt >= 0) && (tt < 2048); xc5[k] = xr[k]; if (!ok) xc5[k] = (u32x4){0u, 0u, 0u, 0u}; }
        { const int cn = (cc + 1 < 16) ? cc + 1 : cc; const int t1 = (dir ? 15 - cn : cn) * 128;
#pragma unroll
            for (int k = 0; k < 5; ++k) { int tt = t1 + 2 * tp - 2 + k; tt = tt < 0 ? 0 : (tt > 2047 ? 2047 : tt); xr[k] = *(const u32x4*)(xcol + (size_t)tt * 2560); } }
        float hfv[2][4]; bf16_t gvv[2][4];
        if (dir) {
#pragma unroll
            for (int jj = 0; jj < 2; ++jj)
#pragma unroll
                for (int i = 0; i < 4; ++i) { const size_t tok = tokbase + t0 + 16 * mt + 4 * kq + i; const int ch = n * 64 + 32 * hf + 16 * jj + col;
                    hfv[jj][i] = HF[tok * 512 + ch]; gvv[jj][i] = P[tok * 2560 + 2048 + ch]; }
        }
#pragma unroll
        for (int i = 0; i < 2; ++i) {
            const int tl = 2 * tp + i;
            f32x4 va = cba, vb = cbb;
#pragma unroll
            for (int j = 0; j < 4; ++j) { const u32x4 x = xc5[i + j];
                va += cwa[j] * (f32x4){bflo(x.x), bfhi(x.x), bflo(x.y), bfhi(x.y)}; vb += cwb[j] * (f32x4){bflo(x.z), bfhi(x.z), bflo(x.w), bfhi(x.w)}; }
            u32x4 w; w.x = pk2(va[0], va[1]); w.y = pk2(va[2], va[3]); w.z = pk2(vb[0], vb[1]); w.w = pk2(vb[2], vb[3]);
            *(LAS u32x4*)(XA + tl * 128 + ((((unsigned)cg) ^ ((unsigned)(tl >> 1) & 7u)) << 4)) = w;
            if ((cg >> 2) == hf) { LAS float* xp = XC + tl * 36 + (cg & 3) * 8; *(LAS f32x4*)(xp) = va; *(LAS f32x4*)(xp + 4) = vb; }
        }
        __syncthreads();
        f32x4 acc[2][2];
#pragma unroll
        for (int jj = 0; jj < 2; ++jj)
#pragma unroll
            for (int gs = 0; gs < 2; ++gs) acc[jj][gs] = (f32x4){0.f, 0.f, 0.f, 0.f};
#pragma unroll
        for (int ks = 0; ks < 2; ++ks) {
            const int row = 16 * mt + col;
            const bf16x8 a = *(const LAS bf16x8*)(XA + row * 128 + ((((unsigned)(4 * ks + kq)) ^ ((unsigned)(row >> 1) & 7u)) << 4));
#pragma unroll
            for (int jj = 0; jj < 2; ++jj)
#pragma unroll
                for (int gs = 0; gs < 2; ++gs) acc[jj][gs] = MFMA16(a, wf[jj][gs][ks], acc[jj][gs]);
        }
        float hl[2][4], Pp[2][4], Pex[2], Hex[2];
#pragma unroll
        for (int jj = 0; jj < 2; ++jj) {
            const int chl = 16 * jj + col;
            float av[4], uv[4];
#pragma unroll
            for (int i = 0; i < 4; ++i) {
                const int tl = 16 * mt + 4 * kq + i;
                const float ga = fsigm_fast(acc[jj][0][i] + ba[jj]), gx = fsigm_fast(acc[jj][1][i] + bx[jj]);
                const float log_a = ga * sp[jj]; const float a = __expf(log_a); const float y2 = 2.f * log_a;
                const float om = (y2 > -0.1f) ? -(y2 * (1.f + y2 * (0.5f + y2 * (0.16666667f + y2 * 0.041666668f)))) : 1.f - a * a;
                av[i] = a; uv[i] = __builtin_amdgcn_sqrtf(om) * gx * XC[tl * 36 + chl];
            }
            if (!dir) { hl[jj][0] = uv[0]; Pp[jj][0] = av[0];
#pragma unroll
                for (int i = 1; i < 4; ++i) { hl[jj][i] = av[i] * hl[jj][i - 1] + uv[i]; Pp[jj][i] = av[i] * Pp[jj][i - 1]; }
            } else { hl[jj][3] = uv[3]; Pp[jj][3] = av[3];
#pragma unroll
                for (int i = 2; i >= 0; --i) { hl[jj][i] = av[i] * hl[jj][i + 1] + uv[i]; Pp[jj][i] = av[i] * Pp[jj][i + 1]; }
            }
            float Pi = dir ? Pp[jj][0] : Pp[jj][3], Hi = dir ? hl[jj][0] : hl[jj][3];
            { const float Pq = dir ? __shfl_down(Pi, 16) : __shfl_up(Pi, 16), Hq = dir ? __shfl_down(Hi, 16) : __shfl_up(Hi, 16);
              if (kqo >= 1) { Hi = Pi * Hq + Hi; Pi = Pi * Pq; } }
            { const float Pq = dir ? __shfl_down(Pi, 32) : __shfl_up(Pi, 32), Hq = dir ? __shfl_down(Hi, 32) : __shfl_up(Hi, 32);
              if (kqo >= 2) { Hi = Pi * Hq + Hi; Pi = Pi * Pq; } }
            { const float Pq = dir ? __shfl_down(Pi, 16) : __shfl_up(Pi, 16), Hq = dir ? __shfl_down(Hi, 16) : __shfl_up(Hi, 16);
              Pex[jj] = (kqo >= 1) ? Pq : 1.f; Hex[jj] = (kqo >= 1) ? Hq : 0.f; }
            if (kqo == 3) PH[mt * 32 + chl] = (f32x2_t){Pi, Hi};
        }
        __syncthreads();
#pragma unroll
        for (int jj = 0; jj < 2; ++jj) {
            const int chl = 16 * jj + col;
            float cw_ = Cc[par * 32 + chl];
            f32x2_t ph[7];
#pragma unroll
            for (int s = 0; s < 7; ++s) ph[s] = PH[(dir ? 7 - s : s) * 32 + chl];
#pragma unroll
            for (int s = 0; s < 7; ++s) cw_ = (s < wo) ? ph[s].x * cw_ + ph[s].y : cw_;
            const float cin = Pex[jj] * cw_ + Hex[jj];
#pragma unroll
            for (int i = 0; i < 4; ++i) hl[jj][i] += Pp[jj][i] * cin;
            if (wo == 7 && kqo == 3) Cc[(par ^ 1) * 32 + chl] = dir ? hl[jj][0] : hl[jj][3];
#pragma unroll
            for (int i = 0; i < 4; ++i) {
                const size_t tok = tokbase + t0 + 16 * mt + 4 * kq + i; const int ch = n * 64 + 32 * hf + chl;
                if (!dir) HF[tok * 512 + ch] = hl[jj][i];
                else { const float g = bf2f(gvv[jj][i]); mixed[tok * 1024 + 512 + ch] = (bf16_t)(pk2((hfv[jj][i] + hl[jj][i]) * g * fsigm_fast(g), 0.f) & 0xffffu); }
            }
        }
    }
    asm volatile("s_waitcnt vmcnt(0)" ::: "memory");
    __syncthreads();
}
__device__ __forceinline__ void lru_unit(KPC p, const Frame& F, int e_layer, int b, int n, int hf) {
    lru_pass<0>(p, F, e_layer, b, n, hf);
    lru_pass<1>(p, F, e_layer, b, n, hf);
}

__device__ __forceinline__ void na_unit(KPC p, const Frame& F, int o_layer, int b, int h, int rp) {
    const int tid = F.tid, lane = F.lane, wave = F.wave;
    const bf16_t* P = (const bf16_t*)(p->ws + WS_PROJ); const bf16_t* VT = (const bf16_t*)(p->ws + WS_VT); bf16_t* mixed = (bf16_t*)(p->ws + WS_MIXED);
    LAS unsigned char* lds = F.lds; LAS unsigned char* KL = lds; LAS unsigned char* VTL = lds + 73728; LAS float* rpbs = (LAS float*)(lds + 148480);
    const size_t tokbase = (size_t)b * 2048;
    const int r0 = 2 * rp; int rb = r0 - 4; rb = rb < 0 ? 0 : (rb > 24 ? 24 : rb);
    const int nrows = (rb + 9 <= 32) ? 9 : 8; const int nchunk = nrows * 64 * 8;
    for (int id = tid; id < nchunk; id += 512) {
        const int key = id >> 3, ch = id & 7;
        *(LAS u32x4*)(KL + key * 128 + ((ch ^ ((key >> 1) & 7)) << 4)) = *(const u32x4*)(P + (tokbase + rb * 64 + key) * 3072 + 1024 + h * 64 + ch * 8);
    }
    { const int cpr = nrows * 8;
      for (int id = tid; id < 64 * cpr; id += 512) { const int e = id / cpr, ch = id % cpr;
          *(LAS u32x4*)(VTL + e * 1168 + ch * 16) = *(const u32x4*)(VT + ((size_t)(b * 1024 + h * 64 + e)) * 2048 + rb * 64 + ch * 8); } }
    if (tid < 465) rpbs[tid] = p->rpb[((size_t)o_layer * 16 + h) * 465 + tid] * LOG2E;
    __syncthreads();
    {
        const int rr = r0 + (wave >> 2), g = wave & 3, c0 = 16 * g, kc0 = (g == 0) ? 0 : (g == 1 ? 8 : (g == 2 ? 24 : 32));
        int rs = rr - 4; rs = rs < 0 ? 0 : (rs > 24 ? 24 : rs); const int li0 = rs - rb;
        const int q = lane & 15, kq = lane >> 4;
        const size_t tok = tokbase + rr * 64 + c0 + q;
        bf16x8 qf[2];
#pragma unroll
        for (int ks = 0; ks < 2; ++ks) qf[ks] = *(const bf16x8*)(P + tok * 3072 + h * 64 + 32 * ks + 8 * kq);
        f32x4 S[8][2];
#pragma unroll
        for (int i = 0; i < 8; ++i)
#pragma unroll
            for (int a = 0; a < 2; ++a) {
                const int keyl = (li0 + i) * 64 + kc0 + 16 * a + q;
                f32x4 acc = (f32x4){0.f, 0.f, 0.f, 0.f};
#pragma unroll
                for (int ks = 0; ks < 2; ++ks) {
                    const bf16x8 A = *(const LAS bf16x8*)(KL + keyl * 128 + ((((unsigned)(4 * ks + kq)) ^ ((unsigned)(keyl >> 1) & 7u)) << 4));
                    acc = MFMA16(A, qf[ks], acc);
                }
                S[i][a] = acc;
            }
        const int c = c0 + q; int cs = c - 8; cs = cs < 0 ? 0 : (cs > 48 ? 48 : cs);
        float mx = -1e30f;
#pragma unroll
        for (int i = 0; i < 8; ++i)
#pragma unroll
            for (int a = 0; a < 2; ++a)
#pragma unroll
                for (int j = 0; j < 4; ++j) {
                    const int kc = kc0 + 16 * a + 4 * kq + j; const bool valid = (kc >= cs) && (kc < cs + 16);
                    int dc = kc - c + 15; dc = dc < 0 ? 0 : (dc > 30 ? 30 : dc);
                    const float bias = rpbs[(rs + i - rr + 7) * 31 + dc];
                    const float s = valid ? S[i][a][j] + bias : -1e30f;
                    S[i][a][j] = s; mx = fmaxf(mx, s);
                }
        mx = fmaxf(mx, __shfl_xor(mx, 16)); mx = fmaxf(mx, __shfl_xor(mx, 32));
        float l = 0.f;
#pragma unroll
        for (int i = 0; i < 8; ++i)
#pragma unroll
            for (int a = 0; a < 2; ++a)
#pragma unroll
                for (int j = 0; j < 4; ++j) { const float e = ex2(S[i][a][j] - mx); S[i][a][j] = e; l += e; }
        l += __shfl_xor(l, 16); l += __shfl_xor(l, 32);
        f32x4 O[4];
#pragma unroll
        for (int et = 0; et < 4; ++et) O[et] = (f32x4){0.f, 0.f, 0.f, 0.f};
#pragma unroll
        for (int i = 0; i < 8; ++i) {
            u32x4 w; w.x = pk2(S[i][0][0], S[i][0][1]); w.y = pk2(S[i][0][2], S[i][0][3]); w.z = pk2(S[i][1][0], S[i][1][1]); w.w = pk2(S[i][1][2], S[i][1][3]);
            const bf16x8 pf = __builtin_bit_cast(bf16x8, w);
#pragma unroll
            for (int et = 0; et < 4; ++et) {
                const LAS unsigned char* vp = VTL + (16 * et + q) * 1168 + ((li0 + i) * 64 + kc0 + 4 * kq) * 2;
                const u32x2 lo = *(const LAS u32x2*)(vp), hi = *(const LAS u32x2*)(vp + 32);
                u32x4 av; av.x = lo.x; av.y = lo.y; av.z = hi.x; av.w = hi.y;
                O[et] = MFMA16(__builtin_bit_cast(bf16x8, av), pf, O[et]);
            }
        }
        const float inv = 1.f / l;
#pragma unroll
        for (int et = 0; et < 4; ++et) {
            const int e0 = 16 * et + 4 * kq;
            const u32x2 ga = *(const u32x2*)(P + tok * 3072 + 2048 + h * 64 + e0);
            u32x2 w; w.x = pk2(O[et][0] * inv * fsilu(bflo(ga.x)), O[et][1] * inv * fsilu(bfhi(ga.x))); w.y = pk2(O[et][2] * inv * fsilu(bflo(ga.y)), O[et][3] * inv * fsilu(bfhi(ga.y)));
            *(u32x2*)(mixed + tok * 1024 + h * 64 + e0) = w;
        }
    }
    __syncthreads();
}
constexpr int N_PHASES = 15;
__device__ __forceinline__ void run_phase(KPC p, const Frame& F, int ph) {
    unsigned char* ws = p->ws;
    if (ph == 0) { phase_p0a(p, F); return; }
    if (ph == 1) { phase_p0b(p, F); return; }
    if (ph == 14) { phase_final(p, F); return; }
    const int l = (ph - 2) / 3, k = (ph - 2) % 3, odd = l & 1, ei = l >> 1;
    bf16_t* xg = (bf16_t*)(ws + WS_XG); bf16_t* mixed = (bf16_t*)(ws + WS_MIXED); bf16_t* proj = (bf16_t*)(ws + WS_PROJ); bf16_t* VT = (bf16_t*)(ws + WS_VT);
    float* ssq = (float*)(ws + WS_SSQ); const float* sW = (const float*)(ws + WS_SW) + (size_t)l * 16 * 4096; const float* mod = (const float*)(ws + WS_MOD);
    if (k == 0) {
        const int N1 = odd ? 3072 : 2560, NV = odd ? 1024 : 512;
        const bf16_t* Wt = odd ? (const bf16_t*)(ws + WS_WTO) + (size_t)ei * 4096 * 1024 : (const bf16_t*)(ws + WS_WTE) + (size_t)ei * 3072 * 1024;
        { pg8::Gemm g{xg, Wt, MTOK, N1, 1024}; pg8::StaticOrder S; S.init(MTOK, N1, F.G, F.bx);
          EpiProj E{proj, N1, ssq, sW, odd ? 1024 : 512};
          pg8::gemm_phase<EpiProj, pg8::StaticOrder, true, true>(F.lds, g, S, E, F.tid); }
        { pg8::Gemm g{Wt + (size_t)N1 * 1024, xg, NV, MTOK, 1024}; pg8::StaticOrder S; S.init(NV, MTOK, F.G, F.bx);
          EpiProjT E{VT, NV, ssq, sW + N1, odd ? 0 : 1};
          pg8::gemm_phase<EpiProjT, pg8::StaticOrder, true, true>(F.lds, g, S, E, F.tid); }
    } else if (k == 1) {
        if (!odd) {
            const float* scal = (const float*)(ws + WS_SCAL); const float lam = scal[ei * 4 + 0], lam_init = scal[ei * 4 + 1];
            for (int u = F.vcu; u < 1280; u += F.G) {
                Frame Fu = F; asm volatile("" : "+v"(Fu.tid)); Fu.lane = Fu.tid & 63;
                if (u < 256) lru_unit(p, Fu, ei, u >> 4, (u >> 1) & 7, u & 1);
                else { const int a = u - 256, bh = a >> 4; attn_unit(p, Fu, ei, bh >> 2, bh & 3, a & 15, lam, lam_init); }
            }
#ifdef PROBE_MIX
            if (l == 0) for (int u = F.vcu; u < 1280; u += F.G) {
                Frame Fu = F; asm volatile("" : "+v"(Fu.tid)); Fu.lane = Fu.tid & 63;
                if (u < 256) { if (PROBE_MIX == 1) lru_unit(p, Fu, ei, u >> 4, (u >> 1) & 7, u & 1); }
                else if (PROBE_MIX == 2) { const int a = u - 256, bh = a >> 4; attn_unit(p, Fu, ei, bh >> 2, bh & 3, a & 15, lam, lam_init); }
            }
#endif
        } else {
            for (int u = F.vcu; u < 4096; u += F.G) { Frame Fu = F; asm volatile("" : "+v"(Fu.tid)); Fu.lane = Fu.tid & 63;
                const int bh = u >> 4; na_unit(p, Fu, ei, bh >> 4, bh & 15, u & 15); }
        }
    } else {
        pg8::Gemm g{mixed, (const bf16_t*)(ws + WS_WTOUT) + (size_t)l * 1024 * 1024, MTOK, 1024, 1024}; pg8::StaticOrder S; S.init(MTOK, 1024, F.G, F.bx);
        EpiOut E{l == 0 ? p->x : p->out, p->out, xg, ssq, mod + (size_t)l * 16 * 3072 + 2048, p->norm_g + (l < 3 ? (l + 1) * 1024 : 0), mod + (size_t)(l < 3 ? l + 1 : 0) * 16 * 3072 + 1024, l < 3 ? 1 : 0};
        pg8::gemm_phase<EpiOut, pg8::StaticOrder, true, true>(F.lds, g, S, E, F.tid);
    }
}


#define XB_TMO      128
#define XB_XCNT(j)  (256  + 64 * (j))
#define XB_XSUB(j)  (1280 + 64 * (j))
#define XB_XGEN(j)  (2304 + 64 * (j))
#define XB_TOP      3328
#define XB_TOPGEN   3392
#define XCD_BAR_WORDS 3456
#define XB_SPIN_CAP (1u << 20)
__device__ __forceinline__ unsigned xb_ld(unsigned* p)              { return __hip_atomic_load(p, __ATOMIC_RELAXED, __HIP_MEMORY_SCOPE_AGENT); }
__device__ __forceinline__ unsigned xb_add(unsigned* p, unsigned v) { return __hip_atomic_fetch_add(p, v, __ATOMIC_RELAXED, __HIP_MEMORY_SCOPE_AGENT); }
__device__ __forceinline__ unsigned xb_xcc_id() { return (unsigned)__builtin_amdgcn_s_getreg((3 << 11) | 20) & 0xFu; }
#define XB_SPIN(cond, bar) do { unsigned _sp = 0; while (cond) { __builtin_amdgcn_s_sleep(1); \
    if ((++_sp & 255u) == 0u) { if (xb_ld(&(bar)[XB_TMO])) break; if (_sp > XB_SPIN_CAP) { atomicAdd(&(bar)[XB_TMO], 1u); break; } } } } while (0)
struct XcdBarrier { unsigned* bar; unsigned x; volatile LAS unsigned* st; };
__device__ __forceinline__ XcdBarrier xcd_barrier_post(unsigned* bar, volatile LAS unsigned* st) {
    XcdBarrier b; b.bar = bar; b.x = xb_xcc_id(); b.st = st;
    if (threadIdx.x == 0) (void)xb_add(&bar[XB_XCNT(b.x)], 1u);
    return b;
}
__device__ __forceinline__ void xcd_barrier_complete(unsigned* bar, unsigned x, unsigned& nloc, unsigned& nx) {
    const unsigned G = gridDim.x * gridDim.y * gridDim.z;
    unsigned sum, cnt, mine, sp = 0u;
    for (;;) {
        sum = 0u; cnt = 0u; mine = 0u;
#pragma unroll
        for (unsigned j = 0; j < 16; ++j) { const unsigned c = xb_ld(&bar[XB_XCNT(j)]); sum += c; cnt += (c > 0u) ? 1u : 0u; mine = (j == x) ? c : mine; }
        if (sum == G) break;
        __builtin_amdgcn_s_sleep(1);
        if ((++sp & 255u) == 0u) { if (xb_ld(&bar[XB_TMO])) break; if (sp > XB_SPIN_CAP) { atomicAdd(&bar[XB_TMO], 1u); break; } }
    }
    nloc = mine > 0u ? mine : 1u; nx = cnt > 0u ? cnt : 1u;
}
__device__ __forceinline__ void xcd_barrier(const XcdBarrier& b) {
    asm volatile("s_waitcnt vmcnt(0)" ::: "memory");
    __syncthreads();
    if (threadIdx.x == 0) {
        unsigned* bar = b.bar;
        __builtin_amdgcn_s_waitcnt(0);
        unsigned nloc = b.st[0], nx = b.st[1];
        if (nloc == 0u) { xcd_barrier_complete(bar, b.x, nloc, nx); b.st[0] = nloc; b.st[1] = nx; }
        const unsigned old = xb_add(&bar[XB_XSUB(b.x)], 1u);
        const unsigned gen = old / nloc;
        if (old + 1u == (gen + 1u) * nloc) {
            __builtin_amdgcn_fence(__ATOMIC_RELEASE, "agent");
            asm volatile("s_waitcnt vmcnt(0)" ::: "memory");
            const unsigned og = xb_add(&bar[XB_TOP], 1u);
            const unsigned tg = og / nx;
            if (og + 1u == (tg + 1u) * nx) xb_add(&bar[XB_TOPGEN], 1u);
            else XB_SPIN(xb_ld(&bar[XB_TOPGEN]) == tg, bar);
            __builtin_amdgcn_fence(__ATOMIC_ACQUIRE, "agent");
            xb_add(&bar[XB_XGEN(b.x)], 1u);
            asm volatile("s_waitcnt vmcnt(0)" ::: "memory");
        } else {
            XB_SPIN(xb_ld(&bar[XB_XGEN(b.x)]) == gen, bar);
            __builtin_amdgcn_fence(__ATOMIC_ACQUIRE, "agent");
            asm volatile("s_waitcnt vmcnt(0)" ::: "memory");
        }
    }
    __syncthreads();
}
#ifndef MK_CG_SYNC
#define MK_CG_SYNC 0
#endif

__global__ void __launch_bounds__(512, 2) mega(KP p) {
    extern __shared__ __attribute__((aligned(16))) unsigned char lds_raw[];
#if !MK_CG_SYNC
    volatile LAS unsigned* misc = (volatile LAS unsigned*)((LAS unsigned char*)lds_raw + LDS_BYTES - 64);
    if (threadIdx.x < 16) misc[threadIdx.x] = 0u;
    __syncthreads();
    XcdBarrier xbar = xcd_barrier_post((unsigned*)(p.ws + WS_CTL), misc);
#endif
#ifdef PROBE_PH
    int probe_rep = 0;
#endif
    for (int ph = p.ph_lo; ph < p.ph_hi; ++ph) {
#if MK_CG_SYNC
        if (ph > p.ph_lo) cooperative_groups::this_grid().sync();
#else
        if (ph > p.ph_lo) xcd_barrier(xbar);
#endif
        KPC pp = (KPC)__builtin_amdgcn_kernarg_segment_ptr(); asm volatile("" : "+s"(pp));
        int tid = threadIdx.x; asm volatile("" : "+v"(tid));
        int bx = blockIdx.x; asm volatile("" : "+s"(bx));
        Frame F; F.lds = (LAS unsigned char*)lds_raw; F.tid = tid; F.lane = tid & 63; F.wave = __builtin_amdgcn_readfirstlane(tid >> 6);
        F.G = gridDim.x; F.bx = bx; F.vcu = (F.G % 8 == 0) ? (bx % 8) * (F.G / 8) + bx / 8 : bx;
        run_phase(pp, F, ph);
#ifdef PROBE_PH
        if (ph == PROBE_PH && probe_rep == 0) { probe_rep = 1; --ph; }
#endif
    }
}

#ifndef MK_PER_PHASE
#define MK_PER_PHASE 0
#endif
#ifndef MK_DBG
#define MK_DBG 0
#endif
#if MK_DBG
#endif

static void fill_kp(KP& p, void* const* d_in, void* d_out, void* d_ws) {
    const float** f = (const float**)&p;
    for (int i = 0; i < 21; ++i) f[i] = (const float*)d_in[i];
    p.out = (float*)d_out; p.ws = (unsigned char*)d_ws;
}

extern "C" void kernel_launch(void* const* d_in, const int* in_sizes, int n_in, void* d_out, int out_size, void* d_ws, size_t ws_size, hipStream_t stream) {
    static int grid = 0;
    if (grid == 0) {
        int dev = 0, cus = 0, per_cu = 0;
        if (n_in != 21 || out_size != MTOK * DM || ws_size < WS_END) { fprintf(stderr, "kernel_launch: unexpected shapes (n_in %d out %d ws %zu)\n", n_in, out_size, ws_size); grid = -1; return; }
        (void)hipGetDevice(&dev); (void)hipDeviceGetAttribute(&cus, hipDeviceAttributeMultiprocessorCount, dev);
        if (hipFuncSetAttribute((const void*)mega, hipFuncAttributeMaxDynamicSharedMemorySize, LDS_BYTES) != hipSuccess) { fprintf(stderr, "kernel_launch: hipFuncSetAttribute failed\n"); grid = -1; return; }
        if (hipOccupancyMaxActiveBlocksPerMultiprocessor(&per_cu, (const void*)mega, 512, LDS_BYTES) != hipSuccess || per_cu < 1) { fprintf(stderr, "kernel_launch: occupancy query says %d\n", per_cu); per_cu = 1; }
        (void)hipGetLastError();
        grid = cus * 1;
        if (grid % 8 != 0 || grid < 8) grid = 256;
    }
    if (grid < 0) return;
    KP p{}; fill_kp(p, d_in, d_out, d_ws);
#if MK_DBG
    dbg_forward(p, grid, stream);
#elif MK_PER_PHASE
    (void)hipMemsetAsync((char*)d_ws + WS_CTL, 0, 65536, stream);
    for (int ph = 0; ph < N_PHASES; ++ph) { p.ph_lo = ph; p.ph_hi = ph + 1; hipLaunchKernelGGL(mega, dim3(grid), dim3(512), LDS_BYTES, stream, p); }
#else
    p.ph_lo = 0; p.ph_hi = N_PHASES;
#if MK_CG_SYNC
    void* args[] = {&p};
    hipError_t e = hipLaunchCooperativeKernel((const void*)mega, dim3(grid), dim3(512), args, LDS_BYTES, stream);
    if (e != hipSuccess) fprintf(stderr, "cooperative launch failed: %s (grid %d)\n", hipGetErrorString(e), grid);
#else
    (void)hipMemsetAsync((char*)d_ws + WS_CTL, 0, 65536, stream);
    hipLaunchKernelGGL(mega, dim3(grid), dim3(512), LDS_BYTES, stream, p);
#endif
#endif
}
```

```cpp
#include <hip/hip_runtime.h>
#include <hip/hip_cooperative_groups.h>
#include <cstdio>
#include <cstdint>
#include <cmath>

#define LAS __attribute__((address_space(3)))
typedef unsigned short bf16_t;
typedef short bf16x8 __attribute__((ext_vector_type(8)));
typedef float f32x4 __attribute__((ext_vector_type(4)));
typedef float f32x16 __attribute__((ext_vector_type(16)));
typedef unsigned u32x4 __attribute__((ext_vector_type(4)));
typedef unsigned u32x2 __attribute__((ext_vector_type(2)));
typedef float f32x2_t __attribute__((ext_vector_type(2)));
typedef __bf16 bf16x2_t __attribute__((ext_vector_type(2)));

__device__ __forceinline__ unsigned pk2(float lo, float hi) { f32x2_t v = {lo, hi}; bf16x2_t b = __builtin_convertvector(v, bf16x2_t); return __builtin_bit_cast(unsigned, b); }
__device__ __forceinline__ float bflo(unsigned w) { return __uint_as_float(w << 16); }
__device__ __forceinline__ float bfhi(unsigned w) { return __uint_as_float(w & 0xffff0000u); }
__device__ __forceinline__ float bf2f(bf16_t h) { return __uint_as_float((unsigned)h << 16); }
__device__ __forceinline__ float fsilu(float v) { return v / (1.f + __expf(-v)); }
__device__ __forceinline__ float fsigm(float v) { return 1.f / (1.f + __expf(-v)); }
__device__ __forceinline__ float ex2(float v) { return __builtin_amdgcn_exp2f(v); }
__device__ __forceinline__ float wave_sum(float v) {
#pragma unroll
    for (int o = 1; o < 64; o <<= 1) v += __shfl_xor(v, o);
    return v;
}
__device__ __forceinline__ int t5_bucket(int rel) {
    const int n = rel < 0 ? -rel : rel; const int ret = rel > 0 ? 16 : 0;
    int v; if (n < 8) v = n; else { v = 33 - __clz(n * n); if (v > 15) v = 15; }
    return ret + v;
}
#define LDS_WAIT() asm volatile("s_waitcnt lgkmcnt(0)" ::: "memory")
constexpr float LOG2E = 1.4426950408889634f;
constexpr float QSCALE = 0.125f * 1.4426950408889634f;

constexpr int DM = 1024, SEQ = 2048, NBATCH = 16, MTOK = NBATCH * SEQ;
constexpr size_t MiB = 1u << 20;
constexpr size_t WS_CTL = 0, WS_MOD = 1 * MiB, WS_SW = 2 * MiB, WS_SSQ = 3 * MiB, WS_SCAL = 5 * MiB, WS_WG = 5 * MiB + 65536;
constexpr size_t WS_WTE = 6 * MiB, WS_WTO = 18 * MiB, WS_WTOUT = 34 * MiB;
constexpr size_t WS_XG = 48 * MiB, WS_MIXED = 112 * MiB, WS_PROJ = 176 * MiB, WS_VT = 368 * MiB, WS_END = 432 * MiB;
constexpr int LDS_BYTES = 163840;
constexpr int LDS_SPARE = 131072;

struct KP {
    const float *x, *c, *ada_w, *ada_b, *norm_g, *final_g, *t5, *even_w_in, *even_w_out, *da_lam, *da_subg, *conv_w, *conv_b, *w_a, *b_a, *w_x, *b_x, *lru_lam, *odd_w_in, *odd_w_out, *rpb;
    float* out; unsigned char* ws; int ph_lo, ph_hi;
};
typedef const __attribute__((address_space(4))) KP* KPC;
struct Frame { LAS unsigned char* lds; int tid, lane, wave, vcu, G, bx; };

namespace pg8 {
constexpr int BM = 256, BK = 64, HALF = 128, HTB = HALF * BK * 2, STAGE_BYTES = 8 * HTB, NXCD = 8, WGM = 8;
__host__ __device__ __forceinline__ int lds_byte(int r, int c) { const int st = (r >> 4) * 2 + (c >> 5), rr = r & 15, cc = c & 31, ob = rr * 64 + cc * 2; return st * 1024 + (ob ^ (((ob >> 9) & 1) << 5)); }
__host__ __device__ __forceinline__ void stage_rc(int b, int& R, int& C) { const int st = b / 1024, sb = b % 1024, swz = sb ^ (((sb >> 9) & 1) << 5); R = (st >> 1) * 16 + swz / 64; C = (st & 1) * 32 + (swz % 64) / 2; }
__host__ __device__ __forceinline__ int perm32(int rho) { const int n = rho >> 4, i = rho & 15; return 8 * (i >> 2) + 4 * n + (i & 3); }
struct Unit { int pm, pn; };
struct Gemm { const bf16_t* A; const bf16_t* Bt; int M, N, K; };
struct StaticOrder {
    int nM, nN, nwg, G, c;
    __host__ __device__ void init(int M, int N, int G_, int c_) { nM = M / BM; nN = N / BM; nwg = nM * nN; G = G_; c = c_; }
    __host__ __device__ bool next(int i, Unit& u) const {
        const long L = (long)i * G + c; if (L >= nwg) return false;
        int wgid = (int)L; { const int q = nwg / NXCD, r = nwg % NXCD, xcd = wgid % NXCD, off = wgid / NXCD; wgid = (xcd < r ? xcd * (q + 1) : r * (q + 1) + (xcd - r) * q) + off; }
        const int nig = WGM * nN, gid = wgid / nig, fm = gid * WGM, gsz = (nM - fm) < WGM ? (nM - fm) : WGM;
        u.pm = fm + ((wgid % nig) % gsz); u.pn = (wgid % nig) / gsz; return true;
    }
};

template <class Epi, class Sched, bool ALIGN_EPI = false, bool SP2 = false>
__device__ __forceinline__ void gemm_phase(LAS unsigned char* lds, const Gemm g, const Sched& S, const Epi& E, const int tid) {
    const int wid = __builtin_amdgcn_readfirstlane(tid >> 6), lane = tid & 63, wr = wid >> 2, wc = wid & 3, fr = lane & 15, fq = lane >> 4;
    const int K = g.K, nt = K / BK;
    unsigned voffA[2], voffB[2];
#pragma unroll
    for (int i = 0; i < 2; ++i) { int R, C; stage_rc(tid * 16 + i * 8192, R, C); const int Rb = Epi::PERM ? ((R & ~31) + perm32(R & 31)) : R;
        voffA[i] = (unsigned)(R * K + C) * 2u; voffB[i] = (unsigned)(Rb * K + C) * 2u; }
    const size_t kstep = (size_t)(BK * 2);
    const size_t hstep = (size_t)HALF * K * 2;
    const size_t tstep = 2 * hstep;
    const unsigned ldsw = (unsigned)wid * 1024u;
    const int aoff = lds_byte(wr * 64 + fr, fq * 8), boff = lds_byte(wc * 32 + fr, fq * 8);
#define PG8_SA(b, h) (((b) * 2 + (h)) * HTB)
#define PG8_SB(b, h) ((4 + (b) * 2 + (h)) * HTB)
#define PG8_STAGE(bufoff, gbase, voff) do { _Pragma("unroll") for (int _i = 0; _i < 2; ++_i) \
        __builtin_amdgcn_global_load_lds((const unsigned*)((const char*)(gbase) + (voff)[_i]), (LAS unsigned*)(lds + (bufoff) + ldsw + _i * 8192), 16, 0, 0); } while (0)
#define PG8_LDA(dst, b, h) do { _Pragma("unroll") for (int m = 0; m < 4; ++m) _Pragma("unroll") for (int k = 0; k < 2; ++k) dst[m][k] = *(const LAS bf16x8*)(lds + PG8_SA(b, h) + aoff + m * 2048 + k * 1024); } while (0)
#define PG8_LDB(dst, b, h) do { _Pragma("unroll") for (int n = 0; n < 2; ++n) _Pragma("unroll") for (int k = 0; k < 2; ++k) dst[n][k] = *(const LAS bf16x8*)(lds + PG8_SB(b, h) + boff + n * 2048 + k * 1024); } while (0)
#define PG8_MMA(ai, bj, At, Bt) do { __builtin_amdgcn_s_setprio(1); _Pragma("unroll") for (int m = 0; m < 4; ++m) _Pragma("unroll") for (int n = 0; n < 2; ++n) _Pragma("unroll") for (int k = 0; k < 2; ++k) \
        acc[ai][bj][m][n] = __builtin_amdgcn_mfma_f32_16x16x32_bf16(Bt[n][k], At[m][k], acc[ai][bj][m][n], 0, 0, 0); __builtin_amdgcn_s_setprio(0); } while (0)
#define PG8_WAIT_V(n) asm volatile("s_waitcnt vmcnt(" #n ")" ::: "memory")
#define PG8_WAIT_L(n) asm volatile("s_waitcnt lgkmcnt(" #n ")" ::: "memory")
#define PG8_BAR __builtin_amdgcn_s_barrier()
#define PG8_SCHED __builtin_amdgcn_sched_barrier(0)
    Unit cur, nxt; int ui = 0;
    if (!S.next(0, cur)) return;
    f32x4 acc[2][2][4][2];
#pragma unroll
    for (int a = 0; a < 2; ++a)
#pragma unroll
        for (int b = 0; b < 2; ++b)
#pragma unroll
            for (int m = 0; m < 4; ++m)
#pragma unroll
                for (int n = 0; n < 2; ++n) acc[a][b][m][n] = (f32x4){0.f, 0.f, 0.f, 0.f};
    bf16x8 At[4][2], B0[2][2], B1[2][2];
    const char* cA = (const char*)g.A + (size_t)cur.pm * tstep; const char* cB = (const char*)g.Bt + (size_t)cur.pn * tstep;
    if constexpr (SP2) {
        PG8_STAGE(PG8_SB(0, 0), cB, voffB); PG8_STAGE(PG8_SB(0, 1), cB + hstep, voffB); PG8_STAGE(PG8_SA(0, 0), cA, voffA); PG8_STAGE(PG8_SA(0, 1), cA + hstep, voffA);
        if (wr == 1) PG8_BAR;
        PG8_WAIT_V(2); PG8_BAR;
        PG8_STAGE(PG8_SB(1, 0), cB + kstep, voffB); PG8_STAGE(PG8_SA(1, 0), cA + kstep, voffA); PG8_STAGE(PG8_SB(1, 1), cB + hstep + kstep, voffB);
        PG8_WAIT_V(6); PG8_BAR;
    } else {
        PG8_STAGE(PG8_SB(0, 0), cB, voffB); PG8_STAGE(PG8_SA(0, 0), cA, voffA); PG8_STAGE(PG8_SB(0, 1), cB + hstep, voffB); PG8_STAGE(PG8_SA(0, 1), cA + hstep, voffA);
        if (wr == 1) PG8_BAR;
        PG8_WAIT_V(4); PG8_BAR;
        PG8_STAGE(PG8_SB(1, 0), cB + kstep, voffB); PG8_STAGE(PG8_SA(1, 0), cA + kstep, voffA); PG8_STAGE(PG8_SB(1, 1), cB + hstep + kstep, voffB);
        PG8_WAIT_V(6); PG8_BAR;
    }
    for (;;) {
        const bool has_next = S.next(ui + 1, nxt);
        const char* nA = has_next ? (const char*)g.A + (size_t)nxt.pm * tstep : cA; const char* nB = has_next ? (const char*)g.Bt + (size_t)nxt.pn * tstep : cB;
        for (int t = 0; t < nt; t += 2) {
            const bool last = (t == nt - 2);
            const char* a1 = cA + (size_t)(t + 1) * kstep;
            const char* a2 = last ? nA : cA + (size_t)(t + 2) * kstep; const char* b2 = last ? nB : cB + (size_t)(t + 2) * kstep;
            const char* a3 = a2 + kstep; const char* b3 = b2 + kstep;
            if constexpr (SP2) {
            PG8_LDB(B0, 0, 0); PG8_LDB(B1, 0, 1); PG8_SCHED; PG8_LDA(At, 0, 0); PG8_STAGE(PG8_SA(1, 1), a1 + hstep, voffA);
            PG8_WAIT_V(8); PG8_WAIT_L(0); PG8_BAR; PG8_MMA(0, 0, At, B0); PG8_MMA(0, 1, At, B1); PG8_BAR; PG8_SCHED;
            PG8_LDA(At, 0, 1); PG8_STAGE(PG8_SB(0, 0), b2, voffB); PG8_STAGE(PG8_SB(0, 1), b2 + hstep, voffB); PG8_STAGE(PG8_SA(0, 0), a2, voffA);
            PG8_WAIT_V(8); PG8_WAIT_L(0); PG8_BAR; PG8_MMA(1, 0, At, B0); PG8_MMA(1, 1, At, B1); PG8_BAR; PG8_SCHED;
            PG8_LDB(B0, 1, 0); PG8_LDB(B1, 1, 1); PG8_SCHED; PG8_LDA(At, 1, 0); PG8_STAGE(PG8_SA(0, 1), a2 + hstep, voffA);
            PG8_WAIT_V(8); PG8_WAIT_L(0); PG8_BAR; PG8_MMA(0, 0, At, B0); PG8_MMA(0, 1, At, B1); PG8_BAR; PG8_SCHED;
            PG8_LDA(At, 1, 1); PG8_STAGE(PG8_SB(1, 0), b3, voffB); PG8_STAGE(PG8_SB(1, 1), b3 + hstep, voffB); PG8_STAGE(PG8_SA(1, 0), a3, voffA);
            PG8_WAIT_V(8); PG8_WAIT_L(0); PG8_BAR; PG8_MMA(1, 0, At, B0); PG8_MMA(1, 1, At, B1); PG8_BAR; PG8_SCHED;
            } else {
            PG8_LDB(B0, 0, 0); PG8_SCHED; PG8_LDA(At, 0, 0); PG8_STAGE(PG8_SA(1, 1), a1 + hstep, voffA);
            PG8_WAIT_L(8); PG8_BAR; PG8_WAIT_L(0); PG8_MMA(0, 0, At, B0); PG8_BAR; PG8_SCHED;
            PG8_LDB(B1, 0, 1); PG8_STAGE(PG8_SB(0, 0), b2, voffB);
            PG8_BAR; PG8_WAIT_L(0); PG8_MMA(0, 1, At, B1); PG8_BAR;
            PG8_LDA(At, 0, 1); PG8_STAGE(PG8_SA(0, 0), a2, voffA);
            PG8_BAR; PG8_WAIT_L(0); PG8_MMA(1, 0, At, B0); PG8_BAR; PG8_SCHED;
            PG8_STAGE(PG8_SB(0, 1), b2 + hstep, voffB);
            PG8_WAIT_V(6); PG8_BAR; PG8_MMA(1, 1, At, B1); PG8_BAR;
            PG8_LDB(B0, 1, 0); PG8_SCHED; PG8_LDA(At, 1, 0); PG8_STAGE(PG8_SA(0, 1), a2 + hstep, voffA);
            PG8_WAIT_L(8); PG8_BAR; PG8_WAIT_L(0); PG8_MMA(0, 0, At, B0); PG8_BAR; PG8_SCHED;
            PG8_LDB(B1, 1, 1); PG8_STAGE(PG8_SB(1, 0), b3, voffB);
            PG8_BAR; PG8_WAIT_L(0); PG8_MMA(0, 1, At, B1); PG8_BAR;
            PG8_LDA(At, 1, 1); PG8_STAGE(PG8_SA(1, 0), a3, voffA);
            PG8_BAR; PG8_WAIT_L(0); PG8_MMA(1, 0, At, B0); PG8_BAR; PG8_SCHED;
            PG8_STAGE(PG8_SB(1, 1), b3 + hstep, voffB);
            PG8_WAIT_V(6); PG8_BAR; PG8_MMA(1, 1, At, B1); PG8_BAR;
            }
        }
        if constexpr (ALIGN_EPI) { if (wr == 0) PG8_BAR; }
        E(acc, cur, wr, wc, fr, fq);
        if (!has_next) break;
#pragma unroll
        for (int a = 0; a < 2; ++a)
#pragma unroll
            for (int b = 0; b < 2; ++b)
#pragma unroll
                for (int m = 0; m < 4; ++m)
#pragma unroll
                    for (int n = 0; n < 2; ++n) acc[a][b][m][n] = (f32x4){0.f, 0.f, 0.f, 0.f};
        cur = nxt; cA = nA; cB = nB; ++ui;
        if constexpr (ALIGN_EPI) { if (wr == 1) PG8_BAR; }
    }
    PG8_WAIT_V(0);
    if constexpr (!ALIGN_EPI) { if (wr == 0) PG8_BAR; }
    PG8_BAR;
#undef PG8_SA
#undef PG8_SB
#undef PG8_STAGE
#undef PG8_LDA
#undef PG8_LDB
#undef PG8_MMA
#undef PG8_WAIT_V
#undef PG8_WAIT_L
#undef PG8_BAR
#undef PG8_SCHED
}
}
__device__ __forceinline__ float ssq_rinv(const float* ssq, int row) {
    const f32x4* sp = (const f32x4*)(ssq + (size_t)row * 16);
    const f32x4 a = sp[0], b = sp[1], c = sp[2], d = sp[3];
    const float s = ((a[0] + a[1]) + (a[2] + a[3])) + ((b[0] + b[1]) + (b[2] + b[3])) + ((c[0] + c[1]) + (c[2] + c[3])) + ((d[0] + d[1]) + (d[2] + d[3]));
    return rsqrtf(s * (1.f / 1024.f) + 1e-6f);
}
struct EpiProj {
    static constexpr bool PERM = true;
    bf16_t* O; int ldc; const float* ssq; const float* sW; int qcols;
    __device__ __forceinline__ void operator()(const f32x4 (&acc)[2][2][4][2], const pg8::Unit& u, int wr, int wc, int fr, int fq) const {
        const int row0 = u.pm * 256 + wr * 64 + fr, colb = u.pn * 256 + wc * 32 + 8 * fq, b = (u.pm * 256) >> 11;
        const float* sWb = sW + (size_t)b * 4096;
        f32x4 bv[2][2];
#pragma unroll
        for (int bj = 0; bj < 2; ++bj)
#pragma unroll
            for (int n = 0; n < 2; ++n) bv[bj][n] = *(const f32x4*)(sWb + colb + bj * 128 + 4 * n);
#pragma unroll
        for (int ai = 0; ai < 2; ++ai)
#pragma unroll
            for (int m = 0; m < 4; ++m) {
                const int row = row0 + ai * 128 + m * 16; const float rt = ssq_rinv(ssq, row);
                bf16_t* rowp = O + (size_t)row * ldc + colb;
#pragma unroll
                for (int bj = 0; bj < 2; ++bj) {
                    const float sc = (u.pn * 256 + bj * 128 < qcols) ? QSCALE : 1.f;
                    const f32x4 v0 = (acc[ai][bj][m][0] * rt + bv[bj][0]) * sc, v1 = (acc[ai][bj][m][1] * rt + bv[bj][1]) * sc;
                    u32x4 w; w.x = pk2(v0[0], v0[1]); w.y = pk2(v0[2], v0[3]); w.z = pk2(v1[0], v1[1]); w.w = pk2(v1[2], v1[3]);
                    *(u32x4*)(rowp + bj * 128) = w;
                }
            }
    }
};
struct EpiProjT {
    static constexpr bool PERM = true;
    bf16_t* VT; int NV; const float* ssq; const float* sW;   int swap23;
    __device__ __forceinline__ void operator()(const f32x4 (&acc)[2][2][4][2], const pg8::Unit& u, int wr, int wc, int fr, int fq) const {
        const int tok0 = u.pn * 256, b = tok0 >> 11, t0 = tok0 & 2047;
        const int vrow0 = u.pm * 256 + wr * 64 + fr;
        const float* sWb = sW + (size_t)b * 4096;
        bf16_t* base = VT + (size_t)b * NV * 2048 + t0;
#pragma unroll
        for (int bj = 0; bj < 2; ++bj) {
            float rt[2][4];
#pragma unroll
            for (int n = 0; n < 2; ++n)
#pragma unroll
                for (int i = 0; i < 4; ++i) rt[n][i] = ssq_rinv(ssq, tok0 + bj * 128 + wc * 32 + 8 * fq + 4 * n + i);
            const int cl = bj * 128 + wc * 32;
#pragma unroll
            for (int ai = 0; ai < 2; ++ai)
#pragma unroll
                for (int m = 0; m < 4; ++m) {
                    const int vrow = vrow0 + ai * 128 + m * 16; const float bias = sWb[vrow];
                    bf16_t* rowp = base + (size_t)vrow * 2048 + cl;
                    const f32x4 a0 = acc[ai][bj][m][0], a1 = acc[ai][bj][m][1];
                    u32x2 w0, w1;
                    w0.x = pk2(a0[0] * rt[0][0] + bias, a0[1] * rt[0][1] + bias); w0.y = pk2(a0[2] * rt[0][2] + bias, a0[3] * rt[0][3] + bias);
                    w1.x = pk2(a1[0] * rt[1][0] + bias, a1[1] * rt[1][1] + bias); w1.y = pk2(a1[2] * rt[1][2] + bias, a1[3] * rt[1][3] + bias);
                    if (swap23) {
                        *(u32x2*)(rowp + 16 * (fq >> 1) + 4 * (fq & 1)) = w0;
                        *(u32x2*)(rowp + 16 * (fq >> 1) + 8 + 4 * (fq & 1)) = w1;
                    } else {
                        u32x4 w; w.x = w0.x; w.y = w0.y; w.z = w1.x; w.w = w1.y; *(u32x4*)(rowp + 8 * fq) = w;
                    }
                }
        }
    }
};
struct EpiOut {
    static constexpr bool PERM = true;
    const float* xin; float* xout; bf16_t* xg; float* ssq; const float* gate;   const float* gnext; const float* scnext;   int has_next;
    __device__ __forceinline__ void operator()(const f32x4 (&acc)[2][2][4][2], const pg8::Unit& u, int wr, int wc, int fr, int fq) const {
        const int row0 = u.pm * 256 + wr * 64 + fr, colb = u.pn * 256 + wc * 32 + 8 * fq, b = (u.pm * 256) >> 11;
        f32x4 gv[2][2], Gn[2][2];
#pragma unroll
        for (int bj = 0; bj < 2; ++bj)
#pragma unroll
            for (int n = 0; n < 2; ++n) {
                const int col = colb + bj * 128 + 4 * n;
                gv[bj][n] = *(const f32x4*)(gate + (size_t)b * 3072 + col);
                if (has_next) { const f32x4 g = *(const f32x4*)(gnext + col), s = *(const f32x4*)(scnext + (size_t)b * 3072 + col); Gn[bj][n] = g * (s + 1.f); }
                else Gn[bj][n] = (f32x4){0.f, 0.f, 0.f, 0.f};
            }
#pragma unroll
        for (int ai = 0; ai < 2; ++ai)
#pragma unroll
            for (int m = 0; m < 4; ++m) {
                const int row = row0 + ai * 128 + m * 16; float ps = 0.f;
#pragma unroll
                for (int bj = 0; bj < 2; ++bj) {
                    const size_t off = (size_t)row * 1024 + colb + bj * 128;
                    const f32x4 x0 = *(const f32x4*)(xin + off), x1 = *(const f32x4*)(xin + off + 4);
                    const f32x4 y0 = x0 + gv[bj][0] * acc[ai][bj][m][0], y1 = x1 + gv[bj][1] * acc[ai][bj][m][1];
                    *(f32x4*)(xout + off) = y0; *(f32x4*)(xout + off + 4) = y1;
                    ps += (y0[0] * y0[0] + y0[1] * y0[1]) + (y0[2] * y0[2] + y0[3] * y0[3]) + (y1[0] * y1[0] + y1[1] * y1[1]) + (y1[2] * y1[2] + y1[3] * y1[3]);
                    if (has_next) { const f32x4 z0 = y0 * Gn[bj][0], z1 = y1 * Gn[bj][1];
                        u32x4 w; w.x = pk2(z0[0], z0[1]); w.y = pk2(z0[2], z0[3]); w.z = pk2(z1[0], z1[1]); w.w = pk2(z1[2], z1[3]); *(u32x4*)(xg + off) = w; }
                }
                ps += __shfl_xor(ps, 16); ps += __shfl_xor(ps, 32);
                if (fq == 0) ssq[(size_t)row * 16 + u.pn * 4 + wc] = ps;
            }
    }
};

__device__ __forceinline__ int remap_col(int n, int mode) {
    if (mode == 1) return n < 1024 ? n : (n < 1536 ? n + 1536 : n - 512);
    if (mode == 2) return n < 2048 ? n : (n < 3072 ? n + 1024 : n - 1024);
    return n;
}
__device__ __forceinline__ int unmap_col(int c, int odd) {
    if (!odd) return c < 1024 ? c : (c < 2560 ? c + 512 : c - 1536);
    return c < 2048 ? c : (c < 3072 ? c + 1024 : c - 1024);
}
__device__ __forceinline__ void p0_transpose_item(const float* W, int K, int N, bf16_t* WT, int item, LAS float* scr, int lane, int mode) {
    const int nblk = N / 32, kb = item / nblk, nb = item % nblk, k0 = 64 * kb, n0 = 32 * nb;
#pragma unroll 8
    for (int i = 0; i < 32; ++i) { const int kk = 2 * i + (lane >> 5); scr[kk * 33 + (lane & 31)] = W[(size_t)(k0 + kk) * N + n0 + (lane & 31)]; }
    LDS_WAIT(); asm volatile("" ::: "memory");
    const int c = lane & 7;
#pragma unroll
    for (int j = 0; j < 4; ++j) { const int n = (lane >> 3) + 8 * j; const LAS float* s = scr + (8 * c) * 33 + n;
        u32x4 o; o.x = pk2(s[0 * 33], s[1 * 33]); o.y = pk2(s[2 * 33], s[3 * 33]); o.z = pk2(s[4 * 33], s[5 * 33]); o.w = pk2(s[6 * 33], s[7 * 33]);
        *(u32x4*)(WT + (size_t)remap_col(n0 + n, mode) * K + k0 + 8 * c) = o; }
    LDS_WAIT(); asm volatile("" ::: "memory");
}
__device__ __forceinline__ void gemv16_item(const LAS float* vec, const float* W, int ldw, int col0, float* out, int out_ld, int ocol0, const float* bias, int lane) {
    const int n = lane & 15, kq = lane >> 4;
    float acc[16];
#pragma unroll
    for (int b = 0; b < 16; ++b) acc[b] = 0.f;
    const float* wp = W + (size_t)(kq * 256) * ldw + col0 + n; const LAS float* vp = vec + kq * 256;
#pragma unroll 4
    for (int i = 0; i < 256; ++i) {
        const float w = wp[(size_t)i * ldw];
#pragma unroll
        for (int b = 0; b < 16; ++b) acc[b] += vp[b * 1024 + i] * w;
    }
#pragma unroll
    for (int b = 0; b < 16; ++b) { acc[b] += __shfl_xor(acc[b], 16); acc[b] += __shfl_xor(acc[b], 32); }
    if (kq == 0) { const float bs = bias ? bias[col0 + n] : 0.f;
#pragma unroll
        for (int b = 0; b < 16; ++b) out[(size_t)b * out_ld + ocol0 + n] = acc[b] + bs; }
}

__device__ __forceinline__ void phase_p0a(KPC p, const Frame& F) {
    unsigned char* ws = p->ws;
    bf16_t* WtE = (bf16_t*)(ws + WS_WTE); bf16_t* WtO = (bf16_t*)(ws + WS_WTO); bf16_t* WtOut = (bf16_t*)(ws + WS_WTOUT); bf16_t* Wg = (bf16_t*)(ws + WS_WG);
    float* mod = (float*)(ws + WS_MOD); float* scal = (float*)(ws + WS_SCAL);
    LAS float* scr = (LAS float*)(F.lds + F.wave * 8448);
    LAS float* vec = (LAS float*)(F.lds + 73728);
    const int gw = F.vcu * 8 + F.wave, NGW = F.G * 8;
    for (int i = F.tid; i < 16384; i += 512) vec[i] = fsilu(p->c[i]);
    for (int it = gw; it < 9216; it += NGW) {
        int r = it;
        if (r < 3072) { const int e = r / 1536; p0_transpose_item(p->even_w_in + (size_t)e * 1024 * 3072, 1024, 3072, WtE + (size_t)e * 3072 * 1024, r % 1536, scr, F.lane, 1); continue; }
        r -= 3072;
        if (r < 4096) { const int o = r / 2048; p0_transpose_item(p->odd_w_in + (size_t)o * 1024 * 4096, 1024, 4096, WtO + (size_t)o * 4096 * 1024, r % 2048, scr, F.lane, 2); continue; }
        r -= 4096;
        { const int j = r / 512; const int l = (j < 2) ? 2 * j : 2 * (j - 2) + 1; const float* src = (j < 2) ? p->even_w_out + (size_t)j * 1024 * 1024 : p->odd_w_out + (size_t)(j - 2) * 1024 * 1024;
          p0_transpose_item(src, 1024, 1024, WtOut + (size_t)l * 1024 * 1024, r % 512, scr, F.lane, 0); }
    }
    for (int idx = gw * 64 + F.lane; idx < 262144; idx += NGW * 64) {
        const int k = idx & 63, j = (idx >> 6) & 255, n = (idx >> 14) & 7, e = idx >> 17; const int set = j >> 6, d = j & 63, r = set >> 1;
        const float* src = (set & 1) ? p->w_x : p->w_a;
        const float v = src[((((size_t)e * 2 + r) * 8 + n) * 64 + k) * 64 + d];
        Wg[idx] = (bf16_t)(pk2(v, 0.f) & 0xffffu);
    }
    if (F.bx == 0 && F.tid < 2) {
        const int e = F.tid; const float* lp = p->da_lam + e * 256; float s01 = 0.f, s23 = 0.f;
        for (int i = 0; i < 64; ++i) { s01 += lp[i] * lp[64 + i]; s23 += lp[128 + i] * lp[192 + i]; }
        const float lam_init = (e == 0) ? 0.2f : 0.47071302f;
        scal[e * 4 + 0] = expf(s01) - expf(s23) + lam_init; scal[e * 4 + 1] = lam_init;
    }
    __syncthreads();
    for (int it = F.wave * F.G + F.vcu; it < 768; it += NGW) {
        const int l = it / 192, ch = it % 192;
        gemv16_item(vec, p->ada_w + (size_t)l * 1024 * 3072, 3072, ch * 16, mod + (size_t)l * 16 * 3072, 3072, ch * 16, p->ada_b + l * 3072, F.lane);
    }
}
__device__ __forceinline__ void phase_p0b(KPC p, const Frame& F) {
    unsigned char* ws = p->ws;
    const float* mod = (const float*)(ws + WS_MOD); float* sW = (float*)(ws + WS_SW); float* ssq = (float*)(ws + WS_SSQ); bf16_t* xg = (bf16_t*)(ws + WS_XG);
    LAS float* vec = (LAS float*)(F.lds);
    const int l = F.vcu & 3;
    for (int i = F.tid; i < 16384; i += 512) vec[i] = mod[((size_t)l * 16 + (i >> 10)) * 3072 + (i & 1023)];
    __syncthreads();
    {
        const int odd = l & 1, N = odd ? 4096 : 3072;
        const float* W = odd ? p->odd_w_in + (size_t)(l >> 1) * 1024 * 4096 : p->even_w_in + (size_t)(l >> 1) * 1024 * 3072;
        for (int it = (F.vcu >> 2) * 8 + F.wave; it < N / 16; it += (F.G >> 2) * 8)
            gemv16_item(vec, W, N, unmap_col(it * 16, odd), sW + (size_t)l * 16 * 4096, 4096, it * 16, nullptr, F.lane);
    }
    const int gw = F.vcu * 8 + F.wave, NGW = F.G * 8;
    for (int row = gw; row < MTOK; row += NGW) {
        const int b = row >> 11;
        const f32x4* xr = (const f32x4*)(p->x + (size_t)row * 1024) + F.lane;
        f32x4 v[4]; float s = 0.f;
#pragma unroll
        for (int j = 0; j < 4; ++j) { v[j] = xr[64 * j]; s += (v[j][0] * v[j][0] + v[j][1] * v[j][1]) + (v[j][2] * v[j][2] + v[j][3] * v[j][3]); }
        s = wave_sum(s);
        unsigned long long* o8 = (unsigned long long*)(xg + (size_t)row * 1024) + F.lane;
#pragma unroll
        for (int j = 0; j < 4; ++j) {
            const int k = 4 * F.lane + 256 * j;
            const f32x4 g = *(const f32x4*)(p->norm_g + k), sc = *(const f32x4*)(mod + (size_t)b * 3072 + 1024 + k);
            const f32x4 z = v[j] * g * (sc + 1.f);
            o8[64 * j] = (unsigned long long)pk2(z[0], z[1]) | ((unsigned long long)pk2(z[2], z[3]) << 32);
        }
        if (F.lane < 16) ssq[(size_t)row * 16 + F.lane] = (F.lane == 0) ? s : 0.f;
    }
}
__device__ __forceinline__ void phase_final(KPC p, const Frame& F) {
    const float* ssq = (const float*)(p->ws + WS_SSQ);
    const int gw = F.vcu * 8 + F.wave, NGW = F.G * 8;
    for (int row = gw; row < MTOK; row += NGW) {
        const float rt = ssq_rinv(ssq, row);
        f32x4* xr = (f32x4*)(p->out + (size_t)row * 1024) + F.lane;
#pragma unroll
        for (int j = 0; j < 4; ++j) { const f32x4 g = *(const f32x4*)(p->final_g + 4 * F.lane + 256 * j); xr[64 * j] = xr[64 * j] * rt * g; }
    }
}
#define MFMA32(a, b, c) __builtin_amdgcn_mfma_f32_32x32x16_bf16((a), (b), (c), 0, 0, 0)
#define MFMA16(a, b, c) __builtin_amdgcn_mfma_f32_16x16x32_bf16((a), (b), (c), 0, 0, 0)
__device__ __forceinline__ float frcp(float v) { return __builtin_amdgcn_rcpf(v); }
__device__ __forceinline__ float fsigm_fast(float v) { return frcp(1.f + __expf(-v)); }
template <int VAR> __device__ __forceinline__ void attn_run(KPC p, const Frame& F, int e_layer, float lam, float lam_init, bf16_t* mixed, int a0, int astride, int count) {
    const int tid = F.tid, lane = F.lane, r = lane & 31, hh = lane >> 5, m = F.wave & 1, sub = F.wave >> 1, grp = F.wave >> 2;
    const bf16_t* P = (const bf16_t*)(p->ws + WS_PROJ); const bf16_t* VT = (const bf16_t*)(p->ws + WS_VT);
    LAS unsigned char* lds = F.lds;
    LAS float* lutall = (LAS float*)(lds + 98304); LAS float* SG = (LAS float*)(lds + 106496); LAS float* SSX = (LAS float*)(lds + 107520); LAS float* X = (LAS float*)(lds + 110592) + sub * 2048;
    for (int i = tid; i < 2048; i += 512) { const int hd = i >> 9, idx = i & 511; lutall[i] = (idx < 511) ? p->t5[hd * 32 + t5_bucket(idx - 255)] * LOG2E : 0.f; }
    if (tid < 128) SG[tid] = p->da_subg[e_layer * 128 + tid] * (1.f - lam_init);
    const int skey = (tid >> 3) & 63, ve0 = tid >> 3, sch = (tid & 7) ^ ((skey >> 1) & 7);
    const unsigned dmaw = (unsigned)F.wave * 1024u;
    const unsigned swz = (unsigned)((r >> 1) & 7);
#define ATT_DMA(stage_off, ks_, vs_) do { \
        __builtin_amdgcn_global_load_lds((const unsigned*)(ks_), (LAS unsigned*)(lds + (stage_off) + dmaw), 16, 0, 0); \
        __builtin_amdgcn_global_load_lds((const unsigned*)((ks_) + 64), (LAS unsigned*)(lds + (stage_off) + 8192 + dmaw), 16, 0, 0); \
        __builtin_amdgcn_global_load_lds((const unsigned*)(vs_), (LAS unsigned*)(lds + (stage_off) + 16384 + dmaw), 16, 0, 0); \
        __builtin_amdgcn_global_load_lds((const unsigned*)((vs_) + (size_t)64 * 2048), (LAS unsigned*)(lds + (stage_off) + 24576 + dmaw), 16, 0, 0); } while (0)
    bf16x8 qf[4];
    {
        const int a = a0, b = a >> 6, h = (a >> 4) & 3, qb = a & 15;
        const bf16_t* ksrc0 = P + ((size_t)b * 2048 + skey) * 2560 + 512 + h * 128 + sch * 8;
        const bf16_t* vsrc0 = VT + ((size_t)(b * 512 + h * 128 + ve0)) * 2048 + sch * 8;
#pragma unroll
        for (int t = 0; t < 2; ++t) ATT_DMA(t * 32768, ksrc0 + (size_t)t * 64 * 2560, vsrc0 + t * 64);
        const bf16_t* qp = P + ((size_t)b * 2048 + qb * 128 + sub * 32 + r) * 2560 + h * 128 + m * 64 + hh * 8;
#pragma unroll
        for (int s = 0; s < 4; ++s) qf[s] = *(const bf16x8*)(qp + 16 * s);
    }
    asm volatile("s_waitcnt vmcnt(0)" ::: "memory");
    __syncthreads();
    int T = 0;
    for (int k = 0; k < count; ++k) {
        const int a = a0 + k * astride, b = a >> 6, h = (a >> 4) & 3, qb = a & 15;
        const int an = (k + 1 < count) ? a + astride : a, bn = an >> 6, hn = (an >> 4) & 3, qbn = an & 15;
        const size_t tokbase = (size_t)b * 2048; const int q0w = qb * 128 + sub * 32;
        const bf16_t* ksrc0 = P + (tokbase + skey) * 2560 + 512 + h * 128 + sch * 8;
        const bf16_t* vsrc0 = VT + ((size_t)(b * 512 + h * 128 + ve0)) * 2048 + sch * 8;
        const bf16_t* ksrcN = P + ((size_t)bn * 2048 + skey) * 2560 + 512 + hn * 128 + sch * 8;
        const bf16_t* vsrcN = VT + ((size_t)(bn * 512 + hn * 128 + ve0)) * 2048 + sch * 8;
        LAS float* lut = lutall + h * 512;
        const float cL = lut[0], cR = lut[510];
        f32x16 O[4];
#pragma unroll
        for (int et = 0; et < 4; ++et)
#pragma unroll
            for (int i = 0; i < 16; ++i) O[et][i] = 0.f;
        constexpr float THR = 8.f;
        float m_run = 0.f, l_run = 0.f;
        if constexpr (!(VAR & 16)) { if (grp == 1) __builtin_amdgcn_s_barrier(); }
        for (int j = 0; j < ((VAR & 128) ? 1 : 32); ++j) {
            const int st = (T % 3) * 32768;
            const bool own = j < 30; const int tl = own ? j + 2 : j - 30;
            const bf16_t* ksn = (own ? ksrc0 : ksrcN) + (size_t)tl * 64 * 2560; const bf16_t* vsn = (own ? vsrc0 : vsrcN) + tl * 64;
            const int sn = ((T + 2) % 3) * 32768;
            if constexpr (!(VAR & 8)) { if (grp == 1) ATT_DMA(sn, ksn, vsn); }
            const LAS unsigned char* kb = lds + st + m * 8192; const LAS unsigned char* vb = lds + st + 16384;
            f32x16 S0, S1;
            { const int rel_max = 64 * j + 63 - q0w, rel_min = 64 * j - (q0w + 31);
              if (rel_max <= -91 || rel_min >= 91) { const float cv = ((rel_max <= -91) ? cL : cR) - m_run;
#pragma unroll
                  for (int i = 0; i < 16; ++i) { S0[i] = cv; S1[i] = cv; }
              } else {
                  const int ib = 64 * j + 4 * hh - (q0w + r) + 255;
#pragma unroll
                  for (int i = 0; i < 16; ++i) { const int idx = ib + (i & 3) + 8 * (i >> 2); S0[i] = lut[idx] - m_run; S1[i] = lut[idx + 32] - m_run; }
              } }
#pragma unroll
            for (int s = 0; s < 4; ++s) {
                const unsigned co = (((unsigned)(2 * s + hh)) ^ swz) << 4;
                bf16x8 a0v, a1v;
                if constexpr (!(VAR & 64)) { a0v = *(const LAS bf16x8*)(kb + r * 128 + co); a1v = *(const LAS bf16x8*)(kb + (32 + r) * 128 + co); } else { a0v = qf[s]; a1v = qf[(s + 1) & 3]; }
                if constexpr (!(VAR & 4)) { S0 = MFMA32(a0v, qf[s], S0); S1 = MFMA32(a1v, qf[s], S1); } else { asm volatile("" :: "v"(a0v), "v"(a1v)); }
            }
            if constexpr (!(VAR & 1)) {
                float mxa = fmaxf(fmaxf(S0[0], S0[1]), S1[0]), mxb = fmaxf(fmaxf(S0[2], S0[3]), S1[1]);
                mxa = fmaxf(fmaxf(mxa, S1[2]), S1[3]);
#pragma unroll
                for (int i = 4; i < 16; i += 4) { mxa = fmaxf(fmaxf(mxa, S0[i]), S0[i + 1]); mxb = fmaxf(fmaxf(mxb, S0[i + 2]), S0[i + 3]); mxa = fmaxf(fmaxf(mxa, S1[i]), S1[i + 1]); mxb = fmaxf(fmaxf(mxb, S1[i + 2]), S1[i + 3]); }
                float mx = fmaxf(mxa, mxb);
                mx = fmaxf(mx, __shfl_xor(mx, 32));
                if (j == 0 || __any(mx > THR)) {
                    const float dl = (j == 0 || mx > THR) ? mx : 0.f;
                    const float alpha = ex2(-dl); m_run += dl; l_run *= alpha;
#pragma unroll
                    for (int i = 0; i < 16; ++i) { S0[i] -= dl; S1[i] -= dl; }
#pragma unroll
                    for (int et = 0; et < 4; ++et)
#pragma unroll
                        for (int i = 0; i < 16; ++i) O[et][i] *= alpha;
                }
                float lsa = 0.f, lsb = 0.f;
#pragma unroll
                for (int i = 0; i < 16; ++i) { S0[i] = ex2(S0[i]); S1[i] = ex2(S1[i]); lsa += S0[i]; lsb += S1[i]; }
                l_run += lsa + lsb;
            }
            bf16x8 pf[4];
            { u32x4 w;
              w.x = pk2(S0[0], S0[1]); w.y = pk2(S0[2], S0[3]); w.z = pk2(S0[4], S0[5]); w.w = pk2(S0[6], S0[7]); pf[0] = __builtin_bit_cast(bf16x8, w);
              w.x = pk2(S0[8], S0[9]); w.y = pk2(S0[10], S0[11]); w.z = pk2(S0[12], S0[13]); w.w = pk2(S0[14], S0[15]); pf[1] = __builtin_bit_cast(bf16x8, w);
              w.x = pk2(S1[0], S1[1]); w.y = pk2(S1[2], S1[3]); w.z = pk2(S1[4], S1[5]); w.w = pk2(S1[6], S1[7]); pf[2] = __builtin_bit_cast(bf16x8, w);
              w.x = pk2(S1[8], S1[9]); w.y = pk2(S1[10], S1[11]); w.z = pk2(S1[12], S1[13]); w.w = pk2(S1[14], S1[15]); pf[3] = __builtin_bit_cast(bf16x8, w); }
            if constexpr (!(VAR & 16)) { if (grp == 1) asm volatile("s_waitcnt vmcnt(4) lgkmcnt(0)\n\ts_barrier" ::: "memory"); else asm volatile("s_waitcnt lgkmcnt(0)\n\ts_barrier" ::: "memory"); }
            if constexpr (!(VAR & 8)) { if (grp == 0) ATT_DMA(sn, ksn, vsn); }
            if (j == 31) {
                const bf16_t* qp = P + ((size_t)bn * 2048 + qbn * 128 + sub * 32 + r) * 2560 + hn * 128 + m * 64 + hh * 8;
#pragma unroll
                for (int s = 0; s < 4; ++s) qf[s] = *(const bf16x8*)(qp + 16 * s);
            }
#pragma unroll
            for (int et = 0; et < 4; ++et)
#pragma unroll
                for (int s = 0; s < 4; ++s) {
                    bf16x8 av;
                    if constexpr (!(VAR & 64)) av = *(const LAS bf16x8*)(vb + (32 * et + r) * 128 + ((((unsigned)(2 * s + hh)) ^ swz) << 4)); else av = pf[(s + et) & 3];
                    if constexpr (!(VAR & 2)) O[et] = MFMA32(av, pf[s], O[et]); else asm volatile("" :: "v"(av), "v"(pf[s]));
                }
            if constexpr (!(VAR & 16)) {
                if (grp == 0) { if (j == 31) asm volatile("s_waitcnt vmcnt(8) lgkmcnt(0)\n\ts_barrier" ::: "memory"); else asm volatile("s_waitcnt vmcnt(4) lgkmcnt(0)\n\ts_barrier" ::: "memory"); }
                else asm volatile("s_waitcnt lgkmcnt(0)\n\ts_barrier" ::: "memory");
            }
            ++T;
        }
        if constexpr (!(VAR & 16)) { if (grp == 0) __builtin_amdgcn_s_barrier(); }
        const size_t tok = tokbase + q0w + r;
        const int et0 = 2 * m;
        u32x2 gav[8];
#pragma unroll
        for (int t = 0; t < 2; ++t)
#pragma unroll
            for (int g4 = 0; g4 < 4; ++g4) gav[t * 4 + g4] = *(const u32x2*)(P + tok * 2560 + 1024 + h * 128 + 32 * (et0 + t) + 8 * g4 + 4 * hh);
        l_run += __shfl_xor(l_run, 32);
        const float inv = __builtin_amdgcn_rcpf(l_run);
        f32x16 D0, D1;
        if (m == 1) {
#pragma unroll
            for (int i = 0; i < 16; ++i) { X[i * 64 + lane] = O[0][i] * inv; X[(16 + i) * 64 + lane] = O[1][i] * inv; }
        }
        __syncthreads();
        if (m == 0) {
#pragma unroll
            for (int i = 0; i < 16; ++i) { D0[i] = O[0][i] * inv - lam * X[i * 64 + lane]; D1[i] = O[1][i] * inv - lam * X[(16 + i) * 64 + lane]; }
        }
        __syncthreads();
        if (m == 0) {
#pragma unroll
            for (int i = 0; i < 16; ++i) { X[i * 64 + lane] = O[2][i] * inv; X[(16 + i) * 64 + lane] = O[3][i] * inv; }
        }
        __syncthreads();
        if (m == 1) {
#pragma unroll
            for (int i = 0; i < 16; ++i) { D0[i] = X[i * 64 + lane] - lam * O[2][i] * inv; D1[i] = X[(16 + i) * 64 + lane] - lam * O[3][i] * inv; }
        }
        float ss = 0.f;
#pragma unroll
        for (int i = 0; i < 16; ++i) ss += D0[i] * D0[i] + D1[i] * D1[i];
        ss += __shfl_xor(ss, 32);
        if (hh == 0) SSX[F.wave * 32 + r] = ss;
        __syncthreads();
        ss += SSX[(F.wave ^ 1) * 32 + r];
        const float rinv = rsqrtf(ss * (1.f / 128.f) + 1e-6f);
        if constexpr (!(VAR & 512)) {
#pragma unroll
            for (int t = 0; t < 2; ++t)
#pragma unroll
                for (int g4 = 0; g4 < 4; ++g4) {
                    const int e0 = 32 * (et0 + t) + 8 * g4 + 4 * hh;
                    const f32x4 sg = *(const LAS f32x4*)(SG + e0);
                    const u32x2 ga = gav[t * 4 + g4];
                    const float g0 = bflo(ga.x), g1 = bfhi(ga.x), g2 = bflo(ga.y), g3 = bfhi(ga.y);
                    const float d0 = t ? D1[4 * g4 + 0] : D0[4 * g4 + 0], d1 = t ? D1[4 * g4 + 1] : D0[4 * g4 + 1], d2 = t ? D1[4 * g4 + 2] : D0[4 * g4 + 2], d3 = t ? D1[4 * g4 + 3] : D0[4 * g4 + 3];
                    u32x2 w; w.x = pk2(d0 * rinv * sg[0] * g0 * fsigm_fast(g0), d1 * rinv * sg[1] * g1 * fsigm_fast(g1)); w.y = pk2(d2 * rinv * sg[2] * g2 * fsigm_fast(g2), d3 * rinv * sg[3] * g3 * fsigm_fast(g3));
                    *(u32x2*)(mixed + tok * 1024 + h * 128 + e0) = w;
                }
        }
    }
    __syncthreads();
}

template <int dir> __device__ __forceinline__ void lru_pass(KPC p, const Frame& F, int e_layer, int b, int n, int hf) {
    const int tid = F.tid, lane = F.lane, wave = F.wave;
    const bf16_t* P = (const bf16_t*)(p->ws + WS_PROJ); bf16_t* mixed = (bf16_t*)(p->ws + WS_MIXED); float* HF = (float*)(p->ws + WS_XG);
    const bf16_t* Wg = (const bf16_t*)(p->ws + WS_WG) + ((size_t)(e_layer * 8 + n)) * 256 * 64;
    LAS unsigned char* lds = F.lds;
    LAS unsigned char* XA = lds; LAS float* XC = (LAS float*)(lds + 16384); LAS f32x2_t* PH = (LAS f32x2_t*)(lds + 34816); LAS float* Cc = (LAS float*)(lds + 36864);
    const size_t tokbase = (size_t)b * 2048;
    const int cg = tid & 7, tp = tid >> 3;
    f32x4 cwa[4], cwb[4], cba, cbb;
    { const float* cwp = p->conv_w + (size_t)e_layer * 4 * 512 + n * 64 + cg * 8;
#pragma unroll
      for (int j = 0; j < 4; ++j) { cwa[j] = *(const f32x4*)(cwp + j * 512); cwb[j] = *(const f32x4*)(cwp + j * 512 + 4); }
      const float* cbp = p->conv_b + e_layer * 512 + n * 64 + cg * 8; cba = *(const f32x4*)(cbp); cbb = *(const f32x4*)(cbp + 4); }
    const bf16_t* xcol = P + tokbase * 2560 + 1536 + n * 64 + cg * 8;
    const int mt = wave, col = lane & 15, kq = lane >> 4;
    const int kqo = dir ? 3 - kq : kq, wo = dir ? 7 - mt : mt;
    bf16x8 wf[2][2][2];
    float ba[2], bx[2], sp[2];
#pragma unroll
    for (int jj = 0; jj < 2; ++jj) {
        const int ch = 32 * hf + 16 * jj + col;
#pragma unroll
        for (int gs = 0; gs < 2; ++gs)
#pragma unroll
            for (int ks = 0; ks < 2; ++ks) wf[jj][gs][ks] = *(const bf16x8*)(Wg + (size_t)((2 * dir + gs) * 64 + ch) * 64 + 32 * ks + 8 * kq);
        ba[jj] = p->b_a[(e_layer * 2 + dir) * 512 + n * 64 + ch]; bx[jj] = p->b_x[(e_layer * 2 + dir) * 512 + n * 64 + ch];
        const float y = -p->lru_lam[(e_layer * 2 + dir) * 512 + n * 64 + ch]; sp[jj] = -8.f * (fmaxf(y, 0.f) + log1pf(expf(-fabsf(y))));
    }
    if (tid < 64) Cc[tid] = 0.f;
    u32x4 xr[5];
    { const int t0 = (dir ? 15 : 0) * 128;
#pragma unroll
      for (int k = 0; k < 5; ++k) { int tt = t0 + 2 * tp - 2 + k; tt = tt < 0 ? 0 : (tt > 2047 ? 2047 : tt); xr[k] = *(const u32x4*)(xcol + (size_t)tt * 2560); } }
    for (int cc = 0; cc < 16; ++cc) {
        const int chunk = dir ? 15 - cc : cc; const int t0 = chunk * 128; const int par = cc & 1;
        u32x4 xc5[5];
#pragma unroll
        for (int k = 0; k < 5; ++k) { const int tt = t0 + 2 * tp - 2 + k; const bool ok = (tt >= 0) && (tt < 2048); xc5[k] = xr[k]; if (!ok) xc5[k] = (u32x4){0u, 0u, 0u, 0u}; }
        { const int cn = (cc + 1 < 16) ? cc + 1 : cc; const int t1 = (dir ? 15 - cn : cn) * 128;
#pragma unroll
            for (int k = 0; k < 5; ++k) { int tt = t1 + 2 * tp - 2 + k; tt = tt < 0 ? 0 : (tt > 2047 ? 2047 : tt); xr[k] = *(const u32x4*)(xcol + (size_t)tt * 2560); } }
        float hfv[2][4]; bf16_t gvv[2][4];
        if (dir) {
#pragma unroll
            for (int jj = 0; jj < 2; ++jj)
#pragma unroll
                for (int i = 0; i < 4; ++i) { const size_t tok = tokbase + t0 + 16 * mt + 4 * kq + i; const int ch = n * 64 + 32 * hf + 16 * jj + col;
                    hfv[jj][i] = HF[tok * 512 + ch]; gvv[jj][i] = P[tok * 2560 + 2048 + ch]; }
        }
#pragma unroll
        for (int i = 0; i < 2; ++i) {
            const int tl = 2 * tp + i;
            f32x4 va = cba, vb = cbb;
#pragma unroll
            for (int j = 0; j < 4; ++j) { const u32x4 x = xc5[i + j];
                va += cwa[j] * (f32x4){bflo(x.x), bfhi(x.x), bflo(x.y), bfhi(x.y)}; vb += cwb[j] * (f32x4){bflo(x.z), bfhi(x.z), bflo(x.w), bfhi(x.w)}; }
            u32x4 w; w.x = pk2(va[0], va[1]); w.y = pk2(va[2], va[3]); w.z = pk2(vb[0], vb[1]); w.w = pk2(vb[2], vb[3]);
            *(LAS u32x4*)(XA + tl * 128 + ((((unsigned)cg) ^ ((unsigned)(tl >> 1) & 7u)) << 4)) = w;
            if ((cg >> 2) == hf) { LAS float* xp = XC + tl * 36 + (cg & 3) * 8; *(LAS f32x4*)(xp) = va; *(LAS f32x4*)(xp + 4) = vb; }
        }
        __syncthreads();
        f32x4 acc[2][2];
#pragma unroll
        for (int jj = 0; jj < 2; ++jj)
#pragma unroll
            for (int gs = 0; gs < 2; ++gs) acc[jj][gs] = (f32x4){0.f, 0.f, 0.f, 0.f};
#pragma unroll
        for (int ks = 0; ks < 2; ++ks) {
            const int row = 16 * mt + col;
            const bf16x8 a = *(const LAS bf16x8*)(XA + row * 128 + ((((unsigned)(4 * ks + kq)) ^ ((unsigned)(row >> 1) & 7u)) << 4));
#pragma unroll
            for (int jj = 0; jj < 2; ++jj)
#pragma unroll
                for (int gs = 0; gs < 2; ++gs) acc[jj][gs] = MFMA16(a, wf[jj][gs][ks], acc[jj][gs]);
        }
        float hl[2][4], Pp[2][4], Pex[2], Hex[2];
#pragma unroll
        for (int jj = 0; jj < 2; ++jj) {
            const int chl = 16 * jj + col;
            float av[4], uv[4];
#pragma unroll
            for (int i = 0; i < 4; ++i) {
                const int tl = 16 * mt + 4 * kq + i;
                const float ga = fsigm_fast(acc[jj][0][i] + ba[jj]), gx = fsigm_fast(acc[jj][1][i] + bx[jj]);
                const float log_a = ga * sp[jj]; const float a = __expf(log_a); const float y2 = 2.f * log_a;
                const float om = (y2 > -0.1f) ? -(y2 * (1.f + y2 * (0.5f + y2 * (0.16666667f + y2 * 0.041666668f)))) : 1.f - a * a;
                av[i] = a; uv[i] = __builtin_amdgcn_sqrtf(om) * gx * XC[tl * 36 + chl];
            }
            if (!dir) { hl[jj][0] = uv[0]; Pp[jj][0] = av[0];
#pragma unroll
                for (int i = 1; i < 4; ++i) { hl[jj][i] = av[i] * hl[jj][i - 1] + uv[i]; Pp[jj][i] = av[i] * Pp[jj][i - 1]; }
            } else { hl[jj][3] = uv[3]; Pp[jj][3] = av[3];
#pragma unroll
                for (int i = 2; i >= 0; --i) { hl[jj][i] = av[i] * hl[jj][i + 1] + uv[i]; Pp[jj][i] = av[i] * Pp[jj][i + 1]; }
            }
            float Pi = dir ? Pp[jj][0] : Pp[jj][3], Hi = dir ? hl[jj][0] : hl[jj][3];
            { const float Pq = dir ? __shfl_down(Pi, 16) : __shfl_up(Pi, 16), Hq = dir ? __shfl_down(Hi, 16) : __shfl_up(Hi, 16);
              if (kqo >= 1) { Hi = Pi * Hq + Hi; Pi = Pi * Pq; } }
            { const float Pq = dir ? __shfl_down(Pi, 32) : __shfl_up(Pi, 32), Hq = dir ? __shfl_down(Hi, 32) : __shfl_up(Hi, 32);
              if (kqo >= 2) { Hi = Pi * Hq + Hi; Pi = Pi * Pq; } }
            { const float Pq = dir ? __shfl_down(Pi, 16) : __shfl_up(Pi, 16), Hq = dir ? __shfl_down(Hi, 16) : __shfl_up(Hi, 16);
              Pex[jj] = (kqo >= 1) ? Pq : 1.f; Hex[jj] = (kqo >= 1) ? Hq : 0.f; }
            if (kqo == 3) PH[mt * 32 + chl] = (f32x2_t){Pi, Hi};
        }
        __syncthreads();
#pragma unroll
        for (int jj = 0; jj < 2; ++jj) {
            const int chl = 16 * jj + col;
            float cw_ = Cc[par * 32 + chl];
            f32x2_t ph[7];
#pragma unroll
            for (int s = 0; s < 7; ++s) ph[s] = PH[(dir ? 7 - s : s) * 32 + chl];
#pragma unroll
            for (int s = 0; s < 7; ++s) cw_ = (s < wo) ? ph[s].x * cw_ + ph[s].y : cw_;
            const float cin = Pex[jj] * cw_ + Hex[jj];
#pragma unroll
            for (int i = 0; i < 4; ++i) hl[jj][i] += Pp[jj][i] * cin;
            if (wo == 7 && kqo == 3) Cc[(par ^ 1) * 32 + chl] = dir ? hl[jj][0] : hl[jj][3];
#pragma unroll
            for (int i = 0; i < 4; ++i) {
                const size_t tok = tokbase + t0 + 16 * mt + 4 * kq + i; const int ch = n * 64 + 32 * hf + chl;
                if (!dir) HF[tok * 512 + ch] = hl[jj][i];
                else { const float g = bf2f(gvv[jj][i]); mixed[tok * 1024 + 512 + ch] = (bf16_t)(pk2((hfv[jj][i] + hl[jj][i]) * g * fsigm_fast(g), 0.f) & 0xffffu); }
            }
        }
    }
    asm volatile("s_waitcnt vmcnt(0)" ::: "memory");
    __syncthreads();
}
__device__ __forceinline__ void lru_unit(KPC p, const Frame& F, int e_layer, int b, int n, int hf) {
    lru_pass<0>(p, F, e_layer, b, n, hf);
    lru_pass<1>(p, F, e_layer, b, n, hf);
}

template <int VAR> __device__ __forceinline__ void na_unit(KPC p, const Frame& F, int o_layer, int b, int h, bf16_t* mixed) {
    const int tid = F.tid, lane = F.lane, wave = F.wave;
    const bf16_t* P = (const bf16_t*)(p->ws + WS_PROJ); const bf16_t* VT = (const bf16_t*)(p->ws + WS_VT);
    LAS unsigned char* lds = F.lds; LAS unsigned char* KL = lds; LAS unsigned char* VTL = lds + 73728; LAS float* rpbs = (LAS float*)(lds + 148480);
    const size_t tokbase = (size_t)b * 2048;
    const int skey = tid >> 3, sch = tid & 7;
    const bf16_t* ksrc = P + (tokbase + skey) * 3072 + 1024 + h * 64 + sch * 8;
    const bf16_t* vsrc = VT + ((size_t)(b * 1024 + h * 64 + skey)) * 2048 + sch * 8;
    const unsigned kdst = (unsigned)(skey * 128 + ((sch ^ ((skey >> 1) & 7)) << 4));
    const unsigned vdst = (unsigned)(73728 + skey * 1168 + sch * 16);
    if (tid < 465) rpbs[tid] = p->rpb[((size_t)o_layer * 16 + h) * 465 + tid] * LOG2E;
    if constexpr (!(VAR & 256)) { u32x4 kr[9], vr[9];
#pragma unroll
      for (int r = 0; r < 9; ++r) { kr[r] = *(const u32x4*)(ksrc + (size_t)r * 64 * 3072); vr[r] = *(const u32x4*)(vsrc + r * 64); }
#pragma unroll
      for (int r = 0; r < 9; ++r) { *(LAS u32x4*)(lds + kdst + r * 8192) = kr[r]; *(LAS u32x4*)(lds + vdst + r * 128) = vr[r]; } }
    const int ri = wave >> 2, g = wave & 3, c0 = 16 * g, kc0 = (g == 0) ? 0 : (g == 1 ? 8 : (g == 2 ? 24 : 32));
    const int q = lane & 15, kq = lane >> 4;
    const int c = c0 + q; int cs = c - 8; cs = cs < 0 ? 0 : (cs > 48 ? 48 : cs);
    f32x4 BT[8][2]; int boff = -1;
    bf16x8 qf[2]; u32x2 gf[4];
    { const size_t tok = tokbase + ri * 64 + c0 + q;
#pragma unroll
      for (int ks = 0; ks < 2; ++ks) qf[ks] = *(const bf16x8*)(P + tok * 3072 + h * 64 + 32 * ks + 8 * kq);
#pragma unroll
      for (int et = 0; et < 4; ++et) gf[et] = *(const u32x2*)(P + tok * 3072 + 2048 + h * 64 + 16 * et + 4 * kq); }
    for (int rp = 0; rp < ((VAR & 128) ? 1 : 16); ++rp) {
        const int r0 = 2 * rp; int rb = r0 - 4; rb = rb < 0 ? 0 : (rb > 24 ? 24 : rb); int rbn = r0 - 2; rbn = rbn < 0 ? 0 : (rbn > 24 ? 24 : rbn);
        const int newA = rb + 9, newB = rb + 10; const bool do_new = rbn > rb; const bool validA = do_new && newA < 32, validB = do_new && newB < 32;
        const int la = newA < 31 ? newA : 31, lb = newB < 31 ? newB : 31;
        if constexpr (!(VAR & 16)) __syncthreads();
        u32x4 kn0 = {0u,0u,0u,0u}, kn1 = kn0, vn0 = kn0, vn1 = kn0;
        if constexpr (!(VAR & 8)) { kn0 = *(const u32x4*)(ksrc + (size_t)la * 64 * 3072); kn1 = *(const u32x4*)(ksrc + (size_t)lb * 64 * 3072); vn0 = *(const u32x4*)(vsrc + la * 64); vn1 = *(const u32x4*)(vsrc + lb * 64); }
        bf16x8 qn[2]; u32x2 gn[4];
        { int rn = r0 + 2 + ri; rn = rn > 31 ? 31 : rn; const size_t tokn = tokbase + rn * 64 + c0 + q;
#pragma unroll
          for (int ks = 0; ks < 2; ++ks) qn[ks] = *(const bf16x8*)(P + tokn * 3072 + h * 64 + 32 * ks + 8 * kq);
#pragma unroll
          for (int et = 0; et < 4; ++et) gn[et] = *(const u32x2*)(P + tokn * 3072 + 2048 + h * 64 + 16 * et + 4 * kq); }
        {
            const int rr = r0 + ri; int rs = rr - 4; rs = rs < 0 ? 0 : (rs > 24 ? 24 : rs);
            const size_t tok = tokbase + rr * 64 + c0 + q;
            const int off = rr - rs;
            if (off != boff) {
                boff = off;
#pragma unroll
                for (int i = 0; i < 8; ++i)
#pragma unroll
                    for (int a = 0; a < 2; ++a)
#pragma unroll
                        for (int j = 0; j < 4; ++j) {
                            const int kc = kc0 + 16 * a + 4 * kq + j; const bool valid = (kc >= cs) && (kc < cs + 16);
                            int dc = kc - c + 15; dc = dc < 0 ? 0 : (dc > 30 ? 30 : dc);
                            const float bias = rpbs[(i - off + 7) * 31 + dc];
                            BT[i][a][j] = valid ? bias : -1e30f;
                        }
            }
            f32x4 S[8][2];
#pragma unroll
            for (int i = 0; i < 8; ++i) {
                const int li = (rs + i) % 9;
#pragma unroll
                for (int a = 0; a < 2; ++a) {
                    const int keyl = li * 64 + kc0 + 16 * a + q;
                    f32x4 acc = BT[i][a];
#pragma unroll
                    for (int ks = 0; ks < 2; ++ks) {
                        bf16x8 A; if constexpr (!(VAR & 64)) A = *(const LAS bf16x8*)(KL + keyl * 128 + ((((unsigned)(4 * ks + kq)) ^ ((unsigned)(keyl >> 1) & 7u)) << 4)); else A = qf[ks ^ 1];
                        if constexpr (!(VAR & 4)) acc = MFMA16(A, qf[ks], acc); else asm volatile("" :: "v"(A));
                    }
                    S[i][a] = acc;
                }
            }
            float l = 1.f;
            if constexpr (!(VAR & 1)) {
            float mx = -1e30f;
#pragma unroll
            for (int i = 0; i < 8; ++i)
#pragma unroll
                for (int a = 0; a < 2; ++a)
#pragma unroll
                    for (int j = 0; j < 4; ++j) mx = fmaxf(mx, S[i][a][j]);
            mx = fmaxf(mx, __shfl_xor(mx, 16)); mx = fmaxf(mx, __shfl_xor(mx, 32));
            l = 0.f;
#pragma unroll
            for (int i = 0; i < 8; ++i)
#pragma unroll
                for (int a = 0; a < 2; ++a)
#pragma unroll
                    for (int j = 0; j < 4; ++j) { const float e = ex2(S[i][a][j] - mx); S[i][a][j] = e; l += e; }
            l += __shfl_xor(l, 16); l += __shfl_xor(l, 32);
            }
            f32x4 O[4];
#pragma unroll
            for (int et = 0; et < 4; ++et) O[et] = (f32x4){0.f, 0.f, 0.f, 0.f};
#pragma unroll
            for (int i = 0; i < 8; ++i) {
                const int li = (rs + i) % 9;
                u32x4 w; w.x = pk2(S[i][0][0], S[i][0][1]); w.y = pk2(S[i][0][2], S[i][0][3]); w.z = pk2(S[i][1][0], S[i][1][1]); w.w = pk2(S[i][1][2], S[i][1][3]);
                const bf16x8 pf = __builtin_bit_cast(bf16x8, w);
#pragma unroll
                for (int et = 0; et < 4; ++et) {
                    const LAS unsigned char* vp = VTL + (16 * et + q) * 1168 + (li * 64 + kc0 + 4 * kq) * 2;
                    u32x4 av;
                    if constexpr (!(VAR & 64)) { const u32x2 lo = *(const LAS u32x2*)(vp), hi = *(const LAS u32x2*)(vp + 32); av.x = lo.x; av.y = lo.y; av.z = hi.x; av.w = hi.y; } else av = __builtin_bit_cast(u32x4, qf[et & 1]);
                    if constexpr (!(VAR & 2)) O[et] = MFMA16(__builtin_bit_cast(bf16x8, av), pf, O[et]); else asm volatile("" :: "v"(av), "v"(pf));
                }
            }
            const float inv = __builtin_amdgcn_rcpf(l);
#pragma unroll
            for (int et = 0; et < 4; ++et) {
                const int e0 = 16 * et + 4 * kq; const u32x2 ga = gf[et];
                const float g0 = bflo(ga.x), g1 = bfhi(ga.x), g2 = bflo(ga.y), g3 = bfhi(ga.y);
                u32x2 w; w.x = pk2(O[et][0] * inv * g0 * fsigm_fast(g0), O[et][1] * inv * g1 * fsigm_fast(g1)); w.y = pk2(O[et][2] * inv * g2 * fsigm_fast(g2), O[et][3] * inv * g3 * fsigm_fast(g3));
                *(u32x2*)(mixed + tok * 1024 + h * 64 + e0) = w;
            }
        }
        if constexpr (!(VAR & 16)) __syncthreads();
        if constexpr (!(VAR & 8)) {
        if (validA) { *(LAS u32x4*)(lds + kdst + (newA % 9) * 8192) = kn0; *(LAS u32x4*)(lds + vdst + (newA % 9) * 128) = vn0; }
        if (validB) { *(LAS u32x4*)(lds + kdst + (newB % 9) * 8192) = kn1; *(LAS u32x4*)(lds + vdst + (newB % 9) * 128) = vn1; }
        }
#pragma unroll
        for (int ks = 0; ks < 2; ++ks) qf[ks] = qn[ks];
#pragma unroll
        for (int et = 0; et < 4; ++et) gf[et] = gn[et];
    }
    __syncthreads();
}
#if defined(PROBE_EMPTY)
constexpr int N_PHASES = 15 + PROBE_EMPTY;
#elif defined(PROBE_ATT) || defined(PROBE_NA)
constexpr int N_PHASES = 16;
#else
constexpr int N_PHASES = 15;
#endif
__device__ __forceinline__ void run_phase(KPC p, const Frame& F, int ph) {
    unsigned char* ws = p->ws;
    if (ph == 0) { phase_p0a(p, F); return; }
    if (ph == 1) { phase_p0b(p, F); return; }
    if (ph == 14) { phase_final(p, F); return; }
#ifdef PROBE_EMPTY
    if (ph >= 15) { return; }
#endif
#ifdef PROBE_NA
    if (ph == 15) {
        for (int u = F.vcu; u < 256; u += F.G) { Frame Fu = F; asm volatile("" : "+v"(Fu.tid)); Fu.lane = Fu.tid & 63; na_unit<PROBE_NA>(p, Fu, 1, u >> 4, u & 15, (bf16_t*)(ws + WS_END)); }
        return;
    }
#endif
#ifdef PROBE_ATT
    if (ph == 15) {
        const float* scal = (const float*)(ws + WS_SCAL); const float lam = scal[0], lam_init = scal[1];
        { Frame Fu = F; asm volatile("" : "+v"(Fu.tid)); Fu.lane = Fu.tid & 63;
          const int cnt = (F.vcu < 1024) ? (1024 - F.vcu + F.G - 1) / F.G : 0;
          if (cnt > 0) attn_run<PROBE_ATT>(p, Fu, 0, lam, lam_init, (bf16_t*)(ws + WS_END), F.vcu, F.G, cnt); }
        return;
    }
#endif
    const int l = (ph - 2) / 3, k = (ph - 2) % 3, odd = l & 1, ei = l >> 1;
    bf16_t* xg = (bf16_t*)(ws + WS_XG); bf16_t* mixed = (bf16_t*)(ws + WS_MIXED); bf16_t* proj = (bf16_t*)(ws + WS_PROJ); bf16_t* VT = (bf16_t*)(ws + WS_VT);
    float* ssq = (float*)(ws + WS_SSQ); const float* sW = (const float*)(ws + WS_SW) + (size_t)l * 16 * 4096; const float* mod = (const float*)(ws + WS_MOD);
    if (k == 0) {
        const int N1 = odd ? 3072 : 2560, NV = odd ? 1024 : 512;
        const bf16_t* Wt = odd ? (const bf16_t*)(ws + WS_WTO) + (size_t)ei * 4096 * 1024 : (const bf16_t*)(ws + WS_WTE) + (size_t)ei * 3072 * 1024;
        { pg8::Gemm g{xg, Wt, MTOK, N1, 1024}; pg8::StaticOrder S; S.init(MTOK, N1, F.G, F.bx);
          EpiProj E{proj, N1, ssq, sW, odd ? 1024 : 512};
          pg8::gemm_phase<EpiProj, pg8::StaticOrder, true, true>(F.lds, g, S, E, F.tid); }
        { pg8::Gemm g{Wt + (size_t)N1 * 1024, xg, NV, MTOK, 1024}; pg8::StaticOrder S; S.init(NV, MTOK, F.G, F.bx);
          EpiProjT E{VT, NV, ssq, sW + N1, odd ? 0 : 1};
          pg8::gemm_phase<EpiProjT, pg8::StaticOrder, true, true>(F.lds, g, S, E, F.tid); }
    } else if (k == 1) {
        if (!odd) {
            const float* scal = (const float*)(ws + WS_SCAL); const float lam = scal[ei * 4 + 0], lam_init = scal[ei * 4 + 1];
            for (int u = F.vcu; u < 256; u += F.G) {
                Frame Fu = F; asm volatile("" : "+v"(Fu.tid)); Fu.lane = Fu.tid & 63;
                lru_unit(p, Fu, ei, u >> 4, (u >> 1) & 7, u & 1);
            }
            { Frame Fu = F; asm volatile("" : "+v"(Fu.tid)); Fu.lane = Fu.tid & 63;
              const int cnt = (F.vcu < 1024) ? (1024 - F.vcu + F.G - 1) / F.G : 0;
              if (cnt > 0) attn_run<0>(p, Fu, ei, lam, lam_init, mixed, F.vcu, F.G, cnt); }
#ifdef PROBE_MIX
            if (l == 0 && PROBE_MIX == 1) for (int u = F.vcu; u < 256; u += F.G) { Frame Fu = F; asm volatile("" : "+v"(Fu.tid)); Fu.lane = Fu.tid & 63; lru_unit(p, Fu, ei, u >> 4, (u >> 1) & 7, u & 1); }
#endif
        } else {
            for (int u = F.vcu; u < 256; u += F.G) { Frame Fu = F; asm volatile("" : "+v"(Fu.tid)); Fu.lane = Fu.tid & 63;
                na_unit<0>(p, Fu, ei, u >> 4, u & 15, mixed); }
        }
    } else {
        pg8::Gemm g{mixed, (const bf16_t*)(ws + WS_WTOUT) + (size_t)l * 1024 * 1024, MTOK, 1024, 1024}; pg8::StaticOrder S; S.init(MTOK, 1024, F.G, F.bx);
        EpiOut E{l == 0 ? p->x : p->out, p->out, xg, ssq, mod + (size_t)l * 16 * 3072 + 2048, p->norm_g + (l < 3 ? (l + 1) * 1024 : 0), mod + (size_t)(l < 3 ? l + 1 : 0) * 16 * 3072 + 1024, l < 3 ? 1 : 0};
        pg8::gemm_phase<EpiOut, pg8::StaticOrder, true, true>(F.lds, g, S, E, F.tid);
    }
}


#define XB_TMO      128
#define XB_XCNT(j)  (256  + 64 * (j))
#define XB_XSUB(j)  (1280 + 64 * (j))
#define XB_XGEN(j)  (2304 + 64 * (j))
#define XB_TOP      3328
#define XB_TOPGEN   3392
#define XCD_BAR_WORDS 3456
#define XB_SPIN_CAP (1u << 20)
__device__ __forceinline__ unsigned xb_ld(unsigned* p)              { return __hip_atomic_load(p, __ATOMIC_RELAXED, __HIP_MEMORY_SCOPE_AGENT); }
__device__ __forceinline__ unsigned xb_add(unsigned* p, unsigned v) { return __hip_atomic_fetch_add(p, v, __ATOMIC_RELAXED, __HIP_MEMORY_SCOPE_AGENT); }
__device__ __forceinline__ unsigned xb_xcc_id() { return (unsigned)__builtin_amdgcn_s_getreg((3 << 11) | 20) & 0xFu; }
#define XB_SPIN(cond, bar) do { unsigned _sp = 0; while (cond) { __builtin_amdgcn_s_sleep(1); \
    if ((++_sp & 255u) == 0u) { if (xb_ld(&(bar)[XB_TMO])) break; if (_sp > XB_SPIN_CAP) { atomicAdd(&(bar)[XB_TMO], 1u); break; } } } } while (0)
struct XcdBarrier { unsigned* bar; unsigned x; volatile LAS unsigned* st; };
__device__ __forceinline__ XcdBarrier xcd_barrier_post(unsigned* bar, volatile LAS unsigned* st) {
    XcdBarrier b; b.bar = bar; b.x = xb_xcc_id(); b.st = st;
    if (threadIdx.x == 0) (void)xb_add(&bar[XB_XCNT(b.x)], 1u);
    return b;
}
__device__ __forceinline__ void xcd_barrier_complete(unsigned* bar, unsigned x, unsigned& nloc, unsigned& nx) {
    const unsigned G = gridDim.x * gridDim.y * gridDim.z;
    unsigned sum, cnt, mine, sp = 0u;
    for (;;) {
        sum = 0u; cnt = 0u; mine = 0u;
#pragma unroll
        for (unsigned j = 0; j < 16; ++j) { const unsigned c = xb_ld(&bar[XB_XCNT(j)]); sum += c; cnt += (c > 0u) ? 1u : 0u; mine = (j == x) ? c : mine; }
        if (sum == G) break;
        __builtin_amdgcn_s_sleep(1);
        if ((++sp & 255u) == 0u) { if (xb_ld(&bar[XB_TMO])) break; if (sp > XB_SPIN_CAP) { atomicAdd(&bar[XB_TMO], 1u); break; } }
    }
    nloc = mine > 0u ? mine : 1u; nx = cnt > 0u ? cnt : 1u;
}
__device__ __forceinline__ void xcd_barrier(const XcdBarrier& b) {
    asm volatile("s_waitcnt vmcnt(0)" ::: "memory");
    __syncthreads();
    if (threadIdx.x == 0) {
        unsigned* bar = b.bar;
        __builtin_amdgcn_s_waitcnt(0);
        unsigned nloc = b.st[0], nx = b.st[1];
        if (nloc == 0u) { xcd_barrier_complete(bar, b.x, nloc, nx); b.st[0] = nloc; b.st[1] = nx; }
        const unsigned old = xb_add(&bar[XB_XSUB(b.x)], 1u);
        const unsigned gen = old / nloc;
        if (old + 1u == (gen + 1u) * nloc) {
            __builtin_amdgcn_fence(__ATOMIC_RELEASE, "agent");
            asm volatile("s_waitcnt vmcnt(0)" ::: "memory");
            const unsigned og = xb_add(&bar[XB_TOP], 1u);
            const unsigned tg = og / nx;
            if (og + 1u == (tg + 1u) * nx) xb_add(&bar[XB_TOPGEN], 1u);
            else XB_SPIN(xb_ld(&bar[XB_TOPGEN]) == tg, bar);
            __builtin_amdgcn_fence(__ATOMIC_ACQUIRE, "agent");
            xb_add(&bar[XB_XGEN(b.x)], 1u);
            asm volatile("s_waitcnt vmcnt(0)" ::: "memory");
        } else {
            XB_SPIN(xb_ld(&bar[XB_XGEN(b.x)]) == gen, bar);
            __builtin_amdgcn_fence(__ATOMIC_ACQUIRE, "agent");
            asm volatile("s_waitcnt vmcnt(0)" ::: "memory");
        }
    }
    __syncthreads();
}
#ifndef MK_CG_SYNC
#define MK_CG_SYNC 0
#endif

__global__ void __launch_bounds__(512, 2) mega(KP p) {
    extern __shared__ __attribute__((aligned(16))) unsigned char lds_raw[];
#if !MK_CG_SYNC
    volatile LAS unsigned* misc = (volatile LAS unsigned*)((LAS unsigned char*)lds_raw + LDS_BYTES - 64);
    if (threadIdx.x < 16) misc[threadIdx.x] = 0u;
    __syncthreads();
    XcdBarrier xbar = xcd_barrier_post((unsigned*)(p.ws + WS_CTL), misc);
#endif
#ifdef PROBE_PH
    int probe_rep = 0;
#endif
    for (int ph = p.ph_lo; ph < p.ph_hi; ++ph) {
#if MK_CG_SYNC
        if (ph > p.ph_lo) cooperative_groups::this_grid().sync();
#else
        if (ph > p.ph_lo) xcd_barrier(xbar);
#endif
        KPC pp = (KPC)__builtin_amdgcn_kernarg_segment_ptr(); asm volatile("" : "+s"(pp));
        int tid = threadIdx.x; asm volatile("" : "+v"(tid));
        int bx = blockIdx.x; asm volatile("" : "+s"(bx));
        Frame F; F.lds = (LAS unsigned char*)lds_raw; F.tid = tid; F.lane = tid & 63; F.wave = __builtin_amdgcn_readfirstlane(tid >> 6);
        F.G = gridDim.x; F.bx = bx; F.vcu = (F.G % 8 == 0) ? (bx % 8) * (F.G / 8) + bx / 8 : bx;
        run_phase(pp, F, ph);
#ifdef PROBE_PH
        if (ph == PROBE_PH && probe_rep == 0) { probe_rep = 1; --ph; }
#endif
    }
}

#ifndef MK_PER_PHASE
#define MK_PER_PHASE 0
#endif
#ifndef MK_DBG
#define MK_DBG 0
#endif
#if MK_DBG
#endif

static void fill_kp(KP& p, void* const* d_in, void* d_out, void* d_ws) {
    const float** f = (const float**)&p;
    for (int i = 0; i < 21; ++i) f[i] = (const float*)d_in[i];
    p.out = (float*)d_out; p.ws = (unsigned char*)d_ws;
}

extern "C" void kernel_launch(void* const* d_in, const int* in_sizes, int n_in, void* d_out, int out_size, void* d_ws, size_t ws_size, hipStream_t stream) {
    static int grid = 0;
    if (grid == 0) {
        int dev = 0, cus = 0, per_cu = 0;
        if (n_in != 21 || out_size != MTOK * DM || ws_size < WS_END) { fprintf(stderr, "kernel_launch: unexpected shapes (n_in %d out %d ws %zu)\n", n_in, out_size, ws_size); grid = -1; return; }
        (void)hipGetDevice(&dev); (void)hipDeviceGetAttribute(&cus, hipDeviceAttributeMultiprocessorCount, dev);
        if (hipFuncSetAttribute((const void*)mega, hipFuncAttributeMaxDynamicSharedMemorySize, LDS_BYTES) != hipSuccess) { fprintf(stderr, "kernel_launch: hipFuncSetAttribute failed\n"); grid = -1; return; }
        if (hipOccupancyMaxActiveBlocksPerMultiprocessor(&per_cu, (const void*)mega, 512, LDS_BYTES) != hipSuccess || per_cu < 1) { fprintf(stderr, "kernel_launch: occupancy query says %d\n", per_cu); per_cu = 1; }
        (void)hipGetLastError();
        grid = cus * 1;
        if (grid % 8 != 0 || grid < 8) grid = 256;
    }
    if (grid < 0) return;
    KP p{}; fill_kp(p, d_in, d_out, d_ws);
#if MK_DBG
    dbg_forward(p, grid, stream);
#elif MK_PER_PHASE
    (void)hipMemsetAsync((char*)d_ws + WS_CTL, 0, 65536, stream);
    for (int ph = 0; ph < N_PHASES; ++ph) { p.ph_lo = ph; p.ph_hi = ph + 1; hipLaunchKernelGGL(mega, dim3(grid), dim3(512), LDS_BYTES, stream, p); }
#else
    p.ph_lo = 0; p.ph_hi = N_PHASES;
#if MK_CG_SYNC
    void* args[] = {&p};
    hipError_t e = hipLaunchCooperativeKernel((const void*)mega, dim3(grid), dim3(512), args, LDS_BYTES, stream);
    if (e != hipSuccess) fprintf(stderr, "cooperative launch failed: %s (grid %d)\n", hipGetErrorString(e), grid);
#else
    (void)hipMemsetAsync((char*)d_ws + WS_CTL, 0, 65536, stream);
    hipLaunchKernelGGL(mega, dim3(grid), dim3(512), LDS_BYTES, stream, p);
#endif
#endif
}
```

```cpp
#include <hip/hip_runtime.h>
#include <hip/hip_cooperative_groups.h>
#include <cstdio>
#include <cstdint>
#include <cmath>

#define LAS __attribute__((address_space(3)))
typedef unsigned short bf16_t;
typedef short bf16x8 __attribute__((ext_vector_type(8)));
typedef float f32x4 __attribute__((ext_vector_type(4)));
typedef float f32x16 __attribute__((ext_vector_type(16)));
typedef unsigned u32x4 __attribute__((ext_vector_type(4)));
typedef unsigned u32x2 __attribute__((ext_vector_type(2)));
typedef float f32x2_t __attribute__((ext_vector_type(2)));
typedef __bf16 bf16x2_t __attribute__((ext_vector_type(2)));

__device__ __forceinline__ unsigned pk2(float lo, float hi) { f32x2_t v = {lo, hi}; bf16x2_t b = __builtin_convertvector(v, bf16x2_t); return __builtin_bit_cast(unsigned, b); }
__device__ __forceinline__ float bflo(unsigned w) { return __uint_as_float(w << 16); }
__device__ __forceinline__ float bfhi(unsigned w) { return __uint_as_float(w & 0xffff0000u); }
__device__ __forceinline__ float bf2f(bf16_t h) { return __uint_as_float((unsigned)h << 16); }
__device__ __forceinline__ float fsilu(float v) { return v / (1.f + __expf(-v)); }
__device__ __forceinline__ float fsigm(float v) { return 1.f / (1.f + __expf(-v)); }
__device__ __forceinline__ float ex2(float v) { return __builtin_amdgcn_exp2f(v); }
__device__ __forceinline__ float wave_sum(float v) {
#pragma unroll
    for (int o = 1; o < 64; o <<= 1) v += __shfl_xor(v, o);
    return v;
}
__device__ __forceinline__ int t5_bucket(int rel) {
    const int n = rel < 0 ? -rel : rel; const int ret = rel > 0 ? 16 : 0;
    int v; if (n < 8) v = n; else { v = 33 - __clz(n * n); if (v > 15) v = 15; }
    return ret + v;
}
#define LDS_WAIT() asm volatile("s_waitcnt lgkmcnt(0)" ::: "memory")
constexpr float LOG2E = 1.4426950408889634f;
constexpr float QSCALE = 0.125f * 1.4426950408889634f;

constexpr int DM = 1024, SEQ = 2048, NBATCH = 16, MTOK = NBATCH * SEQ;
constexpr size_t MiB = 1u << 20;
constexpr size_t WS_CTL = 0, WS_MOD = 1 * MiB, WS_SW = 2 * MiB, WS_SSQ = 3 * MiB, WS_SCAL = 5 * MiB, WS_WG = 5 * MiB + 65536;
constexpr size_t WS_WTE = 6 * MiB, WS_WTO = 18 * MiB, WS_WTOUT = 34 * MiB;
constexpr size_t WS_XG = 48 * MiB, WS_MIXED = 112 * MiB, WS_PROJ = 176 * MiB, WS_VT = 368 * MiB, WS_XB = 432 * MiB, WS_END = 496 * MiB;
constexpr int LDS_BYTES = 163840;
constexpr int LDS_SPARE = 131072;

struct KP {
    const float *x, *c, *ada_w, *ada_b, *norm_g, *final_g, *t5, *even_w_in, *even_w_out, *da_lam, *da_subg, *conv_w, *conv_b, *w_a, *b_a, *w_x, *b_x, *lru_lam, *odd_w_in, *odd_w_out, *rpb;
    float* out; unsigned char* ws; int ph_lo, ph_hi;
};
typedef const __attribute__((address_space(4))) KP* KPC;
struct Frame { LAS unsigned char* lds; int tid, lane, wave, vcu, G, bx; };

namespace pg8 {
constexpr int BM = 256, BK = 64, HALF = 128, HTB = HALF * BK * 2, STAGE_BYTES = 8 * HTB, NXCD = 8, WGM = 8;
__host__ __device__ __forceinline__ int lds_byte(int r, int c) { const int st = (r >> 4) * 2 + (c >> 5), rr = r & 15, cc = c & 31, ob = rr * 64 + cc * 2; return st * 1024 + (ob ^ (((ob >> 9) & 1) << 5)); }
__host__ __device__ __forceinline__ void stage_rc(int b, int& R, int& C) { const int st = b / 1024, sb = b % 1024, swz = sb ^ (((sb >> 9) & 1) << 5); R = (st >> 1) * 16 + swz / 64; C = (st & 1) * 32 + (swz % 64) / 2; }
__host__ __device__ __forceinline__ int perm32(int rho) { const int n = rho >> 4, i = rho & 15; return 8 * (i >> 2) + 4 * n + (i & 3); }
struct Unit { int pm, pn; };
struct Gemm { const bf16_t* A; const bf16_t* Bt; int M, N, K; };
struct StaticOrder {
    int nM, nN, nwg, G, c;
    __host__ __device__ void init(int M, int N, int G_, int c_) { nM = M / BM; nN = N / BM; nwg = nM * nN; G = G_; c = c_; }
    __host__ __device__ bool next(int i, Unit& u) const {
        const long L = (long)i * G + c; if (L >= nwg) return false;
        int wgid = (int)L; { const int q = nwg / NXCD, r = nwg % NXCD, xcd = wgid % NXCD, off = wgid / NXCD; wgid = (xcd < r ? xcd * (q + 1) : r * (q + 1) + (xcd - r) * q) + off; }
        const int nig = WGM * nN, gid = wgid / nig, fm = gid * WGM, gsz = (nM - fm) < WGM ? (nM - fm) : WGM;
        u.pm = fm + ((wgid % nig) % gsz); u.pn = (wgid % nig) / gsz; return true;
    }
};

template <class Epi, class Sched, bool ALIGN_EPI = false, bool SP2 = false>
__device__ __forceinline__ void gemm_phase(LAS unsigned char* lds, const Gemm g, const Sched& S, const Epi& E, const int tid) {
    const int wid = __builtin_amdgcn_readfirstlane(tid >> 6), lane = tid & 63, wr = wid >> 2, wc = wid & 3, fr = lane & 15, fq = lane >> 4;
    const int K = g.K, nt = K / BK;
    unsigned voffA[2], voffB[2];
#pragma unroll
    for (int i = 0; i < 2; ++i) { int R, C; stage_rc(tid * 16 + i * 8192, R, C); const int Rb = Epi::PERM ? ((R & ~31) + perm32(R & 31)) : R;
        voffA[i] = (unsigned)(R * K + C) * 2u; voffB[i] = (unsigned)(Rb * K + C) * 2u; }
    const size_t kstep = (size_t)(BK * 2);
    const size_t hstep = (size_t)HALF * K * 2;
    const size_t tstep = 2 * hstep;
    const unsigned ldsw = (unsigned)wid * 1024u;
    const int aoff = lds_byte(wr * 64 + fr, fq * 8), boff = lds_byte(wc * 32 + fr, fq * 8);
#define PG8_SA(b, h) (((b) * 2 + (h)) * HTB)
#define PG8_SB(b, h) ((4 + (b) * 2 + (h)) * HTB)
#define PG8_STAGE(bufoff, gbase, voff) do { _Pragma("unroll") for (int _i = 0; _i < 2; ++_i) \
        __builtin_amdgcn_global_load_lds((const unsigned*)((const char*)(gbase) + (voff)[_i]), (LAS unsigned*)(lds + (bufoff) + ldsw + _i * 8192), 16, 0, 0); } while (0)
#define PG8_LDA(dst, b, h) do { _Pragma("unroll") for (int m = 0; m < 4; ++m) _Pragma("unroll") for (int k = 0; k < 2; ++k) dst[m][k] = *(const LAS bf16x8*)(lds + PG8_SA(b, h) + aoff + m * 2048 + k * 1024); } while (0)
#define PG8_LDB(dst, b, h) do { _Pragma("unroll") for (int n = 0; n < 2; ++n) _Pragma("unroll") for (int k = 0; k < 2; ++k) dst[n][k] = *(const LAS bf16x8*)(lds + PG8_SB(b, h) + boff + n * 2048 + k * 1024); } while (0)
#define PG8_MMA(ai, bj, At, Bt) do { __builtin_amdgcn_s_setprio(1); _Pragma("unroll") for (int m = 0; m < 4; ++m) _Pragma("unroll") for (int n = 0; n < 2; ++n) _Pragma("unroll") for (int k = 0; k < 2; ++k) \
        acc[ai][bj][m][n] = __builtin_amdgcn_mfma_f32_16x16x32_bf16(Bt[n][k], At[m][k], acc[ai][bj][m][n], 0, 0, 0); __builtin_amdgcn_s_setprio(0); } while (0)
#define PG8_WAIT_V(n) asm volatile("s_waitcnt vmcnt(" #n ")" ::: "memory")
#define PG8_WAIT_L(n) asm volatile("s_waitcnt lgkmcnt(" #n ")" ::: "memory")
#define PG8_BAR __builtin_amdgcn_s_barrier()
#define PG8_SCHED __builtin_amdgcn_sched_barrier(0)
    Unit cur, nxt; int ui = 0;
    if (!S.next(0, cur)) return;
    f32x4 acc[2][2][4][2];
#pragma unroll
    for (int a = 0; a < 2; ++a)
#pragma unroll
        for (int b = 0; b < 2; ++b)
#pragma unroll
            for (int m = 0; m < 4; ++m)
#pragma unroll
                for (int n = 0; n < 2; ++n) acc[a][b][m][n] = (f32x4){0.f, 0.f, 0.f, 0.f};
    bf16x8 At[4][2], B0[2][2], B1[2][2];
    const char* cA = (const char*)g.A + (size_t)cur.pm * tstep; const char* cB = (const char*)g.Bt + (size_t)cur.pn * tstep;
    if constexpr (SP2) {
        PG8_STAGE(PG8_SB(0, 0), cB, voffB); PG8_STAGE(PG8_SB(0, 1), cB + hstep, voffB); PG8_STAGE(PG8_SA(0, 0), cA, voffA); PG8_STAGE(PG8_SA(0, 1), cA + hstep, voffA);
        if (wr == 1) PG8_BAR;
        PG8_WAIT_V(2); PG8_BAR;
        PG8_STAGE(PG8_SB(1, 0), cB + kstep, voffB); PG8_STAGE(PG8_SA(1, 0), cA + kstep, voffA); PG8_STAGE(PG8_SB(1, 1), cB + hstep + kstep, voffB);
        PG8_WAIT_V(6); PG8_BAR;
    } else {
        PG8_STAGE(PG8_SB(0, 0), cB, voffB); PG8_STAGE(PG8_SA(0, 0), cA, voffA); PG8_STAGE(PG8_SB(0, 1), cB + hstep, voffB); PG8_STAGE(PG8_SA(0, 1), cA + hstep, voffA);
        if (wr == 1) PG8_BAR;
        PG8_WAIT_V(4); PG8_BAR;
        PG8_STAGE(PG8_SB(1, 0), cB + kstep, voffB); PG8_STAGE(PG8_SA(1, 0), cA + kstep, voffA); PG8_STAGE(PG8_SB(1, 1), cB + hstep + kstep, voffB);
        PG8_WAIT_V(6); PG8_BAR;
    }
    for (;;) {
        const bool has_next = S.next(ui + 1, nxt);
        const char* nA = has_next ? (const char*)g.A + (size_t)nxt.pm * tstep : cA; const char* nB = has_next ? (const char*)g.Bt + (size_t)nxt.pn * tstep : cB;
        for (int t = 0; t < nt; t += 2) {
            const bool last = (t == nt - 2);
            const char* a1 = cA + (size_t)(t + 1) * kstep;
            const char* a2 = last ? nA : cA + (size_t)(t + 2) * kstep; const char* b2 = last ? nB : cB + (size_t)(t + 2) * kstep;
            const char* a3 = a2 + kstep; const char* b3 = b2 + kstep;
            if constexpr (SP2) {
            PG8_LDB(B0, 0, 0); PG8_LDB(B1, 0, 1); PG8_SCHED; PG8_LDA(At, 0, 0); PG8_STAGE(PG8_SA(1, 1), a1 + hstep, voffA);
            PG8_WAIT_V(8); PG8_WAIT_L(0); PG8_BAR; PG8_MMA(0, 0, At, B0); PG8_MMA(0, 1, At, B1); PG8_BAR; PG8_SCHED;
            PG8_LDA(At, 0, 1); PG8_STAGE(PG8_SB(0, 0), b2, voffB); PG8_STAGE(PG8_SB(0, 1), b2 + hstep, voffB); PG8_STAGE(PG8_SA(0, 0), a2, voffA);
            PG8_WAIT_V(8); PG8_WAIT_L(0); PG8_BAR; PG8_MMA(1, 0, At, B0); PG8_MMA(1, 1, At, B1); PG8_BAR; PG8_SCHED;
            PG8_LDB(B0, 1, 0); PG8_LDB(B1, 1, 1); PG8_SCHED; PG8_LDA(At, 1, 0); PG8_STAGE(PG8_SA(0, 1), a2 + hstep, voffA);
            PG8_WAIT_V(8); PG8_WAIT_L(0); PG8_BAR; PG8_MMA(0, 0, At, B0); PG8_MMA(0, 1, At, B1); PG8_BAR; PG8_SCHED;
            PG8_LDA(At, 1, 1); PG8_STAGE(PG8_SB(1, 0), b3, voffB); PG8_STAGE(PG8_SB(1, 1), b3 + hstep, voffB); PG8_STAGE(PG8_SA(1, 0), a3, voffA);
            PG8_WAIT_V(8); PG8_WAIT_L(0); PG8_BAR; PG8_MMA(1, 0, At, B0); PG8_MMA(1, 1, At, B1); PG8_BAR; PG8_SCHED;
            } else {
            PG8_LDB(B0, 0, 0); PG8_SCHED; PG8_LDA(At, 0, 0); PG8_STAGE(PG8_SA(1, 1), a1 + hstep, voffA);
            PG8_WAIT_L(8); PG8_BAR; PG8_WAIT_L(0); PG8_MMA(0, 0, At, B0); PG8_BAR; PG8_SCHED;
            PG8_LDB(B1, 0, 1); PG8_STAGE(PG8_SB(0, 0), b2, voffB);
            PG8_BAR; PG8_WAIT_L(0); PG8_MMA(0, 1, At, B1); PG8_BAR;
            PG8_LDA(At, 0, 1); PG8_STAGE(PG8_SA(0, 0), a2, voffA);
            PG8_BAR; PG8_WAIT_L(0); PG8_MMA(1, 0, At, B0); PG8_BAR; PG8_SCHED;
            PG8_STAGE(PG8_SB(0, 1), b2 + hstep, voffB);
            PG8_WAIT_V(6); PG8_BAR; PG8_MMA(1, 1, At, B1); PG8_BAR;
            PG8_LDB(B0, 1, 0); PG8_SCHED; PG8_LDA(At, 1, 0); PG8_STAGE(PG8_SA(0, 1), a2 + hstep, voffA);
            PG8_WAIT_L(8); PG8_BAR; PG8_WAIT_L(0); PG8_MMA(0, 0, At, B0); PG8_BAR; PG8_SCHED;
            PG8_LDB(B1, 1, 1); PG8_STAGE(PG8_SB(1, 0), b3, voffB);
            PG8_BAR; PG8_WAIT_L(0); PG8_MMA(0, 1, At, B1); PG8_BAR;
            PG8_LDA(At, 1, 1); PG8_STAGE(PG8_SA(1, 0), a3, voffA);
            PG8_BAR; PG8_WAIT_L(0); PG8_MMA(1, 0, At, B0); PG8_BAR; PG8_SCHED;
            PG8_STAGE(PG8_SB(1, 1), b3 + hstep, voffB);
            PG8_WAIT_V(6); PG8_BAR; PG8_MMA(1, 1, At, B1); PG8_BAR;
            }
        }
        if constexpr (ALIGN_EPI) { if (wr == 0) PG8_BAR; }
        E(acc, cur, wr, wc, fr, fq);
        if (!has_next) break;
#pragma unroll
        for (int a = 0; a < 2; ++a)
#pragma unroll
            for (int b = 0; b < 2; ++b)
#pragma unroll
                for (int m = 0; m < 4; ++m)
#pragma unroll
                    for (int n = 0; n < 2; ++n) acc[a][b][m][n] = (f32x4){0.f, 0.f, 0.f, 0.f};
        cur = nxt; cA = nA; cB = nB; ++ui;
        if constexpr (ALIGN_EPI) { if (wr == 1) PG8_BAR; }
    }
    PG8_WAIT_V(0);
    if constexpr (!ALIGN_EPI) { if (wr == 0) PG8_BAR; }
    PG8_BAR;
#undef PG8_SA
#undef PG8_SB
#undef PG8_STAGE
#undef PG8_LDA
#undef PG8_LDB
#undef PG8_MMA
#undef PG8_WAIT_V
#undef PG8_WAIT_L
#undef PG8_BAR
#undef PG8_SCHED
}
}
__device__ __forceinline__ float ssq_rinv(const float* ssq, int row) {
    const f32x4* sp = (const f32x4*)(ssq + (size_t)row * 16);
    const f32x4 a = sp[0], b = sp[1], c = sp[2], d = sp[3];
    const float s = ((a[0] + a[1]) + (a[2] + a[3])) + ((b[0] + b[1]) + (b[2] + b[3])) + ((c[0] + c[1]) + (c[2] + c[3])) + ((d[0] + d[1]) + (d[2] + d[3]));
    return rsqrtf(s * (1.f / 1024.f) + 1e-6f);
}
struct EpiProj {
    static constexpr bool PERM = true;
    bf16_t* O; int ldc; const float* ssq; const float* sW; int qcols;
    __device__ __forceinline__ void operator()(const f32x4 (&acc)[2][2][4][2], const pg8::Unit& u, int wr, int wc, int fr, int fq) const {
        const int row0 = u.pm * 256 + wr * 64 + fr, colb = u.pn * 256 + wc * 32 + 8 * fq, b = (u.pm * 256) >> 11;
        const float* sWb = sW + (size_t)b * 4096;
        f32x4 bv[2][2];
#pragma unroll
        for (int bj = 0; bj < 2; ++bj)
#pragma unroll
            for (int n = 0; n < 2; ++n) bv[bj][n] = *(const f32x4*)(sWb + colb + bj * 128 + 4 * n);
#pragma unroll
        for (int ai = 0; ai < 2; ++ai)
#pragma unroll
            for (int m = 0; m < 4; ++m) {
                const int row = row0 + ai * 128 + m * 16; const float rt = ssq_rinv(ssq, row);
                bf16_t* rowp = O + (size_t)row * ldc + colb;
#pragma unroll
                for (int bj = 0; bj < 2; ++bj) {
                    const float sc = (u.pn * 256 + bj * 128 < qcols) ? QSCALE : 1.f;
                    const f32x4 v0 = (acc[ai][bj][m][0] * rt + bv[bj][0]) * sc, v1 = (acc[ai][bj][m][1] * rt + bv[bj][1]) * sc;
                    u32x4 w; w.x = pk2(v0[0], v0[1]); w.y = pk2(v0[2], v0[3]); w.z = pk2(v1[0], v1[1]); w.w = pk2(v1[2], v1[3]);
                    *(u32x4*)(rowp + bj * 128) = w;
                }
            }
    }
};
struct EpiProjT {
    static constexpr bool PERM = true;
    bf16_t* VT; int NV; const float* ssq; const float* sW;   int swap23;
    __device__ __forceinline__ void operator()(const f32x4 (&acc)[2][2][4][2], const pg8::Unit& u, int wr, int wc, int fr, int fq) const {
        const int tok0 = u.pn * 256, b = tok0 >> 11, t0 = tok0 & 2047;
        const int vrow0 = u.pm * 256 + wr * 64 + fr;
        const float* sWb = sW + (size_t)b * 4096;
        bf16_t* base = VT + (size_t)b * NV * 2048 + t0;
#pragma unroll
        for (int bj = 0; bj < 2; ++bj) {
            float rt[2][4];
#pragma unroll
            for (int n = 0; n < 2; ++n)
#pragma unroll
                for (int i = 0; i < 4; ++i) rt[n][i] = ssq_rinv(ssq, tok0 + bj * 128 + wc * 32 + 8 * fq + 4 * n + i);
            const int cl = bj * 128 + wc * 32;
#pragma unroll
            for (int ai = 0; ai < 2; ++ai)
#pragma unroll
                for (int m = 0; m < 4; ++m) {
                    const int vrow = vrow0 + ai * 128 + m * 16; const float bias = sWb[vrow];
                    bf16_t* rowp = base + (size_t)vrow * 2048 + cl;
                    const f32x4 a0 = acc[ai][bj][m][0], a1 = acc[ai][bj][m][1];
                    u32x2 w0, w1;
                    w0.x = pk2(a0[0] * rt[0][0] + bias, a0[1] * rt[0][1] + bias); w0.y = pk2(a0[2] * rt[0][2] + bias, a0[3] * rt[0][3] + bias);
                    w1.x = pk2(a1[0] * rt[1][0] + bias, a1[1] * rt[1][1] + bias); w1.y = pk2(a1[2] * rt[1][2] + bias, a1[3] * rt[1][3] + bias);
                    if (swap23) {
                        *(u32x2*)(rowp + 16 * (fq >> 1) + 4 * (fq & 1)) = w0;
                        *(u32x2*)(rowp + 16 * (fq >> 1) + 8 + 4 * (fq & 1)) = w1;
                    } else {
                        u32x4 w; w.x = w0.x; w.y = w0.y; w.z = w1.x; w.w = w1.y; *(u32x4*)(rowp + 8 * fq) = w;
                    }
                }
        }
    }
};
struct EpiOut {
    static constexpr bool PERM = true;
    const float* xin_f32; const bf16_t* xin_b; bf16_t* xout_b; float* xout_f32; bf16_t* xg; float* ssq; const float* gate;   const float* gnext; const float* scnext;   int has_next;
    __device__ __forceinline__ void operator()(const f32x4 (&acc)[2][2][4][2], const pg8::Unit& u, int wr, int wc, int fr, int fq) const {
        const int row0 = u.pm * 256 + wr * 64 + fr, colb = u.pn * 256 + wc * 32 + 8 * fq, b = (u.pm * 256) >> 11;
        f32x4 gv[2][2], Gn[2][2];
#pragma unroll
        for (int bj = 0; bj < 2; ++bj)
#pragma unroll
            for (int n = 0; n < 2; ++n) {
                const int col = colb + bj * 128 + 4 * n;
                gv[bj][n] = *(const f32x4*)(gate + (size_t)b * 3072 + col);
                if (has_next) { const f32x4 g = *(const f32x4*)(gnext + col), s = *(const f32x4*)(scnext + (size_t)b * 3072 + col); Gn[bj][n] = g * (s + 1.f); }
                else Gn[bj][n] = (f32x4){0.f, 0.f, 0.f, 0.f};
            }
#pragma unroll
        for (int ai = 0; ai < 2; ++ai)
#pragma unroll
            for (int m = 0; m < 4; ++m) {
                const int row = row0 + ai * 128 + m * 16; float ps = 0.f;
#pragma unroll
                for (int bj = 0; bj < 2; ++bj) {
                    const size_t off = (size_t)row * 1024 + colb + bj * 128;
                    f32x4 x0, x1;
                    if (xin_f32) { x0 = *(const f32x4*)(xin_f32 + off); x1 = *(const f32x4*)(xin_f32 + off + 4); }
                    else { const u32x4 xb = *(const u32x4*)(xin_b + off); x0 = (f32x4){bflo(xb.x), bfhi(xb.x), bflo(xb.y), bfhi(xb.y)}; x1 = (f32x4){bflo(xb.z), bfhi(xb.z), bflo(xb.w), bfhi(xb.w)}; }
                    const f32x4 y0 = x0 + gv[bj][0] * acc[ai][bj][m][0], y1 = x1 + gv[bj][1] * acc[ai][bj][m][1];
                    ps += (y0[0] * y0[0] + y0[1] * y0[1]) + (y0[2] * y0[2] + y0[3] * y0[3]) + (y1[0] * y1[0] + y1[1] * y1[1]) + (y1[2] * y1[2] + y1[3] * y1[3]);
                    if (has_next) {
                        u32x4 w; w.x = pk2(y0[0], y0[1]); w.y = pk2(y0[2], y0[3]); w.z = pk2(y1[0], y1[1]); w.w = pk2(y1[2], y1[3]); *(u32x4*)(xout_b + off) = w;
                        const f32x4 z0 = y0 * Gn[bj][0], z1 = y1 * Gn[bj][1];
                        u32x4 v; v.x = pk2(z0[0], z0[1]); v.y = pk2(z0[2], z0[3]); v.z = pk2(z1[0], z1[1]); v.w = pk2(z1[2], z1[3]); *(u32x4*)(xg + off) = v;
                    } else { *(f32x4*)(xout_f32 + off) = y0; *(f32x4*)(xout_f32 + off + 4) = y1; }
                }
                ps += __shfl_xor(ps, 16); ps += __shfl_xor(ps, 32);
                if (fq == 0) ssq[(size_t)row * 16 + u.pn * 4 + wc] = ps;
            }
    }
};

__device__ __forceinline__ int remap_col(int n, int mode) {
    if (mode == 1) return n < 1024 ? n : (n < 1536 ? n + 1536 : n - 512);
    if (mode == 2) return n < 2048 ? n : (n < 3072 ? n + 1024 : n - 1024);
    return n;
}
__device__ __forceinline__ int unmap_col(int c, int odd) {
    if (!odd) return c < 1024 ? c : (c < 2560 ? c + 512 : c - 1536);
    return c < 2048 ? c : (c < 3072 ? c + 1024 : c - 1024);
}
__device__ __forceinline__ void p0_transpose_item(const float* W, int K, int N, bf16_t* WT, int item, LAS float* scr, int lane, int mode) {
    const int nblk = N / 32, kb = item / nblk, nb = item % nblk, k0 = 64 * kb, n0 = 32 * nb;
#pragma unroll 8
    for (int i = 0; i < 32; ++i) { const int kk = 2 * i + (lane >> 5); scr[kk * 33 + (lane & 31)] = W[(size_t)(k0 + kk) * N + n0 + (lane & 31)]; }
    LDS_WAIT(); asm volatile("" ::: "memory");
    const int c = lane & 7;
#pragma unroll
    for (int j = 0; j < 4; ++j) { const int n = (lane >> 3) + 8 * j; const LAS float* s = scr + (8 * c) * 33 + n;
        u32x4 o; o.x = pk2(s[0 * 33], s[1 * 33]); o.y = pk2(s[2 * 33], s[3 * 33]); o.z = pk2(s[4 * 33], s[5 * 33]); o.w = pk2(s[6 * 33], s[7 * 33]);
        *(u32x4*)(WT + (size_t)remap_col(n0 + n, mode) * K + k0 + 8 * c) = o; }
    LDS_WAIT(); asm volatile("" ::: "memory");
}
__device__ __forceinline__ void gemv16_item(const LAS float* vec, const float* W, int ldw, int col0, float* out, int out_ld, int ocol0, const float* bias, int lane) {
    const int n = lane & 15, kq = lane >> 4;
    float acc[16];
#pragma unroll
    for (int b = 0; b < 16; ++b) acc[b] = 0.f;
    const float* wp = W + (size_t)(kq * 256) * ldw + col0 + n; const LAS float* vp = vec + kq * 256;
#pragma unroll 4
    for (int i = 0; i < 256; ++i) {
        const float w = wp[(size_t)i * ldw];
#pragma unroll
        for (int b = 0; b < 16; ++b) acc[b] += vp[b * 1024 + i] * w;
    }
#pragma unroll
    for (int b = 0; b < 16; ++b) { acc[b] += __shfl_xor(acc[b], 16); acc[b] += __shfl_xor(acc[b], 32); }
    if (kq == 0) { const float bs = bias ? bias[col0 + n] : 0.f;
#pragma unroll
        for (int b = 0; b < 16; ++b) out[(size_t)b * out_ld + ocol0 + n] = acc[b] + bs; }
}

__device__ __forceinline__ void phase_p0a(KPC p, const Frame& F) {
    unsigned char* ws = p->ws;
    bf16_t* WtE = (bf16_t*)(ws + WS_WTE); bf16_t* WtO = (bf16_t*)(ws + WS_WTO); bf16_t* WtOut = (bf16_t*)(ws + WS_WTOUT); bf16_t* Wg = (bf16_t*)(ws + WS_WG);
    float* mod = (float*)(ws + WS_MOD); float* scal = (float*)(ws + WS_SCAL);
    LAS float* scr = (LAS float*)(F.lds + F.wave * 8448);
    LAS float* vec = (LAS float*)(F.lds + 73728);
    const int gw = F.vcu * 8 + F.wave, NGW = F.G * 8;
    for (int i = F.tid; i < 16384; i += 512) vec[i] = fsilu(p->c[i]);
    for (int it = gw; it < 9216; it += NGW) {
        int r = it;
        if (r < 3072) { const int e = r / 1536; p0_transpose_item(p->even_w_in + (size_t)e * 1024 * 3072, 1024, 3072, WtE + (size_t)e * 3072 * 1024, r % 1536, scr, F.lane, 1); continue; }
        r -= 3072;
        if (r < 4096) { const int o = r / 2048; p0_transpose_item(p->odd_w_in + (size_t)o * 1024 * 4096, 1024, 4096, WtO + (size_t)o * 4096 * 1024, r % 2048, scr, F.lane, 2); continue; }
        r -= 4096;
        { const int j = r / 512; const int l = (j < 2) ? 2 * j : 2 * (j - 2) + 1; const float* src = (j < 2) ? p->even_w_out + (size_t)j * 1024 * 1024 : p->odd_w_out + (size_t)(j - 2) * 1024 * 1024;
          p0_transpose_item(src, 1024, 1024, WtOut + (size_t)l * 1024 * 1024, r % 512, scr, F.lane, 0); }
    }
    for (int idx = gw * 64 + F.lane; idx < 262144; idx += NGW * 64) {
        const int k = idx & 63, j = (idx >> 6) & 255, n = (idx >> 14) & 7, e = idx >> 17; const int set = j >> 6, d = j & 63, r = set >> 1;
        const float* src = (set & 1) ? p->w_x : p->w_a;
        const float v = src[((((size_t)e * 2 + r) * 8 + n) * 64 + k) * 64 + d];
        Wg[idx] = (bf16_t)(pk2(v, 0.f) & 0xffffu);
    }
    if (F.bx == 0 && F.tid < 2) {
        const int e = F.tid; const float* lp = p->da_lam + e * 256; float s01 = 0.f, s23 = 0.f;
        for (int i = 0; i < 64; ++i) { s01 += lp[i] * lp[64 + i]; s23 += lp[128 + i] * lp[192 + i]; }
        const float lam_init = (e == 0) ? 0.2f : 0.47071302f;
        scal[e * 4 + 0] = expf(s01) - expf(s23) + lam_init; scal[e * 4 + 1] = lam_init;
    }
    __syncthreads();
    for (int it = F.wave * F.G + F.vcu; it < 768; it += NGW) {
        const int l = it / 192, ch = it % 192;
        gemv16_item(vec, p->ada_w + (size_t)l * 1024 * 3072, 3072, ch * 16, mod + (size_t)l * 16 * 3072, 3072, ch * 16, p->ada_b + l * 3072, F.lane);
    }
}
__device__ __forceinline__ void phase_p0b(KPC p, const Frame& F) {
    unsigned char* ws = p->ws;
    const float* mod = (const float*)(ws + WS_MOD); float* sW = (float*)(ws + WS_SW); float* ssq = (float*)(ws + WS_SSQ); bf16_t* xg = (bf16_t*)(ws + WS_XG);
    LAS float* vec = (LAS float*)(F.lds);
    const int l = F.vcu & 3;
    for (int i = F.tid; i < 16384; i += 512) vec[i] = mod[((size_t)l * 16 + (i >> 10)) * 3072 + (i & 1023)];
    __syncthreads();
    {
        const int odd = l & 1, N = odd ? 4096 : 3072;
        const float* W = odd ? p->odd_w_in + (size_t)(l >> 1) * 1024 * 4096 : p->even_w_in + (size_t)(l >> 1) * 1024 * 3072;
        for (int it = (F.vcu >> 2) * 8 + F.wave; it < N / 16; it += (F.G >> 2) * 8)
            gemv16_item(vec, W, N, unmap_col(it * 16, odd), sW + (size_t)l * 16 * 4096, 4096, it * 16, nullptr, F.lane);
    }
    const int gw = F.vcu * 8 + F.wave, NGW = F.G * 8;
    for (int row = gw; row < MTOK; row += NGW) {
        const int b = row >> 11;
        const f32x4* xr = (const f32x4*)(p->x + (size_t)row * 1024) + F.lane;
        f32x4 v[4]; float s = 0.f;
#pragma unroll
        for (int j = 0; j < 4; ++j) { v[j] = xr[64 * j]; s += (v[j][0] * v[j][0] + v[j][1] * v[j][1]) + (v[j][2] * v[j][2] + v[j][3] * v[j][3]); }
        s = wave_sum(s);
        unsigned long long* o8 = (unsigned long long*)(xg + (size_t)row * 1024) + F.lane;
#pragma unroll
        for (int j = 0; j < 4; ++j) {
            const int k = 4 * F.lane + 256 * j;
            const f32x4 g = *(const f32x4*)(p->norm_g + k), sc = *(const f32x4*)(mod + (size_t)b * 3072 + 1024 + k);
            const f32x4 z = v[j] * g * (sc + 1.f);
            o8[64 * j] = (unsigned long long)pk2(z[0], z[1]) | ((unsigned long long)pk2(z[2], z[3]) << 32);
        }
        if (F.lane < 16) ssq[(size_t)row * 16 + F.lane] = (F.lane == 0) ? s : 0.f;
    }
}
__device__ __forceinline__ void phase_final(KPC p, const Frame& F) {
    const float* ssq = (const float*)(p->ws + WS_SSQ);
    const int gw = F.vcu * 8 + F.wave, NGW = F.G * 8;
    for (int row = gw; row < MTOK; row += NGW) {
        const float rt = ssq_rinv(ssq, row);
        f32x4* xr = (f32x4*)(p->out + (size_t)row * 1024) + F.lane;
#pragma unroll
        for (int j = 0; j < 4; ++j) { const f32x4 g = *(const f32x4*)(p->final_g + 4 * F.lane + 256 * j); xr[64 * j] = xr[64 * j] * rt * g; }
    }
}
#define MFMA32(a, b, c) __builtin_amdgcn_mfma_f32_32x32x16_bf16((a), (b), (c), 0, 0, 0)
#define MFMA16(a, b, c) __builtin_amdgcn_mfma_f32_16x16x32_bf16((a), (b), (c), 0, 0, 0)
__device__ __forceinline__ float frcp(float v) { return __builtin_amdgcn_rcpf(v); }
__device__ __forceinline__ float fsigm_fast(float v) { return frcp(1.f + __expf(-v)); }
template <int VAR> __device__ __forceinline__ void attn_run(KPC p, const Frame& F, int e_layer, float lam, float lam_init, bf16_t* mixed, int a0, int astride, int count) {
    const int tid = F.tid, lane = F.lane, r = lane & 31, hh = lane >> 5, m = F.wave & 1, sub = F.wave >> 1, grp = F.wave >> 2;
    const bf16_t* P = (const bf16_t*)(p->ws + WS_PROJ); const bf16_t* VT = (const bf16_t*)(p->ws + WS_VT);
    LAS unsigned char* lds = F.lds;
    LAS float* lutall = (LAS float*)(lds + 98304); LAS float* SG = (LAS float*)(lds + 106496); LAS float* SSX = (LAS float*)(lds + 107520); LAS float* X = (LAS float*)(lds + 110592) + sub * 2048;
    for (int i = tid; i < 2048; i += 512) { const int hd = i >> 9, idx = i & 511; lutall[i] = (idx < 511) ? p->t5[hd * 32 + t5_bucket(idx - 255)] * LOG2E : 0.f; }
    if (tid < 128) SG[tid] = p->da_subg[e_layer * 128 + tid] * (1.f - lam_init);
    const int skey = (tid >> 3) & 63, ve0 = tid >> 3, sch = (tid & 7) ^ ((skey >> 1) & 7);
    const unsigned dmaw = (unsigned)F.wave * 1024u;
    const unsigned swz = (unsigned)((r >> 1) & 7);
#define ATT_DMA(stage_off, ks_, vs_) do { \
        __builtin_amdgcn_global_load_lds((const unsigned*)(ks_), (LAS unsigned*)(lds + (stage_off) + dmaw), 16, 0, 0); \
        __builtin_amdgcn_global_load_lds((const unsigned*)((ks_) + 64), (LAS unsigned*)(lds + (stage_off) + 8192 + dmaw), 16, 0, 0); \
        __builtin_amdgcn_global_load_lds((const unsigned*)(vs_), (LAS unsigned*)(lds + (stage_off) + 16384 + dmaw), 16, 0, 0); \
        __builtin_amdgcn_global_load_lds((const unsigned*)((vs_) + (size_t)64 * 2048), (LAS unsigned*)(lds + (stage_off) + 24576 + dmaw), 16, 0, 0); } while (0)
    bf16x8 qf[4];
    {
        const int a = a0, b = a >> 6, h = (a >> 4) & 3, qb = a & 15;
        const bf16_t* ksrc0 = P + ((size_t)b * 2048 + skey) * 2560 + 512 + h * 128 + sch * 8;
        const bf16_t* vsrc0 = VT + ((size_t)(b * 512 + h * 128 + ve0)) * 2048 + sch * 8;
#pragma unroll
        for (int t = 0; t < 2; ++t) ATT_DMA(t * 32768, ksrc0 + (size_t)t * 64 * 2560, vsrc0 + t * 64);
        const bf16_t* qp = P + ((size_t)b * 2048 + qb * 128 + sub * 32 + r) * 2560 + h * 128 + m * 64 + hh * 8;
#pragma unroll
        for (int s = 0; s < 4; ++s) qf[s] = *(const bf16x8*)(qp + 16 * s);
    }
    asm volatile("s_waitcnt vmcnt(0)" ::: "memory");
    __syncthreads();
    int T = 0;
    for (int k = 0; k < count; ++k) {
        const int a = a0 + k * astride, b = a >> 6, h = (a >> 4) & 3, qb = a & 15;
        const int an = (k + 1 < count) ? a + astride : a, bn = an >> 6, hn = (an >> 4) & 3, qbn = an & 15;
        const size_t tokbase = (size_t)b * 2048; const int q0w = qb * 128 + sub * 32;
        const bf16_t* ksrc0 = P + (tokbase + skey) * 2560 + 512 + h * 128 + sch * 8;
        const bf16_t* vsrc0 = VT + ((size_t)(b * 512 + h * 128 + ve0)) * 2048 + sch * 8;
        const bf16_t* ksrcN = P + ((size_t)bn * 2048 + skey) * 2560 + 512 + hn * 128 + sch * 8;
        const bf16_t* vsrcN = VT + ((size_t)(bn * 512 + hn * 128 + ve0)) * 2048 + sch * 8;
        LAS float* lut = lutall + h * 512;
        const float cL = lut[0], cR = lut[510];
        f32x16 O[4];
#pragma unroll
        for (int et = 0; et < 4; ++et)
#pragma unroll
            for (int i = 0; i < 16; ++i) O[et][i] = 0.f;
        constexpr float THR = 8.f;
        float m_run = 0.f, l_run = 0.f;
        if constexpr (!(VAR & 16)) { if (grp == 1) __builtin_amdgcn_s_barrier(); }
        for (int j = 0; j < ((VAR & 128) ? 1 : 32); ++j) {
            const int st = (T % 3) * 32768;
            const bool own = j < 30; const int tl = own ? j + 2 : j - 30;
            const bf16_t* ksn = (own ? ksrc0 : ksrcN) + (size_t)tl * 64 * 2560; const bf16_t* vsn = (own ? vsrc0 : vsrcN) + tl * 64;
            const int sn = ((T + 2) % 3) * 32768;
            if constexpr (!(VAR & 8)) { if (grp == 1) ATT_DMA(sn, ksn, vsn); }
            const LAS unsigned char* kb = lds + st + m * 8192; const LAS unsigned char* vb = lds + st + 16384;
            f32x16 S0, S1;
            { const int rel_max = 64 * j + 63 - q0w, rel_min = 64 * j - (q0w + 31);
              if (rel_max <= -91 || rel_min >= 91) { const float cv = ((rel_max <= -91) ? cL : cR) - m_run;
#pragma unroll
                  for (int i = 0; i < 16; ++i) { S0[i] = cv; S1[i] = cv; }
              } else {
                  const int ib = 64 * j + 4 * hh - (q0w + r) + 255;
#pragma unroll
                  for (int i = 0; i < 16; ++i) { const int idx = ib + (i & 3) + 8 * (i >> 2); S0[i] = lut[idx] - m_run; S1[i] = lut[idx + 32] - m_run; }
              } }
#pragma unroll
            for (int s = 0; s < 4; ++s) {
                const unsigned co = (((unsigned)(2 * s + hh)) ^ swz) << 4;
                bf16x8 a0v, a1v;
                if constexpr (!(VAR & 64)) { a0v = *(const LAS bf16x8*)(kb + r * 128 + co); a1v = *(const LAS bf16x8*)(kb + (32 + r) * 128 + co); } else { a0v = qf[s]; a1v = qf[(s + 1) & 3]; }
                if constexpr (!(VAR & 4)) { S0 = MFMA32(a0v, qf[s], S0); S1 = MFMA32(a1v, qf[s], S1); } else { asm volatile("" :: "v"(a0v), "v"(a1v)); }
            }
            if constexpr (!(VAR & 1)) {
                float mxa = fmaxf(fmaxf(S0[0], S0[1]), S1[0]), mxb = fmaxf(fmaxf(S0[2], S0[3]), S1[1]);
                mxa = fmaxf(fmaxf(mxa, S1[2]), S1[3]);
#pragma unroll
                for (int i = 4; i < 16; i += 4) { mxa = fmaxf(fmaxf(mxa, S0[i]), S0[i + 1]); mxb = fmaxf(fmaxf(mxb, S0[i + 2]), S0[i + 3]); mxa = fmaxf(fmaxf(mxa, S1[i]), S1[i + 1]); mxb = fmaxf(fmaxf(mxb, S1[i + 2]), S1[i + 3]); }
                float mx = fmaxf(mxa, mxb);
                mx = fmaxf(mx, __shfl_xor(mx, 32));
                if (j == 0 || __any(mx > THR)) {
                    const float dl = (j == 0 || mx > THR) ? mx : 0.f;
                    const float alpha = ex2(-dl); m_run += dl; l_run *= alpha;
#pragma unroll
                    for (int i = 0; i < 16; ++i) { S0[i] -= dl; S1[i] -= dl; }
#pragma unroll
                    for (int et = 0; et < 4; ++et)
#pragma unroll
                        for (int i = 0; i < 16; ++i) O[et][i] *= alpha;
                }
                float lsa = 0.f, lsb = 0.f;
#pragma unroll
                for (int i = 0; i < 16; ++i) { S0[i] = ex2(S0[i]); S1[i] = ex2(S1[i]); lsa += S0[i]; lsb += S1[i]; }
                l_run += lsa + lsb;
            }
            bf16x8 pf[4];
            { u32x4 w;
              w.x = pk2(S0[0], S0[1]); w.y = pk2(S0[2], S0[3]); w.z = pk2(S0[4], S0[5]); w.w = pk2(S0[6], S0[7]); pf[0] = __builtin_bit_cast(bf16x8, w);
              w.x = pk2(S0[8], S0[9]); w.y = pk2(S0[10], S0[11]); w.z = pk2(S0[12], S0[13]); w.w = pk2(S0[14], S0[15]); pf[1] = __builtin_bit_cast(bf16x8, w);
              w.x = pk2(S1[0], S1[1]); w.y = pk2(S1[2], S1[3]); w.z = pk2(S1[4], S1[5]); w.w = pk2(S1[6], S1[7]); pf[2] = __builtin_bit_cast(bf16x8, w);
              w.x = pk2(S1[8], S1[9]); w.y = pk2(S1[10], S1[11]); w.z = pk2(S1[12], S1[13]); w.w = pk2(S1[14], S1[15]); pf[3] = __builtin_bit_cast(bf16x8, w); }
            if constexpr (!(VAR & 16)) { if (grp == 1) asm volatile("s_waitcnt vmcnt(4) lgkmcnt(0)\n\ts_barrier" ::: "memory"); else asm volatile("s_waitcnt lgkmcnt(0)\n\ts_barrier" ::: "memory"); }
            if constexpr (!(VAR & 8)) { if (grp == 0) ATT_DMA(sn, ksn, vsn); }
            if (j == 31) {
                const bf16_t* qp = P + ((size_t)bn * 2048 + qbn * 128 + sub * 32 + r) * 2560 + hn * 128 + m * 64 + hh * 8;
#pragma unroll
                for (int s = 0; s < 4; ++s) qf[s] = *(const bf16x8*)(qp + 16 * s);
            }
#pragma unroll
            for (int et = 0; et < 4; ++et)
#pragma unroll
                for (int s = 0; s < 4; ++s) {
                    bf16x8 av;
                    if constexpr (!(VAR & 64)) av = *(const LAS bf16x8*)(vb + (32 * et + r) * 128 + ((((unsigned)(2 * s + hh)) ^ swz) << 4)); else av = pf[(s + et) & 3];
                    if constexpr (!(VAR & 2)) O[et] = MFMA32(av, pf[s], O[et]); else asm volatile("" :: "v"(av), "v"(pf[s]));
                }
            if constexpr (!(VAR & 16)) {
                if (grp == 0) { if (j == 31) asm volatile("s_waitcnt vmcnt(8) lgkmcnt(0)\n\ts_barrier" ::: "memory"); else asm volatile("s_waitcnt vmcnt(4) lgkmcnt(0)\n\ts_barrier" ::: "memory"); }
                else asm volatile("s_waitcnt lgkmcnt(0)\n\ts_barrier" ::: "memory");
            }
            ++T;
        }
        if constexpr (!(VAR & 16)) { if (grp == 0) __builtin_amdgcn_s_barrier(); }
        const size_t tok = tokbase + q0w + r;
        const int et0 = 2 * m;
        u32x2 gav[8];
#pragma unroll
        for (int t = 0; t < 2; ++t)
#pragma unroll
            for (int g4 = 0; g4 < 4; ++g4) gav[t * 4 + g4] = *(const u32x2*)(P + tok * 2560 + 1024 + h * 128 + 32 * (et0 + t) + 8 * g4 + 4 * hh);
        l_run += __shfl_xor(l_run, 32);
        const float inv = __builtin_amdgcn_rcpf(l_run);
        f32x16 D0, D1;
        if (m == 1) {
#pragma unroll
            for (int i = 0; i < 16; ++i) { X[i * 64 + lane] = O[0][i] * inv; X[(16 + i) * 64 + lane] = O[1][i] * inv; }
        }
        __syncthreads();
        if (m == 0) {
#pragma unroll
            for (int i = 0; i < 16; ++i) { D0[i] = O[0][i] * inv - lam * X[i * 64 + lane]; D1[i] = O[1][i] * inv - lam * X[(16 + i) * 64 + lane]; }
        }
        __syncthreads();
        if (m == 0) {
#pragma unroll
            for (int i = 0; i < 16; ++i) { X[i * 64 + lane] = O[2][i] * inv; X[(16 + i) * 64 + lane] = O[3][i] * inv; }
        }
        __syncthreads();
        if (m == 1) {
#pragma unroll
            for (int i = 0; i < 16; ++i) { D0[i] = X[i * 64 + lane] - lam * O[2][i] * inv; D1[i] = X[(16 + i) * 64 + lane] - lam * O[3][i] * inv; }
        }
        float ss = 0.f;
#pragma unroll
        for (int i = 0; i < 16; ++i) ss += D0[i] * D0[i] + D1[i] * D1[i];
        ss += __shfl_xor(ss, 32);
        if (hh == 0) SSX[F.wave * 32 + r] = ss;
        __syncthreads();
        ss += SSX[(F.wave ^ 1) * 32 + r];
        const float rinv = rsqrtf(ss * (1.f / 128.f) + 1e-6f);
        if constexpr (!(VAR & 512)) {
#pragma unroll
            for (int t = 0; t < 2; ++t)
#pragma unroll
                for (int g4 = 0; g4 < 4; ++g4) {
                    const int e0 = 32 * (et0 + t) + 8 * g4 + 4 * hh;
                    const f32x4 sg = *(const LAS f32x4*)(SG + e0);
                    const u32x2 ga = gav[t * 4 + g4];
                    const float g0 = bflo(ga.x), g1 = bfhi(ga.x), g2 = bflo(ga.y), g3 = bfhi(ga.y);
                    const float d0 = t ? D1[4 * g4 + 0] : D0[4 * g4 + 0], d1 = t ? D1[4 * g4 + 1] : D0[4 * g4 + 1], d2 = t ? D1[4 * g4 + 2] : D0[4 * g4 + 2], d3 = t ? D1[4 * g4 + 3] : D0[4 * g4 + 3];
                    u32x2 w; w.x = pk2(d0 * rinv * sg[0] * g0 * fsigm_fast(g0), d1 * rinv * sg[1] * g1 * fsigm_fast(g1)); w.y = pk2(d2 * rinv * sg[2] * g2 * fsigm_fast(g2), d3 * rinv * sg[3] * g3 * fsigm_fast(g3));
                    *(u32x2*)(mixed + tok * 1024 + h * 128 + e0) = w;
                }
        }
    }
    __syncthreads();
}

template <int dir> __device__ __forceinline__ void lru_pass(KPC p, const Frame& F, int e_layer, int b, int n, int hf) {
    const int tid = F.tid, lane = F.lane, wave = F.wave;
    const bf16_t* P = (const bf16_t*)(p->ws + WS_PROJ); bf16_t* mixed = (bf16_t*)(p->ws + WS_MIXED); float* HF = (float*)(p->ws + WS_XG);
    const bf16_t* Wg = (const bf16_t*)(p->ws + WS_WG) + ((size_t)(e_layer * 8 + n)) * 256 * 64;
    LAS unsigned char* lds = F.lds;
    LAS unsigned char* XA = lds; LAS float* XC = (LAS float*)(lds + 16384); LAS f32x2_t* PH = (LAS f32x2_t*)(lds + 34816); LAS float* Cc = (LAS float*)(lds + 36864);
    const size_t tokbase = (size_t)b * 2048;
    const int cg = tid & 7, tp = tid >> 3;
    f32x4 cwa[4], cwb[4], cba, cbb;
    { const float* cwp = p->conv_w + (size_t)e_layer * 4 * 512 + n * 64 + cg * 8;
#pragma unroll
      for (int j = 0; j < 4; ++j) { cwa[j] = *(const f32x4*)(cwp + j * 512); cwb[j] = *(const f32x4*)(cwp + j * 512 + 4); }
      const float* cbp = p->conv_b + e_layer * 512 + n * 64 + cg * 8; cba = *(const f32x4*)(cbp); cbb = *(const f32x4*)(cbp + 4); }
    const bf16_t* xcol = P + tokbase * 2560 + 1536 + n * 64 + cg * 8;
    const int mt = wave, col = lane & 15, kq = lane >> 4;
    const int kqo = dir ? 3 - kq : kq, wo = dir ? 7 - mt : mt;
    bf16x8 wf[2][2][2];
    float ba[2], bx[2], sp[2];
#pragma unroll
    for (int jj = 0; jj < 2; ++jj) {
        const int ch = 32 * hf + 16 * jj + col;
#pragma unroll
        for (int gs = 0; gs < 2; ++gs)
#pragma unroll
            for (int ks = 0; ks < 2; ++ks) wf[jj][gs][ks] = *(const bf16x8*)(Wg + (size_t)((2 * dir + gs) * 64 + ch) * 64 + 32 * ks + 8 * kq);
        ba[jj] = p->b_a[(e_layer * 2 + dir) * 512 + n * 64 + ch]; bx[jj] = p->b_x[(e_layer * 2 + dir) * 512 + n * 64 + ch];
        const float y = -p->lru_lam[(e_layer * 2 + dir) * 512 + n * 64 + ch]; sp[jj] = -8.f * (fmaxf(y, 0.f) + log1pf(expf(-fabsf(y))));
    }
    if (tid < 64) Cc[tid] = 0.f;
    u32x4 xr[5];
    { const int t0 = (dir ? 15 : 0) * 128;
#pragma unroll
      for (int k = 0; k < 5; ++k) { int tt = t0 + 2 * tp - 2 + k; tt = tt < 0 ? 0 : (tt > 2047 ? 2047 : tt); xr[k] = *(const u32x4*)(xcol + (size_t)tt * 2560); } }
    for (int cc = 0; cc < 16; ++cc) {
        const int chunk = dir ? 15 - cc : cc; const int t0 = chunk * 128; const int par = cc & 1;
        u32x4 xc5[5];
#pragma unroll
        for (int k = 0; k < 5; ++k) { const int tt = t0 + 2 * tp - 2 + k; const bool ok = (tt >= 0) && (tt < 2048); xc5[k] = xr[k]; if (!ok) xc5[k] = (u32x4){0u, 0u, 0u, 0u}; }
        { const int cn = (cc + 1 < 16) ? cc + 1 : cc; const int t1 = (dir ? 15 - cn : cn) * 128;
#pragma unroll
            for (int k = 0; k < 5; ++k) { int tt = t1 + 2 * tp - 2 + k; tt = tt < 0 ? 0 : (tt > 2047 ? 2047 : tt); xr[k] = *(const u32x4*)(xcol + (size_t)tt * 2560); } }
        float hfv[2][4]; bf16_t gvv[2][4];
        if (dir) {
#pragma unroll
            for (int jj = 0; jj < 2; ++jj)
#pragma unroll
                for (int i = 0; i < 4; ++i) { const size_t tok = tokbase + t0 + 16 * mt + 4 * kq + i; const int ch = n * 64 + 32 * hf + 16 * jj + col;
                    hfv[jj][i] = HF[tok * 512 + ch]; gvv[jj][i] = P[tok * 2560 + 2048 + ch]; }
        }
#pragma unroll
        for (int i = 0; i < 2; ++i) {
            const int tl = 2 * tp + i;
            f32x4 va = cba, vb = cbb;
#pragma unroll
            for (int j = 0; j < 4; ++j) { const u32x4 x = xc5[i + j];
                va += cwa[j] * (f32x4){bflo(x.x), bfhi(x.x), bflo(x.y), bfhi(x.y)}; vb += cwb[j] * (f32x4){bflo(x.z), bfhi(x.z), bflo(x.w), bfhi(x.w)}; }
            u32x4 w; w.x = pk2(va[0], va[1]); w.y = pk2(va[2], va[3]); w.z = pk2(vb[0], vb[1]); w.w = pk2(vb[2], vb[3]);
            *(LAS u32x4*)(XA + tl * 128 + ((((unsigned)cg) ^ ((unsigned)(tl >> 1) & 7u)) << 4)) = w;
            if ((cg >> 2) == hf) { LAS float* xp = XC + tl * 36 + (cg & 3) * 8; *(LAS f32x4*)(xp) = va; *(LAS f32x4*)(xp + 4) = vb; }
        }
        __syncthreads();
        f32x4 acc[2][2];
#pragma unroll
        for (int jj = 0; jj < 2; ++jj)
#pragma unroll
            for (int gs = 0; gs < 2; ++gs) acc[jj][gs] = (f32x4){0.f, 0.f, 0.f, 0.f};
#pragma unroll
        for (int ks = 0; ks < 2; ++ks) {
            const int row = 16 * mt + col;
            const bf16x8 a = *(const LAS bf16x8*)(XA + row * 128 + ((((unsigned)(4 * ks + kq)) ^ ((unsigned)(row >> 1) & 7u)) << 4));
#pragma unroll
            for (int jj = 0; jj < 2; ++jj)
#pragma unroll
                for (int gs = 0; gs < 2; ++gs) acc[jj][gs] = MFMA16(a, wf[jj][gs][ks], acc[jj][gs]);
        }
        float hl[2][4], Pp[2][4], Pex[2], Hex[2];
#pragma unroll
        for (int jj = 0; jj < 2; ++jj) {
            const int chl = 16 * jj + col;
            float av[4], uv[4];
#pragma unroll
            for (int i = 0; i < 4; ++i) {
                const int tl = 16 * mt + 4 * kq + i;
                const float ga = fsigm_fast(acc[jj][0][i] + ba[jj]), gx = fsigm_fast(acc[jj][1][i] + bx[jj]);
                const float log_a = ga * sp[jj]; const float a = __expf(log_a); const float y2 = 2.f * log_a;
                const float om = (y2 > -0.1f) ? -(y2 * (1.f + y2 * (0.5f + y2 * (0.16666667f + y2 * 0.041666668f)))) : 1.f - a * a;
                av[i] = a; uv[i] = __builtin_amdgcn_sqrtf(om) * gx * XC[tl * 36 + chl];
            }
            if (!dir) { hl[jj][0] = uv[0]; Pp[jj][0] = av[0];
#pragma unroll
                for (int i = 1; i < 4; ++i) { hl[jj][i] = av[i] * hl[jj][i - 1] + uv[i]; Pp[jj][i] = av[i] * Pp[jj][i - 1]; }
            } else { hl[jj][3] = uv[3]; Pp[jj][3] = av[3];
#pragma unroll
                for (int i = 2; i >= 0; --i) { hl[jj][i] = av[i] * hl[jj][i + 1] + uv[i]; Pp[jj][i] = av[i] * Pp[jj][i + 1]; }
            }
            float Pi = dir ? Pp[jj][0] : Pp[jj][3], Hi = dir ? hl[jj][0] : hl[jj][3];
            { const float Pq = dir ? __shfl_down(Pi, 16) : __shfl_up(Pi, 16), Hq = dir ? __shfl_down(Hi, 16) : __shfl_up(Hi, 16);
              if (kqo >= 1) { Hi = Pi * Hq + Hi; Pi = Pi * Pq; } }
            { const float Pq = dir ? __shfl_down(Pi, 32) : __shfl_up(Pi, 32), Hq = dir ? __shfl_down(Hi, 32) : __shfl_up(Hi, 32);
              if (kqo >= 2) { Hi = Pi * Hq + Hi; Pi = Pi * Pq; } }
            { const float Pq = dir ? __shfl_down(Pi, 16) : __shfl_up(Pi, 16), Hq = dir ? __shfl_down(Hi, 16) : __shfl_up(Hi, 16);
              Pex[jj] = (kqo >= 1) ? Pq : 1.f; Hex[jj] = (kqo >= 1) ? Hq : 0.f; }
            if (kqo == 3) PH[mt * 32 + chl] = (f32x2_t){Pi, Hi};
        }
        __syncthreads();
#pragma unroll
        for (int jj = 0; jj < 2; ++jj) {
            const int chl = 16 * jj + col;
            float cw_ = Cc[par * 32 + chl];
            f32x2_t ph[7];
#pragma unroll
            for (int s = 0; s < 7; ++s) ph[s] = PH[(dir ? 7 - s : s) * 32 + chl];
#pragma unroll
            for (int s = 0; s < 7; ++s) cw_ = (s < wo) ? ph[s].x * cw_ + ph[s].y : cw_;
            const float cin = Pex[jj] * cw_ + Hex[jj];
#pragma unroll
            for (int i = 0; i < 4; ++i) hl[jj][i] += Pp[jj][i] * cin;
            if (wo == 7 && kqo == 3) Cc[(par ^ 1) * 32 + chl] = dir ? hl[jj][0] : hl[jj][3];
#pragma unroll
            for (int i = 0; i < 4; ++i) {
                const size_t tok = tokbase + t0 + 16 * mt + 4 * kq + i; const int ch = n * 64 + 32 * hf + chl;
                if (!dir) HF[tok * 512 + ch] = hl[jj][i];
                else { const float g = bf2f(gvv[jj][i]); mixed[tok * 1024 + 512 + ch] = (bf16_t)(pk2((hfv[jj][i] + hl[jj][i]) * g * fsigm_fast(g), 0.f) & 0xffffu); }
            }
        }
    }
    asm volatile("s_waitcnt vmcnt(0)" ::: "memory");
    __syncthreads();
}
__device__ __forceinline__ void lru_unit(KPC p, const Frame& F, int e_layer, int b, int n, int hf) {
    lru_pass<0>(p, F, e_layer, b, n, hf);
    lru_pass<1>(p, F, e_layer, b, n, hf);
}

template <int VAR> __device__ __forceinline__ void na_unit(KPC p, const Frame& F, int o_layer, int b, int h, bf16_t* mixed) {
    const int tid = F.tid, lane = F.lane, wave = F.wave;
    const bf16_t* P = (const bf16_t*)(p->ws + WS_PROJ); const bf16_t* VT = (const bf16_t*)(p->ws + WS_VT);
    LAS unsigned char* lds = F.lds; LAS unsigned char* KL = lds; LAS unsigned char* VTL = lds + 73728; LAS float* rpbs = (LAS float*)(lds + 148480);
    const size_t tokbase = (size_t)b * 2048;
    const int skey = tid >> 3, sch = tid & 7;
    const bf16_t* ksrc = P + (tokbase + skey) * 3072 + 1024 + h * 64 + sch * 8;
    const bf16_t* vsrc = VT + ((size_t)(b * 1024 + h * 64 + skey)) * 2048 + sch * 8;
    const unsigned kdst = (unsigned)(skey * 128 + ((sch ^ ((skey >> 1) & 7)) << 4));
    const unsigned vdst = (unsigned)(73728 + skey * 1168 + sch * 16);
    if (tid < 465) rpbs[tid] = p->rpb[((size_t)o_layer * 16 + h) * 465 + tid] * LOG2E;
    if constexpr (!(VAR & 256)) { u32x4 kr[9], vr[9];
#pragma unroll
      for (int r = 0; r < 9; ++r) { kr[r] = *(const u32x4*)(ksrc + (size_t)r * 64 * 3072); vr[r] = *(const u32x4*)(vsrc + r * 64); }
#pragma unroll
      for (int r = 0; r < 9; ++r) { *(LAS u32x4*)(lds + kdst + r * 8192) = kr[r]; *(LAS u32x4*)(lds + vdst + r * 128) = vr[r]; } }
    const int ri = wave >> 2, g = wave & 3, c0 = 16 * g, kc0 = (g == 0) ? 0 : (g == 1 ? 8 : (g == 2 ? 24 : 32));
    const int q = lane & 15, kq = lane >> 4;
    const int c = c0 + q; int cs = c - 8; cs = cs < 0 ? 0 : (cs > 48 ? 48 : cs);
    f32x4 BT[8][2]; int boff = -1;
    bf16x8 qf[2]; u32x2 gf[4];
    { const size_t tok = tokbase + ri * 64 + c0 + q;
#pragma unroll
      for (int ks = 0; ks < 2; ++ks) qf[ks] = *(const bf16x8*)(P + tok * 3072 + h * 64 + 32 * ks + 8 * kq);
#pragma unroll
      for (int et = 0; et < 4; ++et) gf[et] = *(const u32x2*)(P + tok * 3072 + 2048 + h * 64 + 16 * et + 4 * kq); }
    for (int rp = 0; rp < ((VAR & 128) ? 1 : 16); ++rp) {
        const int r0 = 2 * rp; int rb = r0 - 4; rb = rb < 0 ? 0 : (rb > 24 ? 24 : rb); int rbn = r0 - 2; rbn = rbn < 0 ? 0 : (rbn > 24 ? 24 : rbn);
        const int newA = rb + 9, newB = rb + 10; const bool do_new = rbn > rb; const bool validA = do_new && newA < 32, validB = do_new && newB < 32;
        const int la = newA < 31 ? newA : 31, lb = newB < 31 ? newB : 31;
        if constexpr (!(VAR & 16)) __syncthreads();
        u32x4 kn0 = {0u,0u,0u,0u}, kn1 = kn0, vn0 = kn0, vn1 = kn0;
        if constexpr (!(VAR & 8)) { kn0 = *(const u32x4*)(ksrc + (size_t)la * 64 * 3072); kn1 = *(const u32x4*)(ksrc + (size_t)lb * 64 * 3072); vn0 = *(const u32x4*)(vsrc + la * 64); vn1 = *(const u32x4*)(vsrc + lb * 64); }
        bf16x8 qn[2]; u32x2 gn[4];
        { int rn = r0 + 2 + ri; rn = rn > 31 ? 31 : rn; const size_t tokn = tokbase + rn * 64 + c0 + q;
#pragma unroll
          for (int ks = 0; ks < 2; ++ks) qn[ks] = *(const bf16x8*)(P + tokn * 3072 + h * 64 + 32 * ks + 8 * kq);
#pragma unroll
          for (int et = 0; et < 4; ++et) gn[et] = *(const u32x2*)(P + tokn * 3072 + 2048 + h * 64 + 16 * et + 4 * kq); }
        {
            const int rr = r0 + ri; int rs = rr - 4; rs = rs < 0 ? 0 : (rs > 24 ? 24 : rs);
            const size_t tok = tokbase + rr * 64 + c0 + q;
            const int off = rr - rs;
            if (off != boff) {
                boff = off;
#pragma unroll
                for (int i = 0; i < 8; ++i)
#pragma unroll
                    for (int a = 0; a < 2; ++a)
#pragma unroll
                        for (int j = 0; j < 4; ++j) {
                            const int kc = kc0 + 16 * a + 4 * kq + j; const bool valid = (kc >= cs) && (kc < cs + 16);
                            int dc = kc - c + 15; dc = dc < 0 ? 0 : (dc > 30 ? 30 : dc);
                            const float bias = rpbs[(i - off + 7) * 31 + dc];
                            BT[i][a][j] = valid ? bias : -1e30f;
                        }
            }
            f32x4 S[8][2];
#pragma unroll
            for (int i = 0; i < 8; ++i) {
                const int li = (rs + i) % 9;
#pragma unroll
                for (int a = 0; a < 2; ++a) {
                    const int keyl = li * 64 + kc0 + 16 * a + q;
                    f32x4 acc = BT[i][a];
#pragma unroll
                    for (int ks = 0; ks < 2; ++ks) {
                        bf16x8 A; if constexpr (!(VAR & 64)) A = *(const LAS bf16x8*)(KL + keyl * 128 + ((((unsigned)(4 * ks + kq)) ^ ((unsigned)(keyl >> 1) & 7u)) << 4)); else A = qf[ks ^ 1];
                        if constexpr (!(VAR & 4)) acc = MFMA16(A, qf[ks], acc); else asm volatile("" :: "v"(A));
                    }
                    S[i][a] = acc;
                }
            }
            float l = 1.f;
            if constexpr (!(VAR & 1)) {
            float mx = -1e30f;
#pragma unroll
            for (int i = 0; i < 8; ++i)
#pragma unroll
                for (int a = 0; a < 2; ++a)
#pragma unroll
                    for (int j = 0; j < 4; ++j) mx = fmaxf(mx, S[i][a][j]);
            mx = fmaxf(mx, __shfl_xor(mx, 16)); mx = fmaxf(mx, __shfl_xor(mx, 32));
            l = 0.f;
#pragma unroll
            for (int i = 0; i < 8; ++i)
#pragma unroll
                for (int a = 0; a < 2; ++a)
#pragma unroll
                    for (int j = 0; j < 4; ++j) { const float e = ex2(S[i][a][j] - mx); S[i][a][j] = e; l += e; }
            l += __shfl_xor(l, 16); l += __shfl_xor(l, 32);
            }
            f32x4 O[4];
#pragma unroll
            for (int et = 0; et < 4; ++et) O[et] = (f32x4){0.f, 0.f, 0.f, 0.f};
#pragma unroll
            for (int i = 0; i < 8; ++i) {
                const int li = (rs + i) % 9;
                u32x4 w; w.x = pk2(S[i][0][0], S[i][0][1]); w.y = pk2(S[i][0][2], S[i][0][3]); w.z = pk2(S[i][1][0], S[i][1][1]); w.w = pk2(S[i][1][2], S[i][1][3]);
                const bf16x8 pf = __builtin_bit_cast(bf16x8, w);
#pragma unroll
                for (int et = 0; et < 4; ++et) {
                    const LAS unsigned char* vp = VTL + (16 * et + q) * 1168 + (li * 64 + kc0 + 4 * kq) * 2;
                    u32x4 av;
                    if constexpr (!(VAR & 64)) { const u32x2 lo = *(const LAS u32x2*)(vp), hi = *(const LAS u32x2*)(vp + 32); av.x = lo.x; av.y = lo.y; av.z = hi.x; av.w = hi.y; } else av = __builtin_bit_cast(u32x4, qf[et & 1]);
                    if constexpr (!(VAR & 2)) O[et] = MFMA16(__builtin_bit_cast(bf16x8, av), pf, O[et]); else asm volatile("" :: "v"(av), "v"(pf));
                }
            }
            const float inv = __builtin_amdgcn_rcpf(l);
#pragma unroll
            for (int et = 0; et < 4; ++et) {
                const int e0 = 16 * et + 4 * kq; const u32x2 ga = gf[et];
                const float g0 = bflo(ga.x), g1 = bfhi(ga.x), g2 = bflo(ga.y), g3 = bfhi(ga.y);
                u32x2 w; w.x = pk2(O[et][0] * inv * g0 * fsigm_fast(g0), O[et][1] * inv * g1 * fsigm_fast(g1)); w.y = pk2(O[et][2] * inv * g2 * fsigm_fast(g2), O[et][3] * inv * g3 * fsigm_fast(g3));
                *(u32x2*)(mixed + tok * 1024 + h * 64 + e0) = w;
            }
        }
        if constexpr (!(VAR & 16)) __syncthreads();
        if constexpr (!(VAR & 8)) {
        if (validA) { *(LAS u32x4*)(lds + kdst + (newA % 9) * 8192) = kn0; *(LAS u32x4*)(lds + vdst + (newA % 9) * 128) = vn0; }
        if (validB) { *(LAS u32x4*)(lds + kdst + (newB % 9) * 8192) = kn1; *(LAS u32x4*)(lds + vdst + (newB % 9) * 128) = vn1; }
        }
#pragma unroll
        for (int ks = 0; ks < 2; ++ks) qf[ks] = qn[ks];
#pragma unroll
        for (int et = 0; et < 4; ++et) gf[et] = gn[et];
    }
    __syncthreads();
}
#if defined(PROBE_EMPTY)
constexpr int N_PHASES = 15 + PROBE_EMPTY;
#elif defined(PROBE_ATT) || defined(PROBE_NA)
constexpr int N_PHASES = 16;
#else
constexpr int N_PHASES = 15;
#endif
__device__ __forceinline__ void run_phase(KPC p, const Frame& F, int ph) {
    unsigned char* ws = p->ws;
    if (ph == 0) { phase_p0a(p, F); return; }
    if (ph == 1) { phase_p0b(p, F); return; }
    if (ph == 14) { phase_final(p, F); return; }
#ifdef PROBE_EMPTY
    if (ph >= 15) { return; }
#endif
#ifdef PROBE_NA
    if (ph == 15) {
        for (int u = F.vcu; u < 256; u += F.G) { Frame Fu = F; asm volatile("" : "+v"(Fu.tid)); Fu.lane = Fu.tid & 63; na_unit<PROBE_NA>(p, Fu, 1, u >> 4, u & 15, (bf16_t*)(ws + WS_END)); }
        return;
    }
#endif
#ifdef PROBE_ATT
    if (ph == 15) {
        const float* scal = (const float*)(ws + WS_SCAL); const float lam = scal[0], lam_init = scal[1];
        { Frame Fu = F; asm volatile("" : "+v"(Fu.tid)); Fu.lane = Fu.tid & 63;
          const int cnt = (F.vcu < 1024) ? (1024 - F.vcu + F.G - 1) / F.G : 0;
          if (cnt > 0) attn_run<PROBE_ATT>(p, Fu, 0, lam, lam_init, (bf16_t*)(ws + WS_END), F.vcu, F.G, cnt); }
        return;
    }
#endif
    const int l = (ph - 2) / 3, k = (ph - 2) % 3, odd = l & 1, ei = l >> 1;
    bf16_t* xg = (bf16_t*)(ws + WS_XG); bf16_t* mixed = (bf16_t*)(ws + WS_MIXED); bf16_t* proj = (bf16_t*)(ws + WS_PROJ); bf16_t* VT = (bf16_t*)(ws + WS_VT);
    float* ssq = (float*)(ws + WS_SSQ); const float* sW = (const float*)(ws + WS_SW) + (size_t)l * 16 * 4096; const float* mod = (const float*)(ws + WS_MOD);
    if (k == 0) {
        const int N1 = odd ? 3072 : 2560, NV = odd ? 1024 : 512;
        const bf16_t* Wt = odd ? (const bf16_t*)(ws + WS_WTO) + (size_t)ei * 4096 * 1024 : (const bf16_t*)(ws + WS_WTE) + (size_t)ei * 3072 * 1024;
        { pg8::Gemm g{xg, Wt, MTOK, N1, 1024}; pg8::StaticOrder S; S.init(MTOK, N1, F.G, F.bx);
          EpiProj E{proj, N1, ssq, sW, odd ? 1024 : 512};
          pg8::gemm_phase<EpiProj, pg8::StaticOrder, true, true>(F.lds, g, S, E, F.tid); }
        { pg8::Gemm g{Wt + (size_t)N1 * 1024, xg, NV, MTOK, 1024}; pg8::StaticOrder S; S.init(NV, MTOK, F.G, F.bx);
          EpiProjT E{VT, NV, ssq, sW + N1, odd ? 0 : 1};
          pg8::gemm_phase<EpiProjT, pg8::StaticOrder, true, true>(F.lds, g, S, E, F.tid); }
    } else if (k == 1) {
        if (!odd) {
            const float* scal = (const float*)(ws + WS_SCAL); const float lam = scal[ei * 4 + 0], lam_init = scal[ei * 4 + 1];
            for (int u = F.vcu; u < 256; u += F.G) {
                Frame Fu = F; asm volatile("" : "+v"(Fu.tid)); Fu.lane = Fu.tid & 63;
                lru_unit(p, Fu, ei, u >> 4, (u >> 1) & 7, u & 1);
            }
            { Frame Fu = F; asm volatile("" : "+v"(Fu.tid)); Fu.lane = Fu.tid & 63;
              const int cnt = (F.vcu < 1024) ? (1024 - F.vcu + F.G - 1) / F.G : 0;
              if (cnt > 0) attn_run<0>(p, Fu, ei, lam, lam_init, mixed, F.vcu, F.G, cnt); }
#ifdef PROBE_MIX
            if (l == 0 && PROBE_MIX == 1) for (int u = F.vcu; u < 256; u += F.G) { Frame Fu = F; asm volatile("" : "+v"(Fu.tid)); Fu.lane = Fu.tid & 63; lru_unit(p, Fu, ei, u >> 4, (u >> 1) & 7, u & 1); }
#endif
        } else {
            for (int u = F.vcu; u < 256; u += F.G) { Frame Fu = F; asm volatile("" : "+v"(Fu.tid)); Fu.lane = Fu.tid & 63;
                na_unit<0>(p, Fu, ei, u >> 4, u & 15, mixed); }
        }
    } else {
        pg8::Gemm g{mixed, (const bf16_t*)(ws + WS_WTOUT) + (size_t)l * 1024 * 1024, MTOK, 1024, 1024}; pg8::StaticOrder S; S.init(MTOK, 1024, F.G, F.bx);
        bf16_t* xbf = (bf16_t*)(ws + WS_XB);
        EpiOut E{l == 0 ? p->x : nullptr, xbf, xbf, p->out, xg, ssq, mod + (size_t)l * 16 * 3072 + 2048, p->norm_g + (l < 3 ? (l + 1) * 1024 : 0), mod + (size_t)(l < 3 ? l + 1 : 0) * 16 * 3072 + 1024, l < 3 ? 1 : 0};
        pg8::gemm_phase<EpiOut, pg8::StaticOrder, true, true>(F.lds, g, S, E, F.tid);
    }
}


#define XB_TMO      128
#define XB_XCNT(j)  (256  + 64 * (j))
#define XB_XSUB(j)  (1280 + 64 * (j))
#define XB_XGEN(j)  (2304 + 64 * (j))
#define XB_TOP      3328
#define XB_TOPGEN   3392
#define XCD_BAR_WORDS 3456
#define XB_SPIN_CAP (1u << 20)
__device__ __forceinline__ unsigned xb_ld(unsigned* p)              { return __hip_atomic_load(p, __ATOMIC_RELAXED, __HIP_MEMORY_SCOPE_AGENT); }
__device__ __forceinline__ unsigned xb_add(unsigned* p, unsigned v) { return __hip_atomic_fetch_add(p, v, __ATOMIC_RELAXED, __HIP_MEMORY_SCOPE_AGENT); }
__device__ __forceinline__ unsigned xb_xcc_id() { return (unsigned)__builtin_amdgcn_s_getreg((3 << 11) | 20) & 0xFu; }
#define XB_SPIN(cond, bar) do { unsigned _sp = 0; while (cond) { __builtin_amdgcn_s_sleep(1); \
    if ((++_sp & 255u) == 0u) { if (xb_ld(&(bar)[XB_TMO])) break; if (_sp > XB_SPIN_CAP) { atomicAdd(&(bar)[XB_TMO], 1u); break; } } } } while (0)
struct XcdBarrier { unsigned* bar; unsigned x; volatile LAS unsigned* st; };
__device__ __forceinline__ XcdBarrier xcd_barrier_post(unsigned* bar, volatile LAS unsigned* st) {
    XcdBarrier b; b.bar = bar; b.x = xb_xcc_id(); b.st = st;
    if (threadIdx.x == 0) (void)xb_add(&bar[XB_XCNT(b.x)], 1u);
    return b;
}
__device__ __forceinline__ void xcd_barrier_complete(unsigned* bar, unsigned x, unsigned& nloc, unsigned& nx) {
    const unsigned G = gridDim.x * gridDim.y * gridDim.z;
    unsigned sum, cnt, mine, sp = 0u;
    for (;;) {
        sum = 0u; cnt = 0u; mine = 0u;
#pragma unroll
        for (unsigned j = 0; j < 16; ++j) { const unsigned c = xb_ld(&bar[XB_XCNT(j)]); sum += c; cnt += (c > 0u) ? 1u : 0u; mine = (j == x) ? c : mine; }
        if (sum == G) break;
        __builtin_amdgcn_s_sleep(1);
        if ((++sp & 255u) == 0u) { if (xb_ld(&bar[XB_TMO])) break; if (sp > XB_SPIN_CAP) { atomicAdd(&bar[XB_TMO], 1u); break; } }
    }
    nloc = mine > 0u ? mine : 1u; nx = cnt > 0u ? cnt : 1u;
}
__device__ __forceinline__ void xcd_barrier(const XcdBarrier& b) {
    asm volatile("s_waitcnt vmcnt(0)" ::: "memory");
    __syncthreads();
    if (threadIdx.x == 0) {
        unsigned* bar = b.bar;
        __builtin_amdgcn_s_waitcnt(0);
        unsigned nloc = b.st[0], nx = b.st[1];
        if (nloc == 0u) { xcd_barrier_complete(bar, b.x, nloc, nx); b.st[0] = nloc; b.st[1] = nx; }
        const unsigned old = xb_add(&bar[XB_XSUB(b.x)], 1u);
        const unsigned gen = old / nloc;
        if (old + 1u == (gen + 1u) * nloc) {
            __builtin_amdgcn_fence(__ATOMIC_RELEASE, "agent");
            asm volatile("s_waitcnt vmcnt(0)" ::: "memory");
            const unsigned og = xb_add(&bar[XB_TOP], 1u);
            const unsigned tg = og / nx;
            if (og + 1u == (tg + 1u) * nx) xb_add(&bar[XB_TOPGEN], 1u);
            else XB_SPIN(xb_ld(&bar[XB_TOPGEN]) == tg, bar);
            __builtin_amdgcn_fence(__ATOMIC_ACQUIRE, "agent");
            xb_add(&bar[XB_XGEN(b.x)], 1u);
            asm volatile("s_waitcnt vmcnt(0)" ::: "memory");
        } else {
            XB_SPIN(xb_ld(&bar[XB_XGEN(b.x)]) == gen, bar);
            __builtin_amdgcn_fence(__ATOMIC_ACQUIRE, "agent");
            asm volatile("s_waitcnt vmcnt(0)" ::: "memory");
        }
    }
    __syncthreads();
}
#ifndef MK_CG_SYNC
#define MK_CG_SYNC 0
#endif

__global__ void __launch_bounds__(512, 2) mega(KP p) {
    extern __shared__ __attribute__((aligned(16))) unsigned char lds_raw[];
#if !MK_CG_SYNC
    volatile LAS unsigned* misc = (volatile LAS unsigned*)((LAS unsigned char*)lds_raw + LDS_BYTES - 64);
    if (threadIdx.x < 16) misc[threadIdx.x] = 0u;
    __syncthreads();
    XcdBarrier xbar = xcd_barrier_post((unsigned*)(p.ws + WS_CTL), misc);
#endif
#ifdef PROBE_PH
    int probe_rep = 0;
#endif
    for (int ph = p.ph_lo; ph < p.ph_hi; ++ph) {
#if MK_CG_SYNC
        if (ph > p.ph_lo) cooperative_groups::this_grid().sync();
#else
        if (ph > p.ph_lo) xcd_barrier(xbar);
#endif
        KPC pp = (KPC)__builtin_amdgcn_kernarg_segment_ptr(); asm volatile("" : "+s"(pp));
        int tid = threadIdx.x; asm volatile("" : "+v"(tid));
        int bx = blockIdx.x; asm volatile("" : "+s"(bx));
        Frame F; F.lds = (LAS unsigned char*)lds_raw; F.tid = tid; F.lane = tid & 63; F.wave = __builtin_amdgcn_readfirstlane(tid >> 6);
        F.G = gridDim.x; F.bx = bx; F.vcu = (F.G % 8 == 0) ? (bx % 8) * (F.G / 8) + bx / 8 : bx;
        run_phase(pp, F, ph);
#ifdef PROBE_PH
        if (ph == PROBE_PH && probe_rep == 0) { probe_rep = 1; --ph; }
#endif
    }
}

#ifndef MK_PER_PHASE
#define MK_PER_PHASE 0
#endif
#ifndef MK_DBG
#define MK_DBG 0
#endif
#if MK_DBG
#endif

static void fill_kp(KP& p, void* const* d_in, void* d_out, void* d_ws) {
    const float** f = (const float**)&p;
    for (int i = 0; i < 21; ++i) f[i] = (const float*)d_in[i];
    p.out = (float*)d_out; p.ws = (unsigned char*)d_ws;
}

extern "C" void kernel_launch(void* const* d_in, const int* in_sizes, int n_in, void* d_out, int out_size, void* d_ws, size_t ws_size, hipStream_t stream) {
    static int grid = 0;
    if (grid == 0) {
        int dev = 0, cus = 0, per_cu = 0;
        if (n_in != 21 || out_size != MTOK * DM || ws_size < WS_END) { fprintf(stderr, "kernel_launch: unexpected shapes (n_in %d out %d ws %zu)\n", n_in, out_size, ws_size); grid = -1; return; }
        (void)hipGetDevice(&dev); (void)hipDeviceGetAttribute(&cus, hipDeviceAttributeMultiprocessorCount, dev);
        if (hipFuncSetAttribute((const void*)mega, hipFuncAttributeMaxDynamicSharedMemorySize, LDS_BYTES) != hipSuccess) { fprintf(stderr, "kernel_launch: hipFuncSetAttribute failed\n"); grid = -1; return; }
        if (hipOccupancyMaxActiveBlocksPerMultiprocessor(&per_cu, (const void*)mega, 512, LDS_BYTES) != hipSuccess || per_cu < 1) { fprintf(stderr, "kernel_launch: occupancy query says %d\n", per_cu); per_cu = 1; }
        (void)hipGetLastError();
        grid = cus * 1;
        if (grid % 8 != 0 || grid < 8) grid = 256;
    }
    if (grid < 0) return;
    KP p{}; fill_kp(p, d_in, d_out, d_ws);
#if MK_DBG
    dbg_forward(p, grid, stream);
#elif MK_PER_PHASE
    (void)hipMemsetAsync((char*)d_ws + WS_CTL, 0, 65536, stream);
    for (int ph = 0; ph < N_PHASES; ++ph) { p.ph_lo = ph; p.ph_hi = ph + 1; hipLaunchKernelGGL(mega, dim3(grid), dim3(512), LDS_BYTES, stream, p); }
#else
    p.ph_lo = 0; p.ph_hi = N_PHASES;
#if MK_CG_SYNC
    void* args[] = {&p};
    hipError_t e = hipLaunchCooperativeKernel((const void*)mega, dim3(grid), dim3(512), args, LDS_BYTES, stream);
    if (e != hipSuccess) fprintf(stderr, "cooperative launch failed: %s (grid %d)\n", hipGetErrorString(e), grid);
#else
    (void)hipMemsetAsync((char*)d_ws + WS_CTL, 0, 65536, stream);
    hipLaunchKernelGGL(mega, dim3(grid), dim3(512), LDS_BYTES, stream, p);
#endif
#endif
}
```

```cpp
#include <hip/hip_runtime.h>
#include <hip/hip_cooperative_groups.h>
#include <cstdio>
#include <cstdint>
#include <cmath>

#define LAS __attribute__((address_space(3)))
typedef unsigned short bf16_t;
typedef short bf16x8 __attribute__((ext_vector_type(8)));
typedef float f32x4 __attribute__((ext_vector_type(4)));
typedef float f32x16 __attribute__((ext_vector_type(16)));
typedef unsigned u32x4 __attribute__((ext_vector_type(4)));
typedef unsigned u32x2 __attribute__((ext_vector_type(2)));
typedef float f32x2_t __attribute__((ext_vector_type(2)));
typedef __bf16 bf16x2_t __attribute__((ext_vector_type(2)));

__device__ __forceinline__ unsigned pk2(float lo, float hi) { f32x2_t v = {lo, hi}; bf16x2_t b = __builtin_convertvector(v, bf16x2_t); return __builtin_bit_cast(unsigned, b); }
__device__ __forceinline__ float bflo(unsigned w) { return __uint_as_float(w << 16); }
__device__ __forceinline__ float bfhi(unsigned w) { return __uint_as_float(w & 0xffff0000u); }
__device__ __forceinline__ float bf2f(bf16_t h) { return __uint_as_float((unsigned)h << 16); }
__device__ __forceinline__ float fsilu(float v) { return v / (1.f + __expf(-v)); }
__device__ __forceinline__ float fsigm(float v) { return 1.f / (1.f + __expf(-v)); }
__device__ __forceinline__ float ex2(float v) { return __builtin_amdgcn_exp2f(v); }
__device__ __forceinline__ float wave_sum(float v) {
#pragma unroll
    for (int o = 1; o < 64; o <<= 1) v += __shfl_xor(v, o);
    return v;
}
__device__ __forceinline__ int t5_bucket(int rel) {
    const int n = rel < 0 ? -rel : rel; const int ret = rel > 0 ? 16 : 0;
    int v; if (n < 8) v = n; else { v = 33 - __clz(n * n); if (v > 15) v = 15; }
    return ret + v;
}
#define LDS_WAIT() asm volatile("s_waitcnt lgkmcnt(0)" ::: "memory")
constexpr float LOG2E = 1.4426950408889634f;
constexpr float QSCALE = 0.125f * 1.4426950408889634f;

constexpr int DM = 1024, SEQ = 2048, NBATCH = 16, MTOK = NBATCH * SEQ;
constexpr size_t MiB = 1u << 20;
constexpr size_t WS_CTL = 0, WS_MOD = 1 * MiB, WS_SW = 2 * MiB, WS_SSQ = 3 * MiB, WS_SCAL = 5 * MiB, WS_WG = 5 * MiB + 65536;
constexpr size_t WS_WTE = 6 * MiB, WS_WTO = 18 * MiB, WS_WTOUT = 34 * MiB;
constexpr size_t WS_XG = 48 * MiB, WS_MIXED = 112 * MiB, WS_PROJ = 176 * MiB, WS_PROJG_E = 240 * MiB, WS_PROJG_O = 304 * MiB  , WS_VT = 368 * MiB, WS_XB = 432 * MiB, WS_END = 496 * MiB;
constexpr int LDS_BYTES = 163840;
constexpr int LDS_SPARE = 131072;

struct KP {
    const float *x, *c, *ada_w, *ada_b, *norm_g, *final_g, *t5, *even_w_in, *even_w_out, *da_lam, *da_subg, *conv_w, *conv_b, *w_a, *b_a, *w_x, *b_x, *lru_lam, *odd_w_in, *odd_w_out, *rpb;
    float* out; unsigned char* ws; int ph_lo, ph_hi;
};
typedef const __attribute__((address_space(4))) KP* KPC;
struct Frame { LAS unsigned char* lds; int tid, lane, wave, vcu, G, bx; };

namespace pg8 {
constexpr int BM = 256, BK = 64, HALF = 128, HTB = HALF * BK * 2, STAGE_BYTES = 8 * HTB, NXCD = 8, WGM = 8;
__host__ __device__ __forceinline__ int lds_byte(int r, int c) { const int st = (r >> 4) * 2 + (c >> 5), rr = r & 15, cc = c & 31, ob = rr * 64 + cc * 2; return st * 1024 + (ob ^ (((ob >> 9) & 1) << 5)); }
__host__ __device__ __forceinline__ void stage_rc(int b, int& R, int& C) { const int st = b / 1024, sb = b % 1024, swz = sb ^ (((sb >> 9) & 1) << 5); R = (st >> 1) * 16 + swz / 64; C = (st & 1) * 32 + (swz % 64) / 2; }
__host__ __device__ __forceinline__ int perm32(int rho) { const int n = rho >> 4, i = rho & 15; return 8 * (i >> 2) + 4 * n + (i & 3); }
struct Unit { int pm, pn; };
struct Gemm { const bf16_t* A; const bf16_t* Bt; int M, N, K; };
struct StaticOrder {
    int nM, nN, nwg, G, c;
    __host__ __device__ void init(int M, int N, int G_, int c_) { nM = M / BM; nN = N / BM; nwg = nM * nN; G = G_; c = c_; }
    __host__ __device__ bool next(int i, Unit& u) const {
        const long L = (long)i * G + c; if (L >= nwg) return false;
        int wgid = (int)L; { const int q = nwg / NXCD, r = nwg % NXCD, xcd = wgid % NXCD, off = wgid / NXCD; wgid = (xcd < r ? xcd * (q + 1) : r * (q + 1) + (xcd - r) * q) + off; }
        const int nig = WGM * nN, gid = wgid / nig, fm = gid * WGM, gsz = (nM - fm) < WGM ? (nM - fm) : WGM;
        u.pm = fm + ((wgid % nig) % gsz); u.pn = (wgid % nig) / gsz; return true;
    }
};

template <class Epi, class Sched, bool ALIGN_EPI = false, bool SP2 = false>
__device__ __forceinline__ void gemm_phase(LAS unsigned char* lds, const Gemm g, const Sched& S, const Epi& E, const int tid) {
    const int wid = __builtin_amdgcn_readfirstlane(tid >> 6), lane = tid & 63, wr = wid >> 2, wc = wid & 3, fr = lane & 15, fq = lane >> 4;
    const int K = g.K, nt = K / BK;
    unsigned voffA[2], voffB[2];
#pragma unroll
    for (int i = 0; i < 2; ++i) { int R, C; stage_rc(tid * 16 + i * 8192, R, C); const int Rb = Epi::PERM ? ((R & ~31) + perm32(R & 31)) : R;
        voffA[i] = (unsigned)(R * K + C) * 2u; voffB[i] = (unsigned)(Rb * K + C) * 2u; }
    const size_t kstep = (size_t)(BK * 2);
    const size_t hstep = (size_t)HALF * K * 2;
    const size_t tstep = 2 * hstep;
    const unsigned ldsw = (unsigned)wid * 1024u;
    const int aoff = lds_byte(wr * 64 + fr, fq * 8), boff = lds_byte(wc * 32 + fr, fq * 8);
#define PG8_SA(b, h) (((b) * 2 + (h)) * HTB)
#define PG8_SB(b, h) ((4 + (b) * 2 + (h)) * HTB)
#define PG8_STAGE(bufoff, gbase, voff) do { _Pragma("unroll") for (int _i = 0; _i < 2; ++_i) \
        __builtin_amdgcn_global_load_lds((const unsigned*)((const char*)(gbase) + (voff)[_i]), (LAS unsigned*)(lds + (bufoff) + ldsw + _i * 8192), 16, 0, 0); } while (0)
#define PG8_LDA(dst, b, h) do { _Pragma("unroll") for (int m = 0; m < 4; ++m) _Pragma("unroll") for (int k = 0; k < 2; ++k) dst[m][k] = *(const LAS bf16x8*)(lds + PG8_SA(b, h) + aoff + m * 2048 + k * 1024); } while (0)
#define PG8_LDB(dst, b, h) do { _Pragma("unroll") for (int n = 0; n < 2; ++n) _Pragma("unroll") for (int k = 0; k < 2; ++k) dst[n][k] = *(const LAS bf16x8*)(lds + PG8_SB(b, h) + boff + n * 2048 + k * 1024); } while (0)
#define PG8_MMA(ai, bj, At, Bt) do { __builtin_amdgcn_s_setprio(1); _Pragma("unroll") for (int m = 0; m < 4; ++m) _Pragma("unroll") for (int n = 0; n < 2; ++n) _Pragma("unroll") for (int k = 0; k < 2; ++k) \
        acc[ai][bj][m][n] = __builtin_amdgcn_mfma_f32_16x16x32_bf16(Bt[n][k], At[m][k], acc[ai][bj][m][n], 0, 0, 0); __builtin_amdgcn_s_setprio(0); } while (0)
#define PG8_WAIT_V(n) asm volatile("s_waitcnt vmcnt(" #n ")" ::: "memory")
#define PG8_WAIT_L(n) asm volatile("s_waitcnt lgkmcnt(" #n ")" ::: "memory")
#define PG8_BAR __builtin_amdgcn_s_barrier()
#define PG8_SCHED __builtin_amdgcn_sched_barrier(0)
    Unit cur, nxt; int ui = 0;
    if (!S.next(0, cur)) return;
    f32x4 acc[2][2][4][2];
#pragma unroll
    for (int a = 0; a < 2; ++a)
#pragma unroll
        for (int b = 0; b < 2; ++b)
#pragma unroll
            for (int m = 0; m < 4; ++m)
#pragma unroll
                for (int n = 0; n < 2; ++n) acc[a][b][m][n] = (f32x4){0.f, 0.f, 0.f, 0.f};
    bf16x8 At[4][2], B0[2][2], B1[2][2];
    const char* cA = (const char*)g.A + (size_t)cur.pm * tstep; const char* cB = (const char*)g.Bt + (size_t)cur.pn * tstep;
    if constexpr (SP2) {
        PG8_STAGE(PG8_SB(0, 0), cB, voffB); PG8_STAGE(PG8_SB(0, 1), cB + hstep, voffB); PG8_STAGE(PG8_SA(0, 0), cA, voffA); PG8_STAGE(PG8_SA(0, 1), cA + hstep, voffA);
        if (wr == 1) PG8_BAR;
        PG8_WAIT_V(2); PG8_BAR;
        PG8_STAGE(PG8_SB(1, 0), cB + kstep, voffB); PG8_STAGE(PG8_SA(1, 0), cA + kstep, voffA); PG8_STAGE(PG8_SB(1, 1), cB + hstep + kstep, voffB);
        PG8_WAIT_V(6); PG8_BAR;
    } else {
        PG8_STAGE(PG8_SB(0, 0), cB, voffB); PG8_STAGE(PG8_SA(0, 0), cA, voffA); PG8_STAGE(PG8_SB(0, 1), cB + hstep, voffB); PG8_STAGE(PG8_SA(0, 1), cA + hstep, voffA);
        if (wr == 1) PG8_BAR;
        PG8_WAIT_V(4); PG8_BAR;
        PG8_STAGE(PG8_SB(1, 0), cB + kstep, voffB); PG8_STAGE(PG8_SA(1, 0), cA + kstep, voffA); PG8_STAGE(PG8_SB(1, 1), cB + hstep + kstep, voffB);
        PG8_WAIT_V(6); PG8_BAR;
    }
    for (;;) {
        const bool has_next = S.next(ui + 1, nxt);
        const char* nA = has_next ? (const char*)g.A + (size_t)nxt.pm * tstep : cA; const char* nB = has_next ? (const char*)g.Bt + (size_t)nxt.pn * tstep : cB;
        for (int t = 0; t < nt; t += 2) {
            const bool last = (t == nt - 2);
            const char* a1 = cA + (size_t)(t + 1) * kstep;
            const char* a2 = last ? nA : cA + (size_t)(t + 2) * kstep; const char* b2 = last ? nB : cB + (size_t)(t + 2) * kstep;
            const char* a3 = a2 + kstep; const char* b3 = b2 + kstep;
            if constexpr (SP2) {
            PG8_LDB(B0, 0, 0); PG8_LDB(B1, 0, 1); PG8_SCHED; PG8_LDA(At, 0, 0); PG8_STAGE(PG8_SA(1, 1), a1 + hstep, voffA);
            PG8_WAIT_V(8); PG8_WAIT_L(0); PG8_BAR; PG8_MMA(0, 0, At, B0); PG8_MMA(0, 1, At, B1); PG8_BAR; PG8_SCHED;
            PG8_LDA(At, 0, 1); PG8_STAGE(PG8_SB(0, 0), b2, voffB); PG8_STAGE(PG8_SB(0, 1), b2 + hstep, voffB); PG8_STAGE(PG8_SA(0, 0), a2, voffA);
            PG8_WAIT_V(8); PG8_WAIT_L(0); PG8_BAR; PG8_MMA(1, 0, At, B0); PG8_MMA(1, 1, At, B1); PG8_BAR; PG8_SCHED;
            PG8_LDB(B0, 1, 0); PG8_LDB(B1, 1, 1); PG8_SCHED; PG8_LDA(At, 1, 0); PG8_STAGE(PG8_SA(0, 1), a2 + hstep, voffA);
            PG8_WAIT_V(8); PG8_WAIT_L(0); PG8_BAR; PG8_MMA(0, 0, At, B0); PG8_MMA(0, 1, At, B1); PG8_BAR; PG8_SCHED;
            PG8_LDA(At, 1, 1); PG8_STAGE(PG8_SB(1, 0), b3, voffB); PG8_STAGE(PG8_SB(1, 1), b3 + hstep, voffB); PG8_STAGE(PG8_SA(1, 0), a3, voffA);
            PG8_WAIT_V(8); PG8_WAIT_L(0); PG8_BAR; PG8_MMA(1, 0, At, B0); PG8_MMA(1, 1, At, B1); PG8_BAR; PG8_SCHED;
            } else {
            PG8_LDB(B0, 0, 0); PG8_SCHED; PG8_LDA(At, 0, 0); PG8_STAGE(PG8_SA(1, 1), a1 + hstep, voffA);
            PG8_WAIT_L(8); PG8_BAR; PG8_WAIT_L(0); PG8_MMA(0, 0, At, B0); PG8_BAR; PG8_SCHED;
            PG8_LDB(B1, 0, 1); PG8_STAGE(PG8_SB(0, 0), b2, voffB);
            PG8_BAR; PG8_WAIT_L(0); PG8_MMA(0, 1, At, B1); PG8_BAR;
            PG8_LDA(At, 0, 1); PG8_STAGE(PG8_SA(0, 0), a2, voffA);
            PG8_BAR; PG8_WAIT_L(0); PG8_MMA(1, 0, At, B0); PG8_BAR; PG8_SCHED;
            PG8_STAGE(PG8_SB(0, 1), b2 + hstep, voffB);
            PG8_WAIT_V(6); PG8_BAR; PG8_MMA(1, 1, At, B1); PG8_BAR;
            PG8_LDB(B0, 1, 0); PG8_SCHED; PG8_LDA(At, 1, 0); PG8_STAGE(PG8_SA(0, 1), a2 + hstep, voffA);
            PG8_WAIT_L(8); PG8_BAR; PG8_WAIT_L(0); PG8_MMA(0, 0, At, B0); PG8_BAR; PG8_SCHED;
            PG8_LDB(B1, 1, 1); PG8_STAGE(PG8_SB(1, 0), b3, voffB);
            PG8_BAR; PG8_WAIT_L(0); PG8_MMA(0, 1, At, B1); PG8_BAR;
            PG8_LDA(At, 1, 1); PG8_STAGE(PG8_SA(1, 0), a3, voffA);
            PG8_BAR; PG8_WAIT_L(0); PG8_MMA(1, 0, At, B0); PG8_BAR; PG8_SCHED;
            PG8_STAGE(PG8_SB(1, 1), b3 + hstep, voffB);
            PG8_WAIT_V(6); PG8_BAR; PG8_MMA(1, 1, At, B1); PG8_BAR;
            }
        }
        if constexpr (ALIGN_EPI) { if (wr == 0) PG8_BAR; }
        E(acc, cur, wr, wc, fr, fq);
        if (!has_next) break;
#pragma unroll
        for (int a = 0; a < 2; ++a)
#pragma unroll
            for (int b = 0; b < 2; ++b)
#pragma unroll
                for (int m = 0; m < 4; ++m)
#pragma unroll
                    for (int n = 0; n < 2; ++n) acc[a][b][m][n] = (f32x4){0.f, 0.f, 0.f, 0.f};
        cur = nxt; cA = nA; cB = nB; ++ui;
        if constexpr (ALIGN_EPI) { if (wr == 1) PG8_BAR; }
    }
    PG8_WAIT_V(0);
    if constexpr (!ALIGN_EPI) { if (wr == 0) PG8_BAR; }
    PG8_BAR;
#undef PG8_SA
#undef PG8_SB
#undef PG8_STAGE
#undef PG8_LDA
#undef PG8_LDB
#undef PG8_MMA
#undef PG8_WAIT_V
#undef PG8_WAIT_L
#undef PG8_BAR
#undef PG8_SCHED
}
}
__device__ __forceinline__ float ssq_rinv(const float* ssq, int row) {
    const f32x4* sp = (const f32x4*)(ssq + (size_t)row * 16);
    const f32x4 a = sp[0], b = sp[1], c = sp[2], d = sp[3];
    const float s = ((a[0] + a[1]) + (a[2] + a[3])) + ((b[0] + b[1]) + (b[2] + b[3])) + ((c[0] + c[1]) + (c[2] + c[3])) + ((d[0] + d[1]) + (d[2] + d[3]));
    return rsqrtf(s * (1.f / 1024.f) + 1e-6f);
}
template <int EV> struct EpiProjV {
    static constexpr bool PERM = true;
    bf16_t* O; bf16_t* OG; int qkcols; int ldg; const float* ssq; const float* sW; int qcols;
    __device__ __forceinline__ void operator()(const f32x4 (&acc)[2][2][4][2], const pg8::Unit& u, int wr, int wc, int fr, int fq) const {
        const int row0 = u.pm * 256 + wr * 64 + fr, colb = u.pn * 256 + wc * 32 + 8 * fq, b = (u.pm * 256) >> 11;
        const float* sWb = sW + (size_t)b * 4096;
        f32x4 bv[2][2];
#pragma unroll
        for (int bj = 0; bj < 2; ++bj)
#pragma unroll
            for (int n = 0; n < 2; ++n) bv[bj][n] = (EV & 4) ? (f32x4){0.f, 0.f, 0.f, 0.f} : *(const f32x4*)(sWb + colb + bj * 128 + 4 * n);
#pragma unroll
        for (int ai = 0; ai < 2; ++ai)
#pragma unroll
            for (int m = 0; m < 4; ++m) {
                const int row = row0 + ai * 128 + m * 16; const float rt = (EV & 1) ? 1.f : ssq_rinv(ssq, row);
                const int colt = u.pn * 256;
                bf16_t* rowp = (colt < qkcols) ? O + (((size_t)(b * (qkcols >> 6) + (colb >> 6))) * 2048 + (row & 2047)) * 64 + (colb & 63)
                                               : OG + (size_t)row * ldg + (colb - qkcols);
                const int bjs = (colt < qkcols) ? 2 * 2048 * 64 : 128;
#pragma unroll
                for (int bj = 0; bj < 2; ++bj) {
                    const float sc = (u.pn * 256 + bj * 128 < qcols) ? QSCALE : 1.f;
                    const f32x4 v0 = (acc[ai][bj][m][0] * rt + bv[bj][0]) * sc, v1 = (acc[ai][bj][m][1] * rt + bv[bj][1]) * sc;
                    u32x4 w; w.x = pk2(v0[0], v0[1]); w.y = pk2(v0[2], v0[3]); w.z = pk2(v1[0], v1[1]); w.w = pk2(v1[2], v1[3]);
                    if constexpr (!(EV & 2)) *(u32x4*)(rowp + (size_t)bj * bjs) = w; else asm volatile("" :: "v"(w));
                }
            }
    }
};
typedef EpiProjV<0> EpiProj;
struct EpiProjT {
    static constexpr bool PERM = true;
    bf16_t* VT; int NV; const float* ssq; const float* sW;   int swap23;
    __device__ __forceinline__ void operator()(const f32x4 (&acc)[2][2][4][2], const pg8::Unit& u, int wr, int wc, int fr, int fq) const {
        const int tok0 = u.pn * 256, b = tok0 >> 11, t0 = tok0 & 2047;
        const int vrow0 = u.pm * 256 + wr * 64 + fr;
        const float* sWb = sW + (size_t)b * 4096;
        bf16_t* base = VT + (size_t)b * NV * 2048 + t0;
#pragma unroll
        for (int bj = 0; bj < 2; ++bj) {
            float rt[2][4];
#pragma unroll
            for (int n = 0; n < 2; ++n)
#pragma unroll
                for (int i = 0; i < 4; ++i) rt[n][i] = ssq_rinv(ssq, tok0 + bj * 128 + wc * 32 + 8 * fq + 4 * n + i);
            const int cl = bj * 128 + wc * 32;
#pragma unroll
            for (int ai = 0; ai < 2; ++ai)
#pragma unroll
                for (int m = 0; m < 4; ++m) {
                    const int vrow = vrow0 + ai * 128 + m * 16; const float bias = sWb[vrow];
                    bf16_t* rowp = base + (size_t)vrow * 2048 + cl;
                    const f32x4 a0 = acc[ai][bj][m][0], a1 = acc[ai][bj][m][1];
                    u32x2 w0, w1;
                    w0.x = pk2(a0[0] * rt[0][0] + bias, a0[1] * rt[0][1] + bias); w0.y = pk2(a0[2] * rt[0][2] + bias, a0[3] * rt[0][3] + bias);
                    w1.x = pk2(a1[0] * rt[1][0] + bias, a1[1] * rt[1][1] + bias); w1.y = pk2(a1[2] * rt[1][2] + bias, a1[3] * rt[1][3] + bias);
                    if (swap23) {
                        *(u32x2*)(rowp + 16 * (fq >> 1) + 4 * (fq & 1)) = w0;
                        *(u32x2*)(rowp + 16 * (fq >> 1) + 8 + 4 * (fq & 1)) = w1;
                    } else {
                        u32x4 w; w.x = w0.x; w.y = w0.y; w.z = w1.x; w.w = w1.y; *(u32x4*)(rowp + 8 * fq) = w;
                    }
                }
        }
    }
};
struct EpiOut {
    static constexpr bool PERM = true;
    const float* xin_f32; const bf16_t* xin_b; bf16_t* xout_b; float* xout_f32; bf16_t* xg; float* ssq; const float* gate;   const float* gnext; const float* scnext;   int has_next;
    __device__ __forceinline__ void operator()(const f32x4 (&acc)[2][2][4][2], const pg8::Unit& u, int wr, int wc, int fr, int fq) const {
        const int row0 = u.pm * 256 + wr * 64 + fr, colb = u.pn * 256 + wc * 32 + 8 * fq, b = (u.pm * 256) >> 11;
        f32x4 gv[2][2], Gn[2][2];
#pragma unroll
        for (int bj = 0; bj < 2; ++bj)
#pragma unroll
            for (int n = 0; n < 2; ++n) {
                const int col = colb + bj * 128 + 4 * n;
                gv[bj][n] = *(const f32x4*)(gate + (size_t)b * 3072 + col);
                if (has_next) { const f32x4 g = *(const f32x4*)(gnext + col), s = *(const f32x4*)(scnext + (size_t)b * 3072 + col); Gn[bj][n] = g * (s + 1.f); }
                else Gn[bj][n] = (f32x4){0.f, 0.f, 0.f, 0.f};
            }
#pragma unroll
        for (int ai = 0; ai < 2; ++ai)
#pragma unroll
            for (int m = 0; m < 4; ++m) {
                const int row = row0 + ai * 128 + m * 16; float ps = 0.f;
#pragma unroll
                for (int bj = 0; bj < 2; ++bj) {
                    const size_t off = (size_t)row * 1024 + colb + bj * 128;
                    f32x4 x0, x1;
                    if (xin_f32) { x0 = *(const f32x4*)(xin_f32 + off); x1 = *(const f32x4*)(xin_f32 + off + 4); }
                    else { const u32x4 xb = *(const u32x4*)(xin_b + off); x0 = (f32x4){bflo(xb.x), bfhi(xb.x), bflo(xb.y), bfhi(xb.y)}; x1 = (f32x4){bflo(xb.z), bfhi(xb.z), bflo(xb.w), bfhi(xb.w)}; }
                    const f32x4 y0 = x0 + gv[bj][0] * acc[ai][bj][m][0], y1 = x1 + gv[bj][1] * acc[ai][bj][m][1];
                    ps += (y0[0] * y0[0] + y0[1] * y0[1]) + (y0[2] * y0[2] + y0[3] * y0[3]) + (y1[0] * y1[0] + y1[1] * y1[1]) + (y1[2] * y1[2] + y1[3] * y1[3]);
                    if (has_next) {
                        u32x4 w; w.x = pk2(y0[0], y0[1]); w.y = pk2(y0[2], y0[3]); w.z = pk2(y1[0], y1[1]); w.w = pk2(y1[2], y1[3]); *(u32x4*)(xout_b + off) = w;
                        const f32x4 z0 = y0 * Gn[bj][0], z1 = y1 * Gn[bj][1];
                        u32x4 v; v.x = pk2(z0[0], z0[1]); v.y = pk2(z0[2], z0[3]); v.z = pk2(z1[0], z1[1]); v.w = pk2(z1[2], z1[3]); *(u32x4*)(xg + off) = v;
                    } else { *(f32x4*)(xout_f32 + off) = y0; *(f32x4*)(xout_f32 + off + 4) = y1; }
                }
                ps += __shfl_xor(ps, 16); ps += __shfl_xor(ps, 32);
                if (fq == 0) ssq[(size_t)row * 16 + u.pn * 4 + wc] = ps;
            }
    }
};

__device__ __forceinline__ int remap_col(int n, int mode) {
    if (mode == 1) return n < 1024 ? n : (n < 1536 ? n + 1536 : n - 512);
    if (mode == 2) return n < 2048 ? n : (n < 3072 ? n + 1024 : n - 1024);
    return n;
}
__device__ __forceinline__ int unmap_col(int c, int odd) {
    if (!odd) return c < 1024 ? c : (c < 2560 ? c + 512 : c - 1536);
    return c < 2048 ? c : (c < 3072 ? c + 1024 : c - 1024);
}
__device__ __forceinline__ void p0_transpose_item(const float* W, int K, int N, bf16_t* WT, int item, LAS float* scr, int lane, int mode) {
    const int nblk = N / 32, kb = item / nblk, nb = item % nblk, k0 = 64 * kb, n0 = 32 * nb;
#pragma unroll 8
    for (int i = 0; i < 32; ++i) { const int kk = 2 * i + (lane >> 5); scr[kk * 33 + (lane & 31)] = W[(size_t)(k0 + kk) * N + n0 + (lane & 31)]; }
    LDS_WAIT(); asm volatile("" ::: "memory");
    const int c = lane & 7;
#pragma unroll
    for (int j = 0; j < 4; ++j) { const int n = (lane >> 3) + 8 * j; const LAS float* s = scr + (8 * c) * 33 + n;
        u32x4 o; o.x = pk2(s[0 * 33], s[1 * 33]); o.y = pk2(s[2 * 33], s[3 * 33]); o.z = pk2(s[4 * 33], s[5 * 33]); o.w = pk2(s[6 * 33], s[7 * 33]);
        *(u32x4*)(WT + (size_t)remap_col(n0 + n, mode) * K + k0 + 8 * c) = o; }
    LDS_WAIT(); asm volatile("" ::: "memory");
}
__device__ __forceinline__ void gemv16_item(const LAS float* vec, const float* W, int ldw, int col0, float* out, int out_ld, int ocol0, const float* bias, int lane) {
    const int n = lane & 15, kq = lane >> 4;
    float acc[16];
#pragma unroll
    for (int b = 0; b < 16; ++b) acc[b] = 0.f;
    const float* wp = W + (size_t)(kq * 256) * ldw + col0 + n; const LAS float* vp = vec + kq * 256;
    for (int i0 = 0; i0 < 256; i0 += 16) {
        float w[16];
#pragma unroll
        for (int j = 0; j < 16; ++j) w[j] = wp[(size_t)(i0 + j) * ldw];
#pragma unroll
        for (int j = 0; j < 16; ++j)
#pragma unroll
            for (int b = 0; b < 16; ++b) acc[b] += vp[b * 1024 + i0 + j] * w[j];
    }
#pragma unroll
    for (int b = 0; b < 16; ++b) { acc[b] += __shfl_xor(acc[b], 16); acc[b] += __shfl_xor(acc[b], 32); }
    if (kq == 0) { const float bs = bias ? bias[col0 + n] : 0.f;
#pragma unroll
        for (int b = 0; b < 16; ++b) out[(size_t)b * out_ld + ocol0 + n] = acc[b] + bs; }
}

__device__ __forceinline__ void phase_p0a(KPC p, const Frame& F) {
    unsigned char* ws = p->ws;
    bf16_t* WtE = (bf16_t*)(ws + WS_WTE); bf16_t* WtO = (bf16_t*)(ws + WS_WTO); bf16_t* WtOut = (bf16_t*)(ws + WS_WTOUT); bf16_t* Wg = (bf16_t*)(ws + WS_WG);
    float* mod = (float*)(ws + WS_MOD); float* scal = (float*)(ws + WS_SCAL);
    LAS float* scr = (LAS float*)(F.lds + F.wave * 8448);
    LAS float* vec = (LAS float*)(F.lds + 73728);
    const int gw = F.vcu * 8 + F.wave, NGW = F.G * 8;
    for (int i = F.tid; i < 16384; i += 512) vec[i] = fsilu(p->c[i]);
    for (int it = gw; it < 9216; it += NGW) {
        int r = it;
        if (r < 3072) { const int e = r / 1536; p0_transpose_item(p->even_w_in + (size_t)e * 1024 * 3072, 1024, 3072, WtE + (size_t)e * 3072 * 1024, r % 1536, scr, F.lane, 1); continue; }
        r -= 3072;
        if (r < 4096) { const int o = r / 2048; p0_transpose_item(p->odd_w_in + (size_t)o * 1024 * 4096, 1024, 4096, WtO + (size_t)o * 4096 * 1024, r % 2048, scr, F.lane, 2); continue; }
        r -= 4096;
        { const int j = r / 512; const int l = (j < 2) ? 2 * j : 2 * (j - 2) + 1; const float* src = (j < 2) ? p->even_w_out + (size_t)j * 1024 * 1024 : p->odd_w_out + (size_t)(j - 2) * 1024 * 1024;
          p0_transpose_item(src, 1024, 1024, WtOut + (size_t)l * 1024 * 1024, r % 512, scr, F.lane, 0); }
    }
    for (int idx = gw * 64 + F.lane; idx < 262144; idx += NGW * 64) {
        const int k = idx & 63, j = (idx >> 6) & 255, n = (idx >> 14) & 7, e = idx >> 17; const int set = j >> 6, d = j & 63, r = set >> 1;
        const float* src = (set & 1) ? p->w_x : p->w_a;
        const float v = src[((((size_t)e * 2 + r) * 8 + n) * 64 + k) * 64 + d];
        Wg[idx] = (bf16_t)(pk2(v, 0.f) & 0xffffu);
    }
    if (F.bx == 0 && F.tid < 2) {
        const int e = F.tid; const float* lp = p->da_lam + e * 256; float s01 = 0.f, s23 = 0.f;
        for (int i = 0; i < 64; ++i) { s01 += lp[i] * lp[64 + i]; s23 += lp[128 + i] * lp[192 + i]; }
        const float lam_init = (e == 0) ? 0.2f : 0.47071302f;
        scal[e * 4 + 0] = expf(s01) - expf(s23) + lam_init; scal[e * 4 + 1] = lam_init;
    }
    __syncthreads();
    for (int it = F.wave * F.G + F.vcu; it < 768; it += NGW) {
        const int l = it / 192, ch = it % 192;
        gemv16_item(vec, p->ada_w + (size_t)l * 1024 * 3072, 3072, ch * 16, mod + (size_t)l * 16 * 3072, 3072, ch * 16, p->ada_b + l * 3072, F.lane);
    }
}
__device__ __forceinline__ void phase_p0b(KPC p, const Frame& F) {
    unsigned char* ws = p->ws;
    const float* mod = (const float*)(ws + WS_MOD); float* sW = (float*)(ws + WS_SW); float* ssq = (float*)(ws + WS_SSQ); bf16_t* xg = (bf16_t*)(ws + WS_XG);
    LAS float* vec = (LAS float*)(F.lds);
    const int l = F.vcu & 3;
    for (int i = F.tid; i < 16384; i += 512) vec[i] = mod[((size_t)l * 16 + (i >> 10)) * 3072 + (i & 1023)];
    __syncthreads();
    {
        const int odd = l & 1, N = odd ? 4096 : 3072;
        const float* W = odd ? p->odd_w_in + (size_t)(l >> 1) * 1024 * 4096 : p->even_w_in + (size_t)(l >> 1) * 1024 * 3072;
        for (int it = (F.vcu >> 2) * 8 + F.wave; it < N / 16; it += (F.G >> 2) * 8)
            gemv16_item(vec, W, N, unmap_col(it * 16, odd), sW + (size_t)l * 16 * 4096, 4096, it * 16, nullptr, F.lane);
    }
    const int gw = F.vcu * 8 + F.wave, NGW = F.G * 8;
    for (int row = gw; row < MTOK; row += NGW) {
        const int b = row >> 11;
        const f32x4* xr = (const f32x4*)(p->x + (size_t)row * 1024) + F.lane;
        f32x4 v[4]; float s = 0.f;
#pragma unroll
        for (int j = 0; j < 4; ++j) { v[j] = xr[64 * j]; s += (v[j][0] * v[j][0] + v[j][1] * v[j][1]) + (v[j][2] * v[j][2] + v[j][3] * v[j][3]); }
        s = wave_sum(s);
        unsigned long long* o8 = (unsigned long long*)(xg + (size_t)row * 1024) + F.lane;
#pragma unroll
        for (int j = 0; j < 4; ++j) {
            const int k = 4 * F.lane + 256 * j;
            const f32x4 g = *(const f32x4*)(p->norm_g + k), sc = *(const f32x4*)(mod + (size_t)b * 3072 + 1024 + k);
            const f32x4 z = v[j] * g * (sc + 1.f);
            o8[64 * j] = (unsigned long long)pk2(z[0], z[1]) | ((unsigned long long)pk2(z[2], z[3]) << 32);
        }
        if (F.lane < 16) ssq[(size_t)row * 16 + F.lane] = (F.lane == 0) ? s : 0.f;
    }
}
__device__ __forceinline__ void phase_final(KPC p, const Frame& F) {
    const float* ssq = (const float*)(p->ws + WS_SSQ);
    const int gw = F.vcu * 8 + F.wave, NGW = F.G * 8;
    for (int row = gw; row < MTOK; row += NGW) {
        const float rt = ssq_rinv(ssq, row);
        f32x4* xr = (f32x4*)(p->out + (size_t)row * 1024) + F.lane;
#pragma unroll
        for (int j = 0; j < 4; ++j) { const f32x4 g = *(const f32x4*)(p->final_g + 4 * F.lane + 256 * j); xr[64 * j] = xr[64 * j] * rt * g; }
    }
}
#define MFMA32(a, b, c) __builtin_amdgcn_mfma_f32_32x32x16_bf16((a), (b), (c), 0, 0, 0)
#define MFMA16(a, b, c) __builtin_amdgcn_mfma_f32_16x16x32_bf16((a), (b), (c), 0, 0, 0)
__device__ __forceinline__ float frcp(float v) { return __builtin_amdgcn_rcpf(v); }
__device__ __forceinline__ float fsigm_fast(float v) { return frcp(1.f + __expf(-v)); }
template <int VAR> __device__ __forceinline__ void attn_run(KPC p, const Frame& F, int e_layer, float lam, float lam_init, bf16_t* mixed, int a0, int astride, int count) {
    const int tid = F.tid, lane = F.lane, r = lane & 31, hh = lane >> 5, m = F.wave & 1, sub = F.wave >> 1, grp = F.wave >> 2;
    const bf16_t* P = (const bf16_t*)(p->ws + WS_PROJ); const bf16_t* PG = (const bf16_t*)(p->ws + WS_PROJG_E); const bf16_t* VT = (const bf16_t*)(p->ws + WS_VT);
    LAS unsigned char* lds = F.lds;
    LAS float* lutall = (LAS float*)(lds + 98304); LAS float* SG = (LAS float*)(lds + 106496); LAS float* SSX = (LAS float*)(lds + 107520); LAS float* X = (LAS float*)(lds + 110592) + sub * 2048;
    for (int i = tid; i < 2048; i += 512) { const int hd = i >> 9, idx = i & 511; lutall[i] = (idx < 511) ? p->t5[hd * 32 + t5_bucket(idx - 255)] * LOG2E : 0.f; }
    if (tid < 128) SG[tid] = p->da_subg[e_layer * 128 + tid] * (1.f - lam_init);
    const int skey = (tid >> 3) & 63, ve0 = tid >> 3, sch = (tid & 7) ^ ((skey >> 1) & 7);
    const unsigned koff = (unsigned)(skey * 64 + sch * 8), voff = (unsigned)(ve0 * 2048 + sch * 8);
    const unsigned dmaw = (unsigned)F.wave * 1024u;
    const unsigned swz = (unsigned)((r >> 1) & 7);
#define ATT_DMA(stage_off, ks_, vs_) do { \
        __builtin_amdgcn_global_load_lds((const unsigned*)((ks_) + koff), (LAS unsigned*)(lds + (stage_off) + dmaw), 16, 0, 0); \
        __builtin_amdgcn_global_load_lds((const unsigned*)((ks_) + (size_t)2048 * 64 + koff), (LAS unsigned*)(lds + (stage_off) + 8192 + dmaw), 16, 0, 0); \
        __builtin_amdgcn_global_load_lds((const unsigned*)((vs_) + voff), (LAS unsigned*)(lds + (stage_off) + 16384 + dmaw), 16, 0, 0); \
        __builtin_amdgcn_global_load_lds((const unsigned*)((vs_) + (size_t)64 * 2048 + voff), (LAS unsigned*)(lds + (stage_off) + 24576 + dmaw), 16, 0, 0); } while (0)
#define ATT_DMA8(stage_off, ks_, vs_) do { ATT_DMA(stage_off, ks_, vs_); \
        __builtin_amdgcn_global_load_lds((const unsigned*)((ks_) + koff + 32 * 64), (LAS unsigned*)(lds + (stage_off) + 4096 + dmaw), 16, 0, 0); \
        __builtin_amdgcn_global_load_lds((const unsigned*)((ks_) + (size_t)2048 * 64 + koff + 32 * 64), (LAS unsigned*)(lds + (stage_off) + 8192 + 4096 + dmaw), 16, 0, 0); \
        __builtin_amdgcn_global_load_lds((const unsigned*)((vs_) + voff + (size_t)32 * 2048), (LAS unsigned*)(lds + (stage_off) + 16384 + 4096 + dmaw), 16, 0, 0); \
        __builtin_amdgcn_global_load_lds((const unsigned*)((vs_) + (size_t)64 * 2048 + voff + (size_t)32 * 2048), (LAS unsigned*)(lds + (stage_off) + 24576 + 4096 + dmaw), 16, 0, 0); } while (0)
    bf16x8 qf[4];
    {
        const int a = a0, b = a >> 6, h = (a >> 4) & 3, qb = a & 15;
        const bf16_t* ksrc0 = P + ((size_t)(b * 16 + 8 + 2 * h)) * 2048 * 64;
        const bf16_t* vsrc0 = VT + ((size_t)(b * 512 + h * 128)) * 2048;
#pragma unroll
        for (int t = 0; t < 2; ++t) ATT_DMA(t * 32768, ksrc0 + (size_t)t * 64 * 64, vsrc0 + t * 64);
        const bf16_t* qp = P + (((size_t)(b * 16 + 2 * h + m)) * 2048 + qb * 128 + sub * 32 + r) * 64 + hh * 8;
#pragma unroll
        for (int s = 0; s < 4; ++s) qf[s] = *(const bf16x8*)(qp + 16 * s);
    }
    asm volatile("s_waitcnt vmcnt(0)" ::: "memory");
    __syncthreads();
    bf16x8 kfr[8];
#define ATT_LDK(stage_off) do { _Pragma("unroll") for (int s = 0; s < 4; ++s) { const unsigned co_ = (((unsigned)(2 * s + hh)) ^ swz) << 4; \
        kfr[2 * s] = *(const LAS bf16x8*)(lds + (stage_off) + m * 8192 + r * 128 + co_); kfr[2 * s + 1] = *(const LAS bf16x8*)(lds + (stage_off) + m * 8192 + (32 + r) * 128 + co_); } } while (0)
    ATT_LDK(0);
#ifdef PROBE_SEC
    unsigned sec_acc = 0, sec_last = 0;
#define ST_BEGIN() do { __builtin_amdgcn_sched_barrier(0); sec_last = (unsigned)__builtin_amdgcn_s_memtime(); __builtin_amdgcn_sched_barrier(0); } while (0)
#define ST(n) do { __builtin_amdgcn_sched_barrier(0); const unsigned now_ = (unsigned)__builtin_amdgcn_s_memtime(); if ((n) == PROBE_SEC) sec_acc += now_ - sec_last; sec_last = now_; __builtin_amdgcn_sched_barrier(0); } while (0)
#else
#define ST_BEGIN() do {} while (0)
#define ST(n) do {} while (0)
#endif
    int T = 0;
    for (int k = 0; k < count; ++k) {
        const int a = a0 + k * astride, b = a >> 6, h = (a >> 4) & 3, qb = a & 15;
        const int an = (k + 1 < count) ? a + astride : a, bn = an >> 6, hn = (an >> 4) & 3, qbn = an & 15;
        const size_t tokbase = (size_t)b * 2048; const int q0w = qb * 128 + sub * 32;
        const bf16_t* ksrc0 = P + ((size_t)(b * 16 + 8 + 2 * h)) * 2048 * 64;
        const bf16_t* vsrc0 = VT + ((size_t)(b * 512 + h * 128)) * 2048;
        const bf16_t* ksrcN = P + ((size_t)(bn * 16 + 8 + 2 * hn)) * 2048 * 64;
        const bf16_t* vsrcN = VT + ((size_t)(bn * 512 + hn * 128)) * 2048;
        LAS float* lut = lutall + h * 512;
        const float cL = lut[0], cR = lut[510];
        f32x16 O[4];
#pragma unroll
        for (int et = 0; et < 4; ++et)
#pragma unroll
            for (int i = 0; i < 16; ++i) O[et][i] = 0.f;
        constexpr float THR = 8.f;
        float m_run = 0.f, l_run = 0.f;
        if constexpr (!(VAR & 16)) { if (grp == 1) __builtin_amdgcn_s_barrier(); }
        ST_BEGIN();
        for (int j = 0; j < ((VAR & 128) ? 1 : 32); ++j) {
            const int st = (T % 3) * 32768;
            const bool own = j < 30; const int tl = own ? j + 2 : j - 30;
            const bf16_t* ksn = (own ? ksrc0 : ksrcN) + (size_t)tl * 64 * 64; const bf16_t* vsn = (own ? vsrc0 : vsrcN) + tl * 64;
            const int sn = ((T + 2) % 3) * 32768;

            const LAS unsigned char* vb = lds + st + 16384;
            __builtin_amdgcn_s_setprio(1);
            f32x16 S0, S1;
            { const int rel_max = 64 * j + 63 - q0w, rel_min = 64 * j - (q0w + 31);
              if (rel_max <= -91 || rel_min >= 91) { const float cv = ((rel_max <= -91) ? cL : cR) - m_run;
#pragma unroll
                  for (int i = 0; i < 16; ++i) { S0[i] = cv; S1[i] = cv; }
              } else {
                  const int ib = 64 * j + 4 * hh - (q0w + r) + 255;
#pragma unroll
                  for (int i = 0; i < 16; ++i) { const int idx = ib + (i & 3) + 8 * (i >> 2); S0[i] = lut[idx] - m_run; S1[i] = lut[idx + 32] - m_run; }
              } }
#pragma unroll
            for (int s = 0; s < 4; ++s) S0 = MFMA32(kfr[2 * s], qf[s], S0);
#pragma unroll
            for (int s = 0; s < 4; ++s) S1 = MFMA32(kfr[2 * s + 1], qf[s], S1);
            constexpr int NVPRE = 1;
            bf16x8 vf[NVPRE][4];
#pragma unroll
            for (int et = 0; et < NVPRE; ++et)
#pragma unroll
                for (int s = 0; s < 4; ++s) vf[et][s] = *(const LAS bf16x8*)(vb + (32 * et + r) * 128 + ((((unsigned)(2 * s + hh)) ^ swz) << 4));
            __builtin_amdgcn_sched_barrier(0);
            ST(1);
            if constexpr (!(VAR & 1)) {
                float mxa = fmaxf(fmaxf(S0[0], S0[1]), S1[0]), mxb = fmaxf(fmaxf(S0[2], S0[3]), S1[1]);
                mxa = fmaxf(fmaxf(mxa, S1[2]), S1[3]);
#pragma unroll
                for (int i = 4; i < 16; i += 4) { mxa = fmaxf(fmaxf(mxa, S0[i]), S0[i + 1]); mxb = fmaxf(fmaxf(mxb, S0[i + 2]), S0[i + 3]); mxa = fmaxf(fmaxf(mxa, S1[i]), S1[i + 1]); mxb = fmaxf(fmaxf(mxb, S1[i + 2]), S1[i + 3]); }
                float mx = fmaxf(mxa, mxb);
                mx = fmaxf(mx, __shfl_xor(mx, 32));
                if (j == 0 || __any(mx > THR)) {
                    const float dl = (j == 0 || mx > THR) ? mx : 0.f;
                    const float alpha = ex2(-dl); m_run += dl; l_run *= alpha;
#pragma unroll
                    for (int i = 0; i < 16; ++i) { S0[i] -= dl; S1[i] -= dl; }
#pragma unroll
                    for (int et = 0; et < 4; ++et)
#pragma unroll
                        for (int i = 0; i < 16; ++i) O[et][i] *= alpha;
                }
                float lsa = 0.f, lsb = 0.f;
#pragma unroll
                for (int i = 0; i < 16; ++i) { S0[i] = ex2(S0[i]); S1[i] = ex2(S1[i]); lsa += S0[i]; lsb += S1[i]; }
                l_run += lsa + lsb;
            }
            bf16x8 pf[4];
            { u32x4 w;
              w.x = pk2(S0[0], S0[1]); w.y = pk2(S0[2], S0[3]); w.z = pk2(S0[4], S0[5]); w.w = pk2(S0[6], S0[7]); pf[0] = __builtin_bit_cast(bf16x8, w);
              w.x = pk2(S0[8], S0[9]); w.y = pk2(S0[10], S0[11]); w.z = pk2(S0[12], S0[13]); w.w = pk2(S0[14], S0[15]); pf[1] = __builtin_bit_cast(bf16x8, w);
              w.x = pk2(S1[0], S1[1]); w.y = pk2(S1[2], S1[3]); w.z = pk2(S1[4], S1[5]); w.w = pk2(S1[6], S1[7]); pf[2] = __builtin_bit_cast(bf16x8, w);
              w.x = pk2(S1[8], S1[9]); w.y = pk2(S1[10], S1[11]); w.z = pk2(S1[12], S1[13]); w.w = pk2(S1[14], S1[15]); pf[3] = __builtin_bit_cast(bf16x8, w); }
            ST(2);
            if constexpr (!(VAR & 16)) { asm volatile("s_waitcnt vmcnt(0) lgkmcnt(0)\n\ts_barrier" ::: "memory"); }
            __builtin_amdgcn_s_setprio(0);
            ST(3);
            if constexpr (!(VAR & 8)) { if (grp == 0) ATT_DMA8(sn, ksn, vsn); }
            if (j == 31) {
                const bf16_t* qp = P + (((size_t)(bn * 16 + 2 * hn + m)) * 2048 + qbn * 128 + sub * 32 + r) * 64 + hh * 8;
#pragma unroll
                for (int s = 0; s < 4; ++s) qf[s] = *(const bf16x8*)(qp + 16 * s);
            }
            {
                bf16x8 va[4], vb2[4];
#define ATT_LDV(dst, et_) do { _Pragma("unroll") for (int s = 0; s < 4; ++s) dst[s] = *(const LAS bf16x8*)(vb + (32 * (et_) + r) * 128 + ((((unsigned)(2 * s + hh)) ^ swz) << 4)); } while (0)
#define ATT_MM(src, et_) do { _Pragma("unroll") for (int s = 0; s < 4; ++s) O[et_] = MFMA32(src[s], pf[s], O[et_]); } while (0)
                ATT_LDV(va, 1); __builtin_amdgcn_sched_barrier(0);
                ATT_MM(vf[0], 0); __builtin_amdgcn_sched_barrier(0);
                ATT_LDK(((T + 1) % 3) * 32768);
                __builtin_amdgcn_sched_barrier(0);
                ATT_LDV(vb2, 2); __builtin_amdgcn_sched_barrier(0);
                ATT_MM(va, 1); __builtin_amdgcn_sched_barrier(0);
                ATT_LDV(va, 3); __builtin_amdgcn_sched_barrier(0);
                ATT_MM(vb2, 2); __builtin_amdgcn_sched_barrier(0);
                ATT_MM(va, 3);
            }
            ST(4);
            if constexpr (!(VAR & 16)) asm volatile("s_waitcnt lgkmcnt(0)\n\ts_barrier" ::: "memory");
            ST(5);
            ++T;
        }
        if constexpr (!(VAR & 16)) { if (grp == 0) __builtin_amdgcn_s_barrier(); }
        const size_t tok = tokbase + q0w + r;
        const int et0 = 2 * m;
        u32x2 gav[8];
#pragma unroll
        for (int t = 0; t < 2; ++t)
#pragma unroll
            for (int g4 = 0; g4 < 4; ++g4) gav[t * 4 + g4] = *(const u32x2*)(PG + tok * 1536 + h * 128 + 32 * (et0 + t) + 8 * g4 + 4 * hh);
        l_run += __shfl_xor(l_run, 32);
        const float inv = __builtin_amdgcn_rcpf(l_run);
        f32x16 D0, D1;
        if (m == 1) {
#pragma unroll
            for (int i = 0; i < 16; ++i) { X[i * 64 + lane] = O[0][i] * inv; X[(16 + i) * 64 + lane] = O[1][i] * inv; }
        }
        __syncthreads();
        if (m == 0) {
#pragma unroll
            for (int i = 0; i < 16; ++i) { D0[i] = O[0][i] * inv - lam * X[i * 64 + lane]; D1[i] = O[1][i] * inv - lam * X[(16 + i) * 64 + lane]; }
        }
        __syncthreads();
        if (m == 0) {
#pragma unroll
            for (int i = 0; i < 16; ++i) { X[i * 64 + lane] = O[2][i] * inv; X[(16 + i) * 64 + lane] = O[3][i] * inv; }
        }
        __syncthreads();
        if (m == 1) {
#pragma unroll
            for (int i = 0; i < 16; ++i) { D0[i] = X[i * 64 + lane] - lam * O[2][i] * inv; D1[i] = X[(16 + i) * 64 + lane] - lam * O[3][i] * inv; }
        }
        float ss = 0.f;
#pragma unroll
        for (int i = 0; i < 16; ++i) ss += D0[i] * D0[i] + D1[i] * D1[i];
        ss += __shfl_xor(ss, 32);
        if (hh == 0) SSX[F.wave * 32 + r] = ss;
        __syncthreads();
        ss += SSX[(F.wave ^ 1) * 32 + r];
        const float rinv = rsqrtf(ss * (1.f / 128.f) + 1e-6f);
        if constexpr (!(VAR & 512)) {
#pragma unroll
            for (int t = 0; t < 2; ++t)
#pragma unroll
                for (int g4 = 0; g4 < 4; ++g4) {
                    const int e0 = 32 * (et0 + t) + 8 * g4 + 4 * hh;
                    const f32x4 sg = *(const LAS f32x4*)(SG + e0);
                    const u32x2 ga = gav[t * 4 + g4];
                    const float g0 = bflo(ga.x), g1 = bfhi(ga.x), g2 = bflo(ga.y), g3 = bfhi(ga.y);
                    const float d0 = t ? D1[4 * g4 + 0] : D0[4 * g4 + 0], d1 = t ? D1[4 * g4 + 1] : D0[4 * g4 + 1], d2 = t ? D1[4 * g4 + 2] : D0[4 * g4 + 2], d3 = t ? D1[4 * g4 + 3] : D0[4 * g4 + 3];
                    u32x2 w; w.x = pk2(d0 * rinv * sg[0] * g0 * fsigm_fast(g0), d1 * rinv * sg[1] * g1 * fsigm_fast(g1)); w.y = pk2(d2 * rinv * sg[2] * g2 * fsigm_fast(g2), d3 * rinv * sg[3] * g3 * fsigm_fast(g3));
                    *(u32x2*)(mixed + tok * 1024 + h * 128 + e0) = w;
                }
        }
        ST(6);
    }
    __syncthreads();
#ifdef PROBE_SEC
    if (F.bx == PROBE_BLK && F.wave == PROBE_WAVE && lane == 0) ((unsigned*)(p->ws + WS_SCAL))[64] = sec_acc;
#endif
}

template <int dir> __device__ __forceinline__ void lru_pass(KPC p, const Frame& F, int e_layer, int b, int n, int hf) {
    const int tid = F.tid, lane = F.lane, wave = F.wave;
    const bf16_t* P = (const bf16_t*)(p->ws + WS_PROJG_E);   bf16_t* mixed = (bf16_t*)(p->ws + WS_MIXED); float* HF = (float*)(p->ws + WS_XG);
    const bf16_t* Wg = (const bf16_t*)(p->ws + WS_WG) + ((size_t)(e_layer * 8 + n)) * 256 * 64;
    LAS unsigned char* lds = F.lds;
    LAS unsigned char* XA = lds; LAS float* XC = (LAS float*)(lds + 16384); LAS f32x2_t* PH = (LAS f32x2_t*)(lds + 34816); LAS float* Cc = (LAS float*)(lds + 36864);
    const size_t tokbase = (size_t)b * 2048;
    const int cg = tid & 7, tp = tid >> 3;
    f32x4 cwa[4], cwb[4], cba, cbb;
    { const float* cwp = p->conv_w + (size_t)e_layer * 4 * 512 + n * 64 + cg * 8;
#pragma unroll
      for (int j = 0; j < 4; ++j) { cwa[j] = *(const f32x4*)(cwp + j * 512); cwb[j] = *(const f32x4*)(cwp + j * 512 + 4); }
      const float* cbp = p->conv_b + e_layer * 512 + n * 64 + cg * 8; cba = *(const f32x4*)(cbp); cbb = *(const f32x4*)(cbp + 4); }
    const bf16_t* xcol = P + tokbase * 1536 + 512 + n * 64 + cg * 8;
    const int mt = wave, col = lane & 15, kq = lane >> 4;
    const int kqo = dir ? 3 - kq : kq, wo = dir ? 7 - mt : mt;
    bf16x8 wf[2][2][2];
    float ba[2], bx[2], sp[2];
#pragma unroll
    for (int jj = 0; jj < 2; ++jj) {
        const int ch = 32 * hf + 16 * jj + col;
#pragma unroll
        for (int gs = 0; gs < 2; ++gs)
#pragma unroll
            for (int ks = 0; ks < 2; ++ks) wf[jj][gs][ks] = *(const bf16x8*)(Wg + (size_t)((2 * dir + gs) * 64 + ch) * 64 + 32 * ks + 8 * kq);
        ba[jj] = p->b_a[(e_layer * 2 + dir) * 512 + n * 64 + ch]; bx[jj] = p->b_x[(e_layer * 2 + dir) * 512 + n * 64 + ch];
        const float y = -p->lru_lam[(e_layer * 2 + dir) * 512 + n * 64 + ch]; sp[jj] = -8.f * (fmaxf(y, 0.f) + log1pf(expf(-fabsf(y))));
    }
    if (tid < 64) Cc[tid] = 0.f;
    u32x4 xr[5];
    { const int t0 = (dir ? 15 : 0) * 128;
#pragma unroll
      for (int k = 0; k < 5; ++k) { int tt = t0 + 2 * tp - 2 + k; tt = tt < 0 ? 0 : (tt > 2047 ? 2047 : tt); xr[k] = *(const u32x4*)(xcol + (size_t)tt * 1536); } }
    for (int cc = 0; cc < 16; ++cc) {
        const int chunk = dir ? 15 - cc : cc; const int t0 = chunk * 128; const int par = cc & 1;
        u32x4 xc5[5];
#pragma unroll
        for (int k = 0; k < 5; ++k) { const int tt = t0 + 2 * tp - 2 + k; const bool ok = (tt >= 0) && (tt < 2048); xc5[k] = xr[k]; if (!ok) xc5[k] = (u32x4){0u, 0u, 0u, 0u}; }
        { const int cn = (cc + 1 < 16) ? cc + 1 : cc; const int t1 = (dir ? 15 - cn : cn) * 128;
#pragma unroll
            for (int k = 0; k < 5; ++k) { int tt = t1 + 2 * tp - 2 + k; tt = tt < 0 ? 0 : (tt > 2047 ? 2047 : tt); xr[k] = *(const u32x4*)(xcol + (size_t)tt * 1536); } }
        float hfv[2][4]; bf16_t gvv[2][4];
        if (dir) {
#pragma unroll
            for (int jj = 0; jj < 2; ++jj)
#pragma unroll
                for (int i = 0; i < 4; ++i) { const size_t tok = tokbase + t0 + 16 * mt + 4 * kq + i; const int ch = n * 64 + 32 * hf + 16 * jj + col;
                    hfv[jj][i] = HF[tok * 512 + ch]; gvv[jj][i] = P[tok * 1536 + 1024 + ch]; }
        }
#pragma unroll
        for (int i = 0; i < 2; ++i) {
            const int tl = 2 * tp + i;
            f32x4 va = cba, vb = cbb;
#pragma unroll
            for (int j = 0; j < 4; ++j) { const u32x4 x = xc5[i + j];
                va += cwa[j] * (f32x4){bflo(x.x), bfhi(x.x), bflo(x.y), bfhi(x.y)}; vb += cwb[j] * (f32x4){bflo(x.z), bfhi(x.z), bflo(x.w), bfhi(x.w)}; }
            u32x4 w; w.x = pk2(va[0], va[1]); w.y = pk2(va[2], va[3]); w.z = pk2(vb[0], vb[1]); w.w = pk2(vb[2], vb[3]);
            *(LAS u32x4*)(XA + tl * 128 + ((((unsigned)cg) ^ ((unsigned)(tl >> 1) & 7u)) << 4)) = w;
            if ((cg >> 2) == hf) { LAS float* xp = XC + tl * 36 + (cg & 3) * 8; *(LAS f32x4*)(xp) = va; *(LAS f32x4*)(xp + 4) = vb; }
        }
        __syncthreads();
        f32x4 acc[2][2];
#pragma unroll
        for (int jj = 0; jj < 2; ++jj)
#pragma unroll
            for (int gs = 0; gs < 2; ++gs) acc[jj][gs] = (f32x4){0.f, 0.f, 0.f, 0.f};
#pragma unroll
        for (int ks = 0; ks < 2; ++ks) {
            const int row = 16 * mt + col;
            const bf16x8 a = *(const LAS bf16x8*)(XA + row * 128 + ((((unsigned)(4 * ks + kq)) ^ ((unsigned)(row >> 1) & 7u)) << 4));
#pragma unroll
            for (int jj = 0; jj < 2; ++jj)
#pragma unroll
                for (int gs = 0; gs < 2; ++gs) acc[jj][gs] = MFMA16(a, wf[jj][gs][ks], acc[jj][gs]);
        }
        float hl[2][4], Pp[2][4], Pex[2], Hex[2];
#pragma unroll
        for (int jj = 0; jj < 2; ++jj) {
            const int chl = 16 * jj + col;
            float av[4], uv[4];
#pragma unroll
            for (int i = 0; i < 4; ++i) {
                const int tl = 16 * mt + 4 * kq + i;
                const float ga = fsigm_fast(acc[jj][0][i] + ba[jj]), gx = fsigm_fast(acc[jj][1][i] + bx[jj]);
                const float log_a = ga * sp[jj]; const float a = __expf(log_a);
                const float om = fmaxf(__builtin_fmaf(-a, a, 1.f), 0.f);
                av[i] = a; uv[i] = __builtin_amdgcn_sqrtf(om) * gx * XC[tl * 36 + chl];
            }
            if (!dir) { hl[jj][0] = uv[0]; Pp[jj][0] = av[0];
#pragma unroll
                for (int i = 1; i < 4; ++i) { hl[jj][i] = av[i] * hl[jj][i - 1] + uv[i]; Pp[jj][i] = av[i] * Pp[jj][i - 1]; }
            } else { hl[jj][3] = uv[3]; Pp[jj][3] = av[3];
#pragma unroll
                for (int i = 2; i >= 0; --i) { hl[jj][i] = av[i] * hl[jj][i + 1] + uv[i]; Pp[jj][i] = av[i] * Pp[jj][i + 1]; }
            }
            float Pi = dir ? Pp[jj][0] : Pp[jj][3], Hi = dir ? hl[jj][0] : hl[jj][3];
            { const float Pq = dir ? __shfl_down(Pi, 16) : __shfl_up(Pi, 16), Hq = dir ? __shfl_down(Hi, 16) : __shfl_up(Hi, 16);
              if (kqo >= 1) { Hi = Pi * Hq + Hi; Pi = Pi * Pq; } }
            { const float Pq = dir ? __shfl_down(Pi, 32) : __shfl_up(Pi, 32), Hq = dir ? __shfl_down(Hi, 32) : __shfl_up(Hi, 32);
              if (kqo >= 2) { Hi = Pi * Hq + Hi; Pi = Pi * Pq; } }
            { const float Pq = dir ? __shfl_down(Pi, 16) : __shfl_up(Pi, 16), Hq = dir ? __shfl_down(Hi, 16) : __shfl_up(Hi, 16);
              Pex[jj] = (kqo >= 1) ? Pq : 1.f; Hex[jj] = (kqo >= 1) ? Hq : 0.f; }
            if (kqo == 3) PH[mt * 32 + chl] = (f32x2_t){Pi, Hi};
        }
        __syncthreads();
#pragma unroll
        for (int jj = 0; jj < 2; ++jj) {
            const int chl = 16 * jj + col;
            float cw_ = Cc[par * 32 + chl];
            f32x2_t ph[7];
#pragma unroll
            for (int s = 0; s < 7; ++s) ph[s] = PH[(dir ? 7 - s : s) * 32 + chl];
#pragma unroll
            for (int s = 0; s < 7; ++s) cw_ = (s < wo) ? ph[s].x * cw_ + ph[s].y : cw_;
            const float cin = Pex[jj] * cw_ + Hex[jj];
#pragma unroll
            for (int i = 0; i < 4; ++i) hl[jj][i] += Pp[jj][i] * cin;
            if (wo == 7 && kqo == 3) Cc[(par ^ 1) * 32 + chl] = dir ? hl[jj][0] : hl[jj][3];
#pragma unroll
            for (int i = 0; i < 4; ++i) {
                const size_t tok = tokbase + t0 + 16 * mt + 4 * kq + i; const int ch = n * 64 + 32 * hf + chl;
                if (!dir) HF[tok * 512 + ch] = hl[jj][i];
                else { const float g = bf2f(gvv[jj][i]); mixed[tok * 1024 + 512 + ch] = (bf16_t)(pk2((hfv[jj][i] + hl[jj][i]) * g * fsigm_fast(g), 0.f) & 0xffffu); }
            }
        }
    }
    asm volatile("s_waitcnt vmcnt(0)" ::: "memory");
    __syncthreads();
}
__device__ __forceinline__ void lru_unit(KPC p, const Frame& F, int e_layer, int b, int n, int hf) {
    lru_pass<0>(p, F, e_layer, b, n, hf);
    lru_pass<1>(p, F, e_layer, b, n, hf);
}

template <int VAR> __device__ __forceinline__ void na_unit(KPC p, const Frame& F, int o_layer, int b, int h, bf16_t* mixed) {
    const int tid = F.tid, lane = F.lane, wave = F.wave;
    const bf16_t* P = (const bf16_t*)(p->ws + WS_PROJ); const bf16_t* PG = (const bf16_t*)(p->ws + WS_PROJG_O); const bf16_t* VT = (const bf16_t*)(p->ws + WS_VT);
    LAS unsigned char* lds = F.lds; LAS unsigned char* KL = lds; LAS unsigned char* VTL = lds + 73728; LAS float* rpbs = (LAS float*)(lds + 148480);
    const size_t tokbase = (size_t)b * 2048;
    const int skey = tid >> 3, sch = tid & 7;
    const bf16_t* ksrc = P + (((size_t)(b * 32 + 16 + h)) * 2048 + skey) * 64 + sch * 8;
    const bf16_t* vsrc = VT + ((size_t)(b * 1024 + h * 64 + skey)) * 2048 + sch * 8;
    const unsigned kdst = (unsigned)(skey * 128 + ((sch ^ ((skey >> 1) & 7)) << 4));
    const unsigned vdst = (unsigned)(73728 + skey * 1168 + sch * 16);
    if (tid < 465) rpbs[tid] = p->rpb[((size_t)o_layer * 16 + h) * 465 + tid] * LOG2E;
    if constexpr (!(VAR & 256)) { u32x4 kr[9], vr[9];
#pragma unroll
      for (int r = 0; r < 9; ++r) { kr[r] = *(const u32x4*)(ksrc + (size_t)r * 64 * 64); vr[r] = *(const u32x4*)(vsrc + r * 64); }
#pragma unroll
      for (int r = 0; r < 9; ++r) { *(LAS u32x4*)(lds + kdst + r * 8192) = kr[r]; *(LAS u32x4*)(lds + vdst + r * 128) = vr[r]; } }
    const int ri = wave >> 2, g = wave & 3, c0 = 16 * g, kc0 = (g == 0) ? 0 : (g == 1 ? 8 : (g == 2 ? 24 : 32));
    const int q = lane & 15, kq = lane >> 4;
    const int c = c0 + q; int cs = c - 8; cs = cs < 0 ? 0 : (cs > 48 ? 48 : cs);
    f32x4 BT[8][2]; int boff = -1;
    bf16x8 qf[2]; u32x2 gf[4];
    { const size_t tok = tokbase + ri * 64 + c0 + q; const size_t tq_ = (size_t)(b * 32 + h) * 2048 + ri * 64 + c0 + q;
#pragma unroll
      for (int ks = 0; ks < 2; ++ks) qf[ks] = *(const bf16x8*)(P + tq_ * 64 + 32 * ks + 8 * kq);
#pragma unroll
      for (int et = 0; et < 4; ++et) gf[et] = *(const u32x2*)(PG + tok * 1024 + h * 64 + 16 * et + 4 * kq); }
    for (int rp = 0; rp < ((VAR & 128) ? 1 : 16); ++rp) {
        const int r0 = 2 * rp; int rb = r0 - 4; rb = rb < 0 ? 0 : (rb > 24 ? 24 : rb); int rbn = r0 - 2; rbn = rbn < 0 ? 0 : (rbn > 24 ? 24 : rbn);
        const int newA = rb + 9, newB = rb + 10; const bool do_new = rbn > rb; const bool validA = do_new && newA < 32, validB = do_new && newB < 32;
        const int la = newA < 31 ? newA : 31, lb = newB < 31 ? newB : 31;
        if constexpr (!(VAR & 16)) __syncthreads();
        u32x4 kn0 = {0u,0u,0u,0u}, kn1 = kn0, vn0 = kn0, vn1 = kn0;
        if constexpr (!(VAR & 8)) { kn0 = *(const u32x4*)(ksrc + (size_t)la * 64 * 64); kn1 = *(const u32x4*)(ksrc + (size_t)lb * 64 * 64); vn0 = *(const u32x4*)(vsrc + la * 64); vn1 = *(const u32x4*)(vsrc + lb * 64); }
        bf16x8 qn[2]; u32x2 gn[4];
        { int rn = r0 + 2 + ri; rn = rn > 31 ? 31 : rn; const size_t tokn = tokbase + rn * 64 + c0 + q; const size_t tqn = (size_t)(b * 32 + h) * 2048 + rn * 64 + c0 + q;
#pragma unroll
          for (int ks = 0; ks < 2; ++ks) qn[ks] = *(const bf16x8*)(P + tqn * 64 + 32 * ks + 8 * kq);
#pragma unroll
          for (int et = 0; et < 4; ++et) gn[et] = *(const u32x2*)(PG + tokn * 1024 + h * 64 + 16 * et + 4 * kq); }
        {
            const int rr = r0 + ri; int rs = rr - 4; rs = rs < 0 ? 0 : (rs > 24 ? 24 : rs);
            const size_t tok = tokbase + rr * 64 + c0 + q;
            const int off = rr - rs;
            if (off != boff) {
                boff = off;
#pragma unroll
                for (int i = 0; i < 8; ++i)
#pragma unroll
                    for (int a = 0; a < 2; ++a)
#pragma unroll
                        for (int j = 0; j < 4; ++j) {
                            const int kc = kc0 + 16 * a + 4 * kq + j; const bool valid = (kc >= cs) && (kc < cs + 16);
                            int dc = kc - c + 15; dc = dc < 0 ? 0 : (dc > 30 ? 30 : dc);
                            const float bias = rpbs[(i - off + 7) * 31 + dc];
                            BT[i][a][j] = valid ? bias : -1e30f;
                        }
            }
            f32x4 S[8][2];
#pragma unroll
            for (int i = 0; i < 8; ++i) {
                const int li = (rs + i) % 9;
#pragma unroll
                for (int a = 0; a < 2; ++a) {
                    const int keyl = li * 64 + kc0 + 16 * a + q;
                    f32x4 acc = BT[i][a];
#pragma unroll
                    for (int ks = 0; ks < 2; ++ks) {
                        bf16x8 A; if constexpr (!(VAR & 64)) A = *(const LAS bf16x8*)(KL + keyl * 128 + ((((unsigned)(4 * ks + kq)) ^ ((unsigned)(keyl >> 1) & 7u)) << 4)); else A = qf[ks ^ 1];
                        if constexpr (!(VAR & 4)) acc = MFMA16(A, qf[ks], acc); else asm volatile("" :: "v"(A));
                    }
                    S[i][a] = acc;
                }
            }
            float l = 1.f;
            if constexpr (!(VAR & 1)) {
            float mx = -1e30f;
#pragma unroll
            for (int i = 0; i < 8; ++i)
#pragma unroll
                for (int a = 0; a < 2; ++a)
#pragma unroll
                    for (int j = 0; j < 4; ++j) mx = fmaxf(mx, S[i][a][j]);
            mx = fmaxf(mx, __shfl_xor(mx, 16)); mx = fmaxf(mx, __shfl_xor(mx, 32));
            l = 0.f;
#pragma unroll
            for (int i = 0; i < 8; ++i)
#pragma unroll
                for (int a = 0; a < 2; ++a)
#pragma unroll
                    for (int j = 0; j < 4; ++j) { const float e = ex2(S[i][a][j] - mx); S[i][a][j] = e; l += e; }
            l += __shfl_xor(l, 16); l += __shfl_xor(l, 32);
            }
            f32x4 O[4];
#pragma unroll
            for (int et = 0; et < 4; ++et) O[et] = (f32x4){0.f, 0.f, 0.f, 0.f};
#pragma unroll
            for (int i = 0; i < 8; ++i) {
                const int li = (rs + i) % 9;
                u32x4 w; w.x = pk2(S[i][0][0], S[i][0][1]); w.y = pk2(S[i][0][2], S[i][0][3]); w.z = pk2(S[i][1][0], S[i][1][1]); w.w = pk2(S[i][1][2], S[i][1][3]);
                const bf16x8 pf = __builtin_bit_cast(bf16x8, w);
#pragma unroll
                for (int et = 0; et < 4; ++et) {
                    const LAS unsigned char* vp = VTL + (16 * et + q) * 1168 + (li * 64 + kc0 + 4 * kq) * 2;
                    u32x4 av;
                    if constexpr (!(VAR & 64)) { const u32x2 lo = *(const LAS u32x2*)(vp), hi = *(const LAS u32x2*)(vp + 32); av.x = lo.x; av.y = lo.y; av.z = hi.x; av.w = hi.y; } else av = __builtin_bit_cast(u32x4, qf[et & 1]);
                    if constexpr (!(VAR & 2)) O[et] = MFMA16(__builtin_bit_cast(bf16x8, av), pf, O[et]); else asm volatile("" :: "v"(av), "v"(pf));
                }
            }
            const float inv = __builtin_amdgcn_rcpf(l);
#pragma unroll
            for (int et = 0; et < 4; ++et) {
                const int e0 = 16 * et + 4 * kq; const u32x2 ga = gf[et];
                const float g0 = bflo(ga.x), g1 = bfhi(ga.x), g2 = bflo(ga.y), g3 = bfhi(ga.y);
                u32x2 w; w.x = pk2(O[et][0] * inv * g0 * fsigm_fast(g0), O[et][1] * inv * g1 * fsigm_fast(g1)); w.y = pk2(O[et][2] * inv * g2 * fsigm_fast(g2), O[et][3] * inv * g3 * fsigm_fast(g3));
                *(u32x2*)(mixed + tok * 1024 + h * 64 + e0) = w;
            }
        }
        if constexpr (!(VAR & 16)) __syncthreads();
        if constexpr (!(VAR & 8)) {
        if (validA) { *(LAS u32x4*)(lds + kdst + (newA % 9) * 8192) = kn0; *(LAS u32x4*)(lds + vdst + (newA % 9) * 128) = vn0; }
        if (validB) { *(LAS u32x4*)(lds + kdst + (newB % 9) * 8192) = kn1; *(LAS u32x4*)(lds + vdst + (newB % 9) * 128) = vn1; }
        }
#pragma unroll
        for (int ks = 0; ks < 2; ++ks) qf[ks] = qn[ks];
#pragma unroll
        for (int et = 0; et < 4; ++et) gf[et] = gn[et];
    }
    __syncthreads();
}
#ifdef PROBE_PROTO
__device__ __forceinline__ void attn_proto(KPC p, const Frame& F, bf16_t* outp, int a0, int astride, int count) {
    const int tid = F.tid, lane = F.lane, r = lane & 31, hh = lane >> 5, wave = F.wave;
    const bool isS = wave < 4; const int sub = wave & 3;
    const bf16_t* P = (const bf16_t*)(p->ws + WS_PROJ); const bf16_t* VT = (const bf16_t*)(p->ws + WS_VT);
    LAS unsigned char* lds = F.lds;
    const int skey = (tid >> 3) & 63, ve0 = tid >> 3, sch = (tid & 7) ^ ((skey >> 1) & 7);
    const unsigned dmaw = (unsigned)wave * 1024u; const unsigned swz = (unsigned)((r >> 1) & 7);
#define PR_DMA_K(st, ks_) do { __builtin_amdgcn_global_load_lds((const unsigned*)(ks_), (LAS unsigned*)(lds + (st) * 16384 + dmaw), 16, 0, 0); \
        __builtin_amdgcn_global_load_lds((const unsigned*)((ks_) + (size_t)2048 * 64), (LAS unsigned*)(lds + (st) * 16384 + 8192 + dmaw), 16, 0, 0); } while (0)
#define PR_DMA_V(st, vs_) do { __builtin_amdgcn_global_load_lds((const unsigned*)(vs_), (LAS unsigned*)(lds + 49152 + (st) * 16384 + dmaw), 16, 0, 0); \
        __builtin_amdgcn_global_load_lds((const unsigned*)((vs_) + (size_t)64 * 2048), (LAS unsigned*)(lds + 49152 + (st) * 16384 + 8192 + dmaw), 16, 0, 0); } while (0)
#define PR_STEP_COMMON(t) if (!(PROBE_PROTO & 8)) { const int tk = ((t) + 2 < 32) ? (t) + 2 : 31, tv = ((t) + 1 < 32) ? (t) + 1 : 31; \
              PR_DMA_K(((t) + 2) % 3, ksrc0 + (size_t)tk * 64 * 64); PR_DMA_V(((t) + 1) % 3, vsrc0 + tv * 64); }
#define PR_BAR() asm volatile("s_waitcnt vmcnt(4) lgkmcnt(0)\n\ts_barrier" ::: "memory")
    if (isS) {
      for (int k = 0; k < count; ++k) {
        const int a = a0 + k * astride, b = a >> 6, h = (a >> 4) & 3, qb = a & 15;
        const bf16_t* ksrc0 = P + (((size_t)(b * 16 + 8 + 2 * h)) * 2048 + skey) * 64 + sch * 8;
        const bf16_t* vsrc0 = VT + ((size_t)(b * 512 + h * 128 + ve0)) * 2048 + sch * 8;
        PR_DMA_K(0, ksrc0); PR_DMA_K(1, ksrc0 + (size_t)64 * 64); PR_DMA_V(0, vsrc0);
        bf16x8 qf[2][4];
#pragma unroll
        for (int mm = 0; mm < 2; ++mm) { const bf16_t* qp = P + (((size_t)(b * 16 + 2 * h + mm)) * 2048 + qb * 128 + sub * 32 + r) * 64 + hh * 8;
#pragma unroll
            for (int s = 0; s < 4; ++s) qf[mm][s] = *(const bf16x8*)(qp + 16 * s); }
        float mrun0 = 0.f, mrun1 = 0.f, l0 = 0.f, l1 = 0.f;
        asm volatile("s_waitcnt vmcnt(0)" ::: "memory");
        __syncthreads();
        for (int t = 0; t < 33; ++t) {
            PR_STEP_COMMON(t);
            if (t < 32 && !(PROBE_PROTO & 2)) {
                const LAS unsigned char* kb = lds + (t % 3) * 16384;
                LAS unsigned char* pb = lds + 98304 + (t & 1) * 32768 + sub * 8192;
#pragma unroll
                for (int mm = 0; mm < 2; ++mm) {
                    f32x16 S0, S1; float& mrun = mm ? mrun1 : mrun0; float& lr = mm ? l1 : l0;
                    const float cv = 0.25f - mrun;
#pragma unroll
                    for (int i = 0; i < 16; ++i) { S0[i] = cv; S1[i] = cv; }
#pragma unroll
                    for (int s = 0; s < 4; ++s) {
                        const unsigned co = (((unsigned)(2 * s + hh)) ^ swz) << 4;
                        const bf16x8 a0v = *(const LAS bf16x8*)(kb + mm * 8192 + r * 128 + co), a1v = *(const LAS bf16x8*)(kb + mm * 8192 + (32 + r) * 128 + co);
                        S0 = MFMA32(a0v, qf[mm][s], S0); S1 = MFMA32(a1v, qf[mm][s], S1);
                    }
                    float mxa = fmaxf(fmaxf(S0[0], S0[1]), S1[0]), mxb = fmaxf(fmaxf(S0[2], S0[3]), S1[1]);
                    mxa = fmaxf(fmaxf(mxa, S1[2]), S1[3]);
#pragma unroll
                    for (int i = 4; i < 16; i += 4) { mxa = fmaxf(fmaxf(mxa, S0[i]), S0[i + 1]); mxb = fmaxf(fmaxf(mxb, S0[i + 2]), S0[i + 3]); mxa = fmaxf(fmaxf(mxa, S1[i]), S1[i + 1]); mxb = fmaxf(fmaxf(mxb, S1[i + 2]), S1[i + 3]); }
                    float mx = fmaxf(mxa, mxb); mx = fmaxf(mx, __shfl_xor(mx, 32));
                    if (t == 0 || __any(mx > 8.f)) { const float dl = (t == 0 || mx > 8.f) ? mx : 0.f; mrun += dl; lr *= ex2(-dl);
#pragma unroll
                        for (int i = 0; i < 16; ++i) { S0[i] -= dl; S1[i] -= dl; } }
                    float lsa = 0.f, lsb = 0.f;
#pragma unroll
                    for (int i = 0; i < 16; ++i) { S0[i] = ex2(S0[i]); S1[i] = ex2(S1[i]); lsa += S0[i]; lsb += S1[i]; }
                    lr += lsa + lsb;
                    u32x4 w;
                    w.x = pk2(S0[0], S0[1]); w.y = pk2(S0[2], S0[3]); w.z = pk2(S0[4], S0[5]); w.w = pk2(S0[6], S0[7]); *(LAS u32x4*)(pb + mm * 4096 + 0 * 1024 + lane * 16) = w;
                    w.x = pk2(S0[8], S0[9]); w.y = pk2(S0[10], S0[11]); w.z = pk2(S0[12], S0[13]); w.w = pk2(S0[14], S0[15]); *(LAS u32x4*)(pb + mm * 4096 + 1 * 1024 + lane * 16) = w;
                    w.x = pk2(S1[0], S1[1]); w.y = pk2(S1[2], S1[3]); w.z = pk2(S1[4], S1[5]); w.w = pk2(S1[6], S1[7]); *(LAS u32x4*)(pb + mm * 4096 + 2 * 1024 + lane * 16) = w;
                    w.x = pk2(S1[8], S1[9]); w.y = pk2(S1[10], S1[11]); w.z = pk2(S1[12], S1[13]); w.w = pk2(S1[14], S1[15]); *(LAS u32x4*)(pb + mm * 4096 + 3 * 1024 + lane * 16) = w;
                }
            }
            PR_BAR();
        }
        if (lane == 0) ((float*)outp)[(a * 8 + wave) * 2] = l0 + l1 + mrun0 + mrun1;
        asm volatile("s_waitcnt vmcnt(0)" ::: "memory");
        __syncthreads();
      }
    } else {
      for (int k = 0; k < count; ++k) {
        const int a = a0 + k * astride, b = a >> 6, h = (a >> 4) & 3;
        const bf16_t* ksrc0 = P + (((size_t)(b * 16 + 8 + 2 * h)) * 2048 + skey) * 64 + sch * 8;
        const bf16_t* vsrc0 = VT + ((size_t)(b * 512 + h * 128 + ve0)) * 2048 + sch * 8;
        PR_DMA_K(0, ksrc0); PR_DMA_K(1, ksrc0 + (size_t)64 * 64); PR_DMA_V(0, vsrc0);
        f32x16 O0[4], O1[4];
#pragma unroll
        for (int et = 0; et < 4; ++et)
#pragma unroll
            for (int i = 0; i < 16; ++i) { O0[et][i] = 0.f; O1[et][i] = 0.f; }
        asm volatile("s_waitcnt vmcnt(0)" ::: "memory");
        __syncthreads();
        for (int t = 0; t < 33; ++t) {
            PR_STEP_COMMON(t);
            if (t >= 1 && !(PROBE_PROTO & 4)) {
                const LAS unsigned char* vb = lds + 49152 + ((t - 1) % 3) * 16384;
                const LAS unsigned char* pb = lds + 98304 + ((t - 1) & 1) * 32768 + sub * 8192;
                bf16x8 pf0[4], pf1[4];
#pragma unroll
                for (int s = 0; s < 4; ++s) { pf0[s] = *(const LAS bf16x8*)(pb + s * 1024 + lane * 16); pf1[s] = *(const LAS bf16x8*)(pb + 4096 + s * 1024 + lane * 16); }
                bf16x8 vfa[4], vfb[4];
#define PR_LDV(dst, et_) do { _Pragma("unroll") for (int s = 0; s < 4; ++s) dst[s] = *(const LAS bf16x8*)(vb + (32 * (et_) + r) * 128 + ((((unsigned)(2 * s + hh)) ^ swz) << 4)); } while (0)
#define PR_MM(src, et_) do { _Pragma("unroll") for (int s = 0; s < 4; ++s) { O0[et_] = MFMA32(src[s], pf0[s], O0[et_]); O1[et_] = MFMA32(src[s], pf1[s], O1[et_]); } } while (0)
                PR_LDV(vfa, 0); PR_LDV(vfb, 1); __builtin_amdgcn_sched_barrier(0);
                PR_MM(vfa, 0); __builtin_amdgcn_sched_barrier(0);
                PR_LDV(vfa, 2); __builtin_amdgcn_sched_barrier(0);
                PR_MM(vfb, 1); __builtin_amdgcn_sched_barrier(0);
                PR_LDV(vfb, 3); __builtin_amdgcn_sched_barrier(0);
                PR_MM(vfa, 2); __builtin_amdgcn_sched_barrier(0);
                PR_MM(vfb, 3);
            }
            PR_BAR();
        }
        float acc = 0.f;
#pragma unroll
        for (int et = 0; et < 4; ++et)
#pragma unroll
            for (int i = 0; i < 16; ++i) acc += O0[et][i] - O1[et][i];
        ((float*)outp)[1024 * 64 + (a * 8 + wave) * 64 + lane] = acc;
        asm volatile("s_waitcnt vmcnt(0)" ::: "memory");
        __syncthreads();
      }
    }
}
#endif
#if defined(PROBE_EMPTY)
constexpr int N_PHASES = 15 + PROBE_EMPTY;
#elif defined(PROBE_ATT) || defined(PROBE_NA) || defined(PROBE_GEMM) || defined(PROBE_PROTO)
constexpr int N_PHASES = 16;
#else
constexpr int N_PHASES = 15;
#endif
__device__ __forceinline__ void run_phase(KPC p, const Frame& F, int ph) {
    unsigned char* ws = p->ws;
    if (ph == 0) { phase_p0a(p, F); return; }
    if (ph == 1) { phase_p0b(p, F); return; }
    if (ph == 14) { phase_final(p, F); return; }
#ifdef PROBE_EMPTY
    if (ph >= 15) { return; }
#endif
#ifdef PROBE_PROTO
    if (ph == 15) {
        Frame Fu = F; asm volatile("" : "+v"(Fu.tid)); Fu.lane = Fu.tid & 63;
        attn_proto(p, Fu, (bf16_t*)(ws + WS_XG), F.vcu, F.G, 4);
        return;
    }
#endif
#ifdef PROBE_GEMM
    if (ph == 15) {
        pg8::Gemm g{(const bf16_t*)(ws + WS_XG), (const bf16_t*)(ws + WS_WTE), MTOK, 2560, 1024}; pg8::StaticOrder S; S.init(MTOK, 2560, F.G, F.bx);
        EpiProjV<PROBE_GEMM> E{(bf16_t*)(ws + WS_PROJ), (bf16_t*)(ws + WS_PROJG_E), 1024, 1536, (const float*)(ws + WS_SSQ), (const float*)(ws + WS_SW), 512};
        pg8::gemm_phase<EpiProjV<PROBE_GEMM>, pg8::StaticOrder, true, true>(F.lds, g, S, E, F.tid);
        return;
    }
#endif
#ifdef PROBE_NA
    if (ph == 15) {
        for (int u = F.vcu; u < 256; u += F.G) { Frame Fu = F; asm volatile("" : "+v"(Fu.tid)); Fu.lane = Fu.tid & 63; na_unit<PROBE_NA>(p, Fu, 1, u >> 4, u & 15, (bf16_t*)(ws + WS_XG)); }
        return;
    }
#endif
#ifdef PROBE_ATT
    if (ph == 15) {
        const float* scal = (const float*)(ws + WS_SCAL); const float lam = scal[0], lam_init = scal[1];
        { Frame Fu = F; asm volatile("" : "+v"(Fu.tid)); Fu.lane = Fu.tid & 63;
          const int cnt = (F.vcu < 1024) ? (1024 - F.vcu + F.G - 1) / F.G : 0;
          if (cnt > 0) attn_run<PROBE_ATT>(p, Fu, 0, lam, lam_init, (bf16_t*)(ws + WS_XG), F.vcu, F.G, cnt); }
        return;
    }
#endif
    const int l = (ph - 2) / 3, k = (ph - 2) % 3, odd = l & 1, ei = l >> 1;
    bf16_t* xg = (bf16_t*)(ws + WS_XG); bf16_t* mixed = (bf16_t*)(ws + WS_MIXED); bf16_t* proj = (bf16_t*)(ws + WS_PROJ); bf16_t* VT = (bf16_t*)(ws + WS_VT);
    float* ssq = (float*)(ws + WS_SSQ); const float* sW = (const float*)(ws + WS_SW) + (size_t)l * 16 * 4096; const float* mod = (const float*)(ws + WS_MOD);
    if (k == 0) {
        const int N1 = odd ? 3072 : 2560, NV = odd ? 1024 : 512;
        const bf16_t* Wt = odd ? (const bf16_t*)(ws + WS_WTO) + (size_t)ei * 4096 * 1024 : (const bf16_t*)(ws + WS_WTE) + (size_t)ei * 3072 * 1024;
        { pg8::Gemm g{xg, Wt, MTOK, N1, 1024}; pg8::StaticOrder S; S.init(MTOK, N1, F.G, F.bx);
          EpiProj E{proj, (bf16_t*)(ws + (odd ? WS_PROJG_O : WS_PROJG_E)), odd ? 2048 : 1024, odd ? 1024 : 1536, ssq, sW, odd ? 1024 : 512};
          pg8::gemm_phase<EpiProj, pg8::StaticOrder, true, true>(F.lds, g, S, E, F.tid); }
        { pg8::Gemm g{Wt + (size_t)N1 * 1024, xg, NV, MTOK, 1024}; pg8::StaticOrder S; S.init(NV, MTOK, F.G, F.bx);
          EpiProjT E{VT, NV, ssq, sW + N1, odd ? 0 : 1};
          pg8::gemm_phase<EpiProjT, pg8::StaticOrder, true, true>(F.lds, g, S, E, F.tid); }
    } else if (k == 1) {
        if (!odd) {
            const float* scal = (const float*)(ws + WS_SCAL); const float lam = scal[ei * 4 + 0], lam_init = scal[ei * 4 + 1];
            for (int u = F.vcu; u < 256; u += F.G) {
                Frame Fu = F; asm volatile("" : "+v"(Fu.tid)); Fu.lane = Fu.tid & 63;
                lru_unit(p, Fu, ei, u >> 4, (u >> 1) & 7, u & 1);
            }
            { Frame Fu = F; asm volatile("" : "+v"(Fu.tid)); Fu.lane = Fu.tid & 63;
              const int cnt = (F.vcu < 1024) ? (1024 - F.vcu + F.G - 1) / F.G : 0;
              if (cnt > 0) attn_run<0>(p, Fu, ei, lam, lam_init, mixed, F.vcu, F.G, cnt); }
#ifdef PROBE_MIX
            if (l == 0 && PROBE_MIX == 1) for (int u = F.vcu; u < 256; u += F.G) { Frame Fu = F; asm volatile("" : "+v"(Fu.tid)); Fu.lane = Fu.tid & 63; lru_unit(p, Fu, ei, u >> 4, (u >> 1) & 7, u & 1); }
#endif
        } else {
            for (int u = F.vcu; u < 256; u += F.G) { Frame Fu = F; asm volatile("" : "+v"(Fu.tid)); Fu.lane = Fu.tid & 63;
                na_unit<0>(p, Fu, ei, u >> 4, u & 15, mixed); }
        }
    } else {
        pg8::Gemm g{mixed, (const bf16_t*)(ws + WS_WTOUT) + (size_t)l * 1024 * 1024, MTOK, 1024, 1024}; pg8::StaticOrder S; S.init(MTOK, 1024, F.G, F.bx);
        bf16_t* xbf = (bf16_t*)(ws + WS_XB);
        EpiOut E{l == 0 ? p->x : nullptr, xbf, xbf, p->out, xg, ssq, mod + (size_t)l * 16 * 3072 + 2048, p->norm_g + (l < 3 ? (l + 1) * 1024 : 0), mod + (size_t)(l < 3 ? l + 1 : 0) * 16 * 3072 + 1024, l < 3 ? 1 : 0};
        pg8::gemm_phase<EpiOut, pg8::StaticOrder, true, true>(F.lds, g, S, E, F.tid);
    }
}


#define XB_TMO      128
#define XB_XCNT(j)  (256  + 64 * (j))
#define XB_XSUB(j)  (1280 + 64 * (j))
#define XB_XGEN(j)  (2304 + 64 * (j))
#define XB_TOP      3328
#define XB_TOPGEN   3392
#define XCD_BAR_WORDS 3456
#define XB_SPIN_CAP (1u << 20)
__device__ __forceinline__ unsigned xb_ld(unsigned* p)              { return __hip_atomic_load(p, __ATOMIC_RELAXED, __HIP_MEMORY_SCOPE_AGENT); }
__device__ __forceinline__ unsigned xb_add(unsigned* p, unsigned v) { return __hip_atomic_fetch_add(p, v, __ATOMIC_RELAXED, __HIP_MEMORY_SCOPE_AGENT); }
__device__ __forceinline__ unsigned xb_xcc_id() { return (unsigned)__builtin_amdgcn_s_getreg((3 << 11) | 20) & 0xFu; }
#define XB_SPIN(cond, bar) do { unsigned _sp = 0; while (cond) { __builtin_amdgcn_s_sleep(1); \
    if ((++_sp & 255u) == 0u) { if (xb_ld(&(bar)[XB_TMO])) break; if (_sp > XB_SPIN_CAP) { atomicAdd(&(bar)[XB_TMO], 1u); break; } } } } while (0)
struct XcdBarrier { unsigned* bar; unsigned x; volatile LAS unsigned* st; };
__device__ __forceinline__ XcdBarrier xcd_barrier_post(unsigned* bar, volatile LAS unsigned* st, bool leader) {
    XcdBarrier b; b.bar = bar; b.x = xb_xcc_id(); b.st = st;
    if (leader) (void)xb_add(&bar[XB_XCNT(b.x)], 1u);
    return b;
}
__device__ __forceinline__ void xcd_barrier_complete(unsigned* bar, unsigned x, unsigned& nloc, unsigned& nx) {
    const unsigned G = gridDim.x * gridDim.y * gridDim.z;
    unsigned sum, cnt, mine, sp = 0u;
    for (;;) {
        sum = 0u; cnt = 0u; mine = 0u;
#pragma unroll
        for (unsigned j = 0; j < 16; ++j) { const unsigned c = xb_ld(&bar[XB_XCNT(j)]); sum += c; cnt += (c > 0u) ? 1u : 0u; mine = (j == x) ? c : mine; }
        if (sum == G) break;
        __builtin_amdgcn_s_sleep(1);
        if ((++sp & 255u) == 0u) { if (xb_ld(&bar[XB_TMO])) break; if (sp > XB_SPIN_CAP) { atomicAdd(&bar[XB_TMO], 1u); break; } }
    }
    nloc = mine > 0u ? mine : 1u; nx = cnt > 0u ? cnt : 1u;
}
__device__ __forceinline__ void xcd_barrier(const XcdBarrier& b, bool leader) {
    asm volatile("s_waitcnt vmcnt(0)" ::: "memory");
    __syncthreads();
    if (leader) {
        unsigned* bar = b.bar;
        __builtin_amdgcn_s_waitcnt(0);
        unsigned nloc = b.st[0], nx = b.st[1];
        if (nloc == 0u) { xcd_barrier_complete(bar, b.x, nloc, nx); b.st[0] = nloc; b.st[1] = nx; }
        const unsigned old = xb_add(&bar[XB_XSUB(b.x)], 1u);
        const unsigned gen = old / nloc;
        if (old + 1u == (gen + 1u) * nloc) {
            __builtin_amdgcn_fence(__ATOMIC_RELEASE, "agent");
            asm volatile("s_waitcnt vmcnt(0)" ::: "memory");
            const unsigned og = xb_add(&bar[XB_TOP], 1u);
            const unsigned tg = og / nx;
            if (og + 1u == (tg + 1u) * nx) xb_add(&bar[XB_TOPGEN], 1u);
            else XB_SPIN(xb_ld(&bar[XB_TOPGEN]) == tg, bar);
            __builtin_amdgcn_fence(__ATOMIC_ACQUIRE, "agent");
            xb_add(&bar[XB_XGEN(b.x)], 1u);
            asm volatile("s_waitcnt vmcnt(0)" ::: "memory");
        } else {
            XB_SPIN(xb_ld(&bar[XB_XGEN(b.x)]) == gen, bar);
            __builtin_amdgcn_fence(__ATOMIC_ACQUIRE, "agent");
            asm volatile("s_waitcnt vmcnt(0)" ::: "memory");
        }
    }
    __syncthreads();
}
#ifndef MK_CG_SYNC
#define MK_CG_SYNC 0
#endif

__global__ void __launch_bounds__(512, 2) mega(KP p) {
    extern __shared__ __attribute__((aligned(16))) unsigned char lds_raw[];
    const int wave_id = __builtin_amdgcn_readfirstlane(threadIdx.x >> 6);
#define MK_LANE() ((int)__builtin_amdgcn_mbcnt_hi(~0u, __builtin_amdgcn_mbcnt_lo(~0u, 0u)))
    volatile LAS unsigned* misc = (volatile LAS unsigned*)((LAS unsigned char*)lds_raw + LDS_BYTES - 64);
    if (wave_id == 0 && MK_LANE() < 16) misc[MK_LANE()] = 0u;
    __syncthreads();
    XcdBarrier xbar = xcd_barrier_post((unsigned*)(p.ws + WS_CTL), misc, wave_id == 0 && MK_LANE() == 0);
#ifdef PROBE_PH
    int probe_rep = 0;
#endif
#ifdef PROBE_CLK
    unsigned probe_val = 0;
#endif
    for (int ph = p.ph_lo; ph < p.ph_hi; ++ph) {
        if (ph > p.ph_lo) {
#if MK_CG_SYNC
            cooperative_groups::this_grid().sync();
#else
            { unsigned zb_ = 0u; asm volatile("" : "+v"(zb_)); xcd_barrier(xbar, wave_id == 0 && __builtin_amdgcn_mbcnt_hi(~0u, __builtin_amdgcn_mbcnt_lo(~0u, zb_)) == 0u); }
#endif
        }
        KPC pp = (KPC)__builtin_amdgcn_kernarg_segment_ptr(); asm volatile("" : "+s"(pp));
        unsigned z_ = 0u; asm volatile("" : "+v"(z_));
        int tid = wave_id * 64 + (int)__builtin_amdgcn_mbcnt_hi(~0u, __builtin_amdgcn_mbcnt_lo(~0u, z_)); asm volatile("" : "+v"(tid));
        int bx = blockIdx.x; asm volatile("" : "+s"(bx));
        Frame F; F.lds = (LAS unsigned char*)lds_raw; F.tid = tid; F.lane = tid & 63; F.wave = __builtin_amdgcn_readfirstlane(tid >> 6);
        F.G = gridDim.x; F.bx = bx; F.vcu = (F.G % 8 == 0) ? (bx % 8) * (F.G / 8) + bx / 8 : bx;
#ifdef PROBE_CLK
        unsigned long long c0_ = 0, r0_ = 0;
        if (ph == PROBE_CLK) { c0_ = __builtin_amdgcn_s_memtime(); r0_ = __builtin_amdgcn_s_memrealtime(); }
#endif
        run_phase(pp, F, ph);
#ifdef PROBE_CLK
        if (ph == PROBE_CLK) { const unsigned long long c1_ = __builtin_amdgcn_s_memtime(), r1_ = __builtin_amdgcn_s_memrealtime();
            probe_val = (unsigned)(((c1_ - c0_) * 10ull) / (r1_ - r0_ + 1ull)); }
        if (ph == p.ph_hi - 1 && blockIdx.x == 0 && wave_id == 0 && MK_LANE() == 0) {
            const unsigned long long t0_ = __builtin_amdgcn_s_memrealtime();
            while (__builtin_amdgcn_s_memrealtime() - t0_ < (unsigned long long)probe_val * 100ull) __builtin_amdgcn_s_sleep(8);
        }
#endif
#ifdef PROBE_PH
        if (ph == PROBE_PH && probe_rep == 0) { probe_rep = 1; --ph; }
#endif
    }
#ifdef PROBE_SEC
    if (blockIdx.x == 0 && wave_id == 0 && MK_LANE() == 0) {
        const unsigned v_ = __hip_atomic_load((unsigned*)(p.ws + WS_SCAL) + 64, __ATOMIC_RELAXED, __HIP_MEMORY_SCOPE_AGENT) / 1280u;
        const unsigned long long t0_ = __builtin_amdgcn_s_memrealtime();
        while (__builtin_amdgcn_s_memrealtime() - t0_ < (unsigned long long)v_ * 100ull) __builtin_amdgcn_s_sleep(8);
    }
#endif
}

#ifndef MK_PER_PHASE
#define MK_PER_PHASE 0
#endif
#ifndef MK_DBG
#define MK_DBG 0
#endif
#if MK_DBG
#endif

static void fill_kp(KP& p, void* const* d_in, void* d_out, void* d_ws) {
    const float** f = (const float**)&p;
    for (int i = 0; i < 21; ++i) f[i] = (const float*)d_in[i];
    p.out = (float*)d_out; p.ws = (unsigned char*)d_ws;
}

extern "C" void kernel_launch(void* const* d_in, const int* in_sizes, int n_in, void* d_out, int out_size, void* d_ws, size_t ws_size, hipStream_t stream) {
    static int grid = 0;
    if (grid == 0) {
        int dev = 0, cus = 0, per_cu = 0;
        if (n_in != 21 || out_size != MTOK * DM || ws_size < WS_END) { fprintf(stderr, "kernel_launch: unexpected shapes (n_in %d out %d ws %zu)\n", n_in, out_size, ws_size); grid = -1; return; }
        (void)hipGetDevice(&dev); (void)hipDeviceGetAttribute(&cus, hipDeviceAttributeMultiprocessorCount, dev);
        if (hipFuncSetAttribute((const void*)mega, hipFuncAttributeMaxDynamicSharedMemorySize, LDS_BYTES) != hipSuccess) { fprintf(stderr, "kernel_launch: hipFuncSetAttribute failed\n"); grid = -1; return; }
        if (hipOccupancyMaxActiveBlocksPerMultiprocessor(&per_cu, (const void*)mega, 512, LDS_BYTES) != hipSuccess || per_cu < 1) { fprintf(stderr, "kernel_launch: occupancy query says %d\n", per_cu); per_cu = 1; }
        (void)hipGetLastError();
        grid = cus * 1;
        if (grid % 8 != 0 || grid < 8) grid = 256;
    }
    if (grid < 0) return;
    KP p{}; fill_kp(p, d_in, d_out, d_ws);
#if MK_DBG
    dbg_forward(p, grid, stream);
#elif MK_PER_PHASE
    (void)hipMemsetAsync((char*)d_ws + WS_CTL, 0, 65536, stream);
    for (int ph = 0; ph < N_PHASES; ++ph) { p.ph_lo = ph; p.ph_hi = ph + 1; hipLaunchKernelGGL(mega, dim3(grid), dim3(512), LDS_BYTES, stream, p); }
#else
    p.ph_lo = 0; p.ph_hi = N_PHASES;
#if MK_CG_SYNC
    void* args[] = {&p};
    hipError_t e = hipLaunchCooperativeKernel((const void*)mega, dim3(grid), dim3(512), args, LDS_BYTES, stream);
    if (e != hipSuccess) fprintf(stderr, "cooperative launch failed: %s (grid %d)\n", hipGetErrorString(e), grid);
#else
    (void)hipMemsetAsync((char*)d_ws + WS_CTL, 0, 65536, stream);
    hipLaunchKernelGGL(mega, dim3(grid), dim3(512), LDS_BYTES, stream, p);
#endif
#endif
}
```

```cpp
#include <hip/hip_runtime.h>
#include <hip/hip_cooperative_groups.h>
#include <cstdio>
#include <cstdint>
#include <cmath>

#define LAS __attribute__((address_space(3)))
typedef unsigned short bf16_t;
typedef short bf16x8 __attribute__((ext_vector_type(8)));
typedef float f32x4 __attribute__((ext_vector_type(4)));
typedef float f32x16 __attribute__((ext_vector_type(16)));
typedef unsigned u32x4 __attribute__((ext_vector_type(4)));
typedef unsigned u32x2 __attribute__((ext_vector_type(2)));
typedef float f32x2_t __attribute__((ext_vector_type(2)));
typedef __bf16 bf16x2_t __attribute__((ext_vector_type(2)));

__device__ __forceinline__ unsigned pk2(float lo, float hi) { f32x2_t v = {lo, hi}; bf16x2_t b = __builtin_convertvector(v, bf16x2_t); return __builtin_bit_cast(unsigned, b); }
__device__ __forceinline__ float bflo(unsigned w) { return __uint_as_float(w << 16); }
__device__ __forceinline__ float bfhi(unsigned w) { return __uint_as_float(w & 0xffff0000u); }
__device__ __forceinline__ float bf2f(bf16_t h) { return __uint_as_float((unsigned)h << 16); }
__device__ __forceinline__ float fsilu(float v) { return v / (1.f + __expf(-v)); }
__device__ __forceinline__ float fsigm(float v) { return 1.f / (1.f + __expf(-v)); }
__device__ __forceinline__ float ex2(float v) { return __builtin_amdgcn_exp2f(v); }
__device__ __forceinline__ float wave_sum(float v) {
#pragma unroll
    for (int o = 1; o < 64; o <<= 1) v += __shfl_xor(v, o);
    return v;
}
__device__ __forceinline__ int t5_bucket(int rel) {
    const int n = rel < 0 ? -rel : rel; const int ret = rel > 0 ? 16 : 0;
    int v; if (n < 8) v = n; else { v = 33 - __clz(n * n); if (v > 15) v = 15; }
    return ret + v;
}
#define LDS_WAIT() asm volatile("s_waitcnt lgkmcnt(0)" ::: "memory")
constexpr float LOG2E = 1.4426950408889634f;
constexpr float QSCALE = 0.125f * 1.4426950408889634f;

constexpr int DM = 1024, SEQ = 2048, NBATCH = 16, MTOK = NBATCH * SEQ;
constexpr size_t MiB = 1u << 20;
constexpr size_t WS_CTL = 0, WS_MOD = 1 * MiB, WS_SW = 2 * MiB, WS_SSQ = 3 * MiB, WS_SCAL = 5 * MiB, WS_WG = 5 * MiB + 65536;
constexpr size_t WS_WTE = 6 * MiB, WS_WTO = 18 * MiB, WS_WTOUT = 34 * MiB;
constexpr size_t WS_XG = 48 * MiB, WS_MIXED = 112 * MiB, WS_PROJ = 176 * MiB, WS_PROJG_E = 240 * MiB, WS_PROJG_O = 304 * MiB  , WS_VT = 368 * MiB, WS_XB = 432 * MiB, WS_END = 496 * MiB;
constexpr int LDS_BYTES = 163840;
constexpr int LDS_SPARE = 131072;

struct KP {
    const float *x, *c, *ada_w, *ada_b, *norm_g, *final_g, *t5, *even_w_in, *even_w_out, *da_lam, *da_subg, *conv_w, *conv_b, *w_a, *b_a, *w_x, *b_x, *lru_lam, *odd_w_in, *odd_w_out, *rpb;
    float* out; unsigned char* ws; int ph_lo, ph_hi;
};
typedef const __attribute__((address_space(4))) KP* KPC;
struct Frame { LAS unsigned char* lds; int tid, lane, wave, vcu, G, bx; };

namespace pg8 {
constexpr int BM = 256, BK = 64, HALF = 128, HTB = HALF * BK * 2, STAGE_BYTES = 8 * HTB, NXCD = 8, WGM = 8;
__host__ __device__ __forceinline__ int lds_byte(int r, int c) { const int st = (r >> 4) * 2 + (c >> 5), rr = r & 15, cc = c & 31, ob = rr * 64 + cc * 2; return st * 1024 + (ob ^ (((ob >> 9) & 1) << 5)); }
__host__ __device__ __forceinline__ void stage_rc(int b, int& R, int& C) { const int st = b / 1024, sb = b % 1024, swz = sb ^ (((sb >> 9) & 1) << 5); R = (st >> 1) * 16 + swz / 64; C = (st & 1) * 32 + (swz % 64) / 2; }
__host__ __device__ __forceinline__ int perm32(int rho) { const int n = rho >> 4, i = rho & 15; return 8 * (i >> 2) + 4 * n + (i & 3); }
struct Unit { int pm, pn; };
struct Gemm { const bf16_t* A; const bf16_t* Bt; int M, N, K; };
struct StaticOrder {
    int nM, nN, nwg, G, c;
    __host__ __device__ void init(int M, int N, int G_, int c_) { nM = M / BM; nN = N / BM; nwg = nM * nN; G = G_; c = c_; }
    __host__ __device__ bool next(int i, Unit& u) const {
        const long L = (long)i * G + c; if (L >= nwg) return false;
        int wgid = (int)L; { const int q = nwg / NXCD, r = nwg % NXCD, xcd = wgid % NXCD, off = wgid / NXCD; wgid = (xcd < r ? xcd * (q + 1) : r * (q + 1) + (xcd - r) * q) + off; }
        const int nig = WGM * nN, gid = wgid / nig, fm = gid * WGM, gsz = (nM - fm) < WGM ? (nM - fm) : WGM;
        u.pm = fm + ((wgid % nig) % gsz); u.pn = (wgid % nig) / gsz; return true;
    }
};

template <class Epi, class Sched, bool ALIGN_EPI = false, bool SP2 = false>
__device__ __forceinline__ void gemm_phase(LAS unsigned char* lds, const Gemm g, const Sched& S, const Epi& E, const int tid) {
    const int wid = __builtin_amdgcn_readfirstlane(tid >> 6), lane = tid & 63, wr = wid >> 2, wc = wid & 3, fr = lane & 15, fq = lane >> 4;
    const int K = g.K, nt = K / BK;
    unsigned voffA[2], voffB[2];
#pragma unroll
    for (int i = 0; i < 2; ++i) { int R, C; stage_rc(tid * 16 + i * 8192, R, C); const int Rb = Epi::PERM ? ((R & ~31) + perm32(R & 31)) : R;
        voffA[i] = (unsigned)(R * K + C) * 2u; voffB[i] = (unsigned)(Rb * K + C) * 2u; }
    const size_t kstep = (size_t)(BK * 2);
    const size_t hstep = (size_t)HALF * K * 2;
    const size_t tstep = 2 * hstep;
    const unsigned ldsw = (unsigned)wid * 1024u;
    const int aoff = lds_byte(wr * 64 + fr, fq * 8), boff = lds_byte(wc * 32 + fr, fq * 8);
#define PG8_SA(b, h) (((b) * 2 + (h)) * HTB)
#define PG8_SB(b, h) ((4 + (b) * 2 + (h)) * HTB)
#define PG8_STAGE(bufoff, gbase, voff) do { _Pragma("unroll") for (int _i = 0; _i < 2; ++_i) \
        __builtin_amdgcn_global_load_lds((const unsigned*)((const char*)(gbase) + (voff)[_i]), (LAS unsigned*)(lds + (bufoff) + ldsw + _i * 8192), 16, 0, 0); } while (0)
#define PG8_LDA(dst, b, h) do { _Pragma("unroll") for (int m = 0; m < 4; ++m) _Pragma("unroll") for (int k = 0; k < 2; ++k) dst[m][k] = *(const LAS bf16x8*)(lds + PG8_SA(b, h) + aoff + m * 2048 + k * 1024); } while (0)
#define PG8_LDB(dst, b, h) do { _Pragma("unroll") for (int n = 0; n < 2; ++n) _Pragma("unroll") for (int k = 0; k < 2; ++k) dst[n][k] = *(const LAS bf16x8*)(lds + PG8_SB(b, h) + boff + n * 2048 + k * 1024); } while (0)
#define PG8_MMA(ai, bj, At, Bt) do { __builtin_amdgcn_s_setprio(1); _Pragma("unroll") for (int m = 0; m < 4; ++m) _Pragma("unroll") for (int n = 0; n < 2; ++n) _Pragma("unroll") for (int k = 0; k < 2; ++k) \
        acc[ai][bj][m][n] = __builtin_amdgcn_mfma_f32_16x16x32_bf16(Bt[n][k], At[m][k], acc[ai][bj][m][n], 0, 0, 0); __builtin_amdgcn_s_setprio(0); } while (0)
#define PG8_WAIT_V(n) asm volatile("s_waitcnt vmcnt(" #n ")" ::: "memory")
#define PG8_WAIT_L(n) asm volatile("s_waitcnt lgkmcnt(" #n ")" ::: "memory")
#define PG8_BAR __builtin_amdgcn_s_barrier()
#define PG8_SCHED __builtin_amdgcn_sched_barrier(0)
    Unit cur, nxt; int ui = 0;
    if (!S.next(0, cur)) return;
    f32x4 acc[2][2][4][2];
#pragma unroll
    for (int a = 0; a < 2; ++a)
#pragma unroll
        for (int b = 0; b < 2; ++b)
#pragma unroll
            for (int m = 0; m < 4; ++m)
#pragma unroll
                for (int n = 0; n < 2; ++n) acc[a][b][m][n] = (f32x4){0.f, 0.f, 0.f, 0.f};
    bf16x8 At[4][2], B0[2][2], B1[2][2];
    const char* cA = (const char*)g.A + (size_t)cur.pm * tstep; const char* cB = (const char*)g.Bt + (size_t)cur.pn * tstep;
    if constexpr (SP2) {
        PG8_STAGE(PG8_SB(0, 0), cB, voffB); PG8_STAGE(PG8_SB(0, 1), cB + hstep, voffB); PG8_STAGE(PG8_SA(0, 0), cA, voffA); PG8_STAGE(PG8_SA(0, 1), cA + hstep, voffA);
        if (wr == 1) PG8_BAR;
        PG8_WAIT_V(2); PG8_BAR;
        PG8_STAGE(PG8_SB(1, 0), cB + kstep, voffB); PG8_STAGE(PG8_SA(1, 0), cA + kstep, voffA); PG8_STAGE(PG8_SB(1, 1), cB + hstep + kstep, voffB);
        PG8_WAIT_V(6); PG8_BAR;
    } else {
        PG8_STAGE(PG8_SB(0, 0), cB, voffB); PG8_STAGE(PG8_SA(0, 0), cA, voffA); PG8_STAGE(PG8_SB(0, 1), cB + hstep, voffB); PG8_STAGE(PG8_SA(0, 1), cA + hstep, voffA);
        if (wr == 1) PG8_BAR;
        PG8_WAIT_V(4); PG8_BAR;
        PG8_STAGE(PG8_SB(1, 0), cB + kstep, voffB); PG8_STAGE(PG8_SA(1, 0), cA + kstep, voffA); PG8_STAGE(PG8_SB(1, 1), cB + hstep + kstep, voffB);
        PG8_WAIT_V(6); PG8_BAR;
    }
    for (;;) {
        const bool has_next = S.next(ui + 1, nxt);
        const char* nA = has_next ? (const char*)g.A + (size_t)nxt.pm * tstep : cA; const char* nB = has_next ? (const char*)g.Bt + (size_t)nxt.pn * tstep : cB;
        for (int t = 0; t < nt; t += 2) {
            const bool last = (t == nt - 2);
            const char* a1 = cA + (size_t)(t + 1) * kstep;
            const char* a2 = last ? nA : cA + (size_t)(t + 2) * kstep; const char* b2 = last ? nB : cB + (size_t)(t + 2) * kstep;
            const char* a3 = a2 + kstep; const char* b3 = b2 + kstep;
            if constexpr (SP2) {
            PG8_LDB(B0, 0, 0); PG8_LDB(B1, 0, 1); PG8_SCHED; PG8_LDA(At, 0, 0); PG8_STAGE(PG8_SA(1, 1), a1 + hstep, voffA);
            PG8_WAIT_V(8); PG8_WAIT_L(0); PG8_BAR; PG8_MMA(0, 0, At, B0); PG8_MMA(0, 1, At, B1); PG8_BAR; PG8_SCHED;
            PG8_LDA(At, 0, 1); PG8_STAGE(PG8_SB(0, 0), b2, voffB); PG8_STAGE(PG8_SB(0, 1), b2 + hstep, voffB); PG8_STAGE(PG8_SA(0, 0), a2, voffA);
            PG8_WAIT_V(8); PG8_WAIT_L(0); PG8_BAR; PG8_MMA(1, 0, At, B0); PG8_MMA(1, 1, At, B1); PG8_BAR; PG8_SCHED;
            PG8_LDB(B0, 1, 0); PG8_LDB(B1, 1, 1); PG8_SCHED; PG8_LDA(At, 1, 0); PG8_STAGE(PG8_SA(0, 1), a2 + hstep, voffA);
            PG8_WAIT_V(8); PG8_WAIT_L(0); PG8_BAR; PG8_MMA(0, 0, At, B0); PG8_MMA(0, 1, At, B1); PG8_BAR; PG8_SCHED;
            PG8_LDA(At, 1, 1); PG8_STAGE(PG8_SB(1, 0), b3, voffB); PG8_STAGE(PG8_SB(1, 1), b3 + hstep, voffB); PG8_STAGE(PG8_SA(1, 0), a3, voffA);
            PG8_WAIT_V(8); PG8_WAIT_L(0); PG8_BAR; PG8_MMA(1, 0, At, B0); PG8_MMA(1, 1, At, B1); PG8_BAR; PG8_SCHED;
            } else {
            PG8_LDB(B0, 0, 0); PG8_SCHED; PG8_LDA(At, 0, 0); PG8_STAGE(PG8_SA(1, 1), a1 + hstep, voffA);
            PG8_WAIT_L(8); PG8_BAR; PG8_WAIT_L(0); PG8_MMA(0, 0, At, B0); PG8_BAR; PG8_SCHED;
            PG8_LDB(B1, 0, 1); PG8_STAGE(PG8_SB(0, 0), b2, voffB);
            PG8_BAR; PG8_WAIT_L(0); PG8_MMA(0, 1, At, B1); PG8_BAR;
            PG8_LDA(At, 0, 1); PG8_STAGE(PG8_SA(0, 0), a2, voffA);
            PG8_BAR; PG8_WAIT_L(0); PG8_MMA(1, 0, At, B0); PG8_BAR; PG8_SCHED;
            PG8_STAGE(PG8_SB(0, 1), b2 + hstep, voffB);
            PG8_WAIT_V(6); PG8_BAR; PG8_MMA(1, 1, At, B1); PG8_BAR;
            PG8_LDB(B0, 1, 0); PG8_SCHED; PG8_LDA(At, 1, 0); PG8_STAGE(PG8_SA(0, 1), a2 + hstep, voffA);
            PG8_WAIT_L(8); PG8_BAR; PG8_WAIT_L(0); PG8_MMA(0, 0, At, B0); PG8_BAR; PG8_SCHED;
            PG8_LDB(B1, 1, 1); PG8_STAGE(PG8_SB(1, 0), b3, voffB);
            PG8_BAR; PG8_WAIT_L(0); PG8_MMA(0, 1, At, B1); PG8_BAR;
            PG8_LDA(At, 1, 1); PG8_STAGE(PG8_SA(1, 0), a3, voffA);
            PG8_BAR; PG8_WAIT_L(0); PG8_MMA(1, 0, At, B0); PG8_BAR; PG8_SCHED;
            PG8_STAGE(PG8_SB(1, 1), b3 + hstep, voffB);
            PG8_WAIT_V(6); PG8_BAR; PG8_MMA(1, 1, At, B1); PG8_BAR;
            }
        }
        if constexpr (ALIGN_EPI) { if (wr == 0) PG8_BAR; }
        E(acc, cur, wr, wc, fr, fq, ui);
        if (!has_next) break;
#pragma unroll
        for (int a = 0; a < 2; ++a)
#pragma unroll
            for (int b = 0; b < 2; ++b)
#pragma unroll
                for (int m = 0; m < 4; ++m)
#pragma unroll
                    for (int n = 0; n < 2; ++n) acc[a][b][m][n] = (f32x4){0.f, 0.f, 0.f, 0.f};
        cur = nxt; cA = nA; cB = nB; ++ui;
        if constexpr (ALIGN_EPI) { if (wr == 1) PG8_BAR; }
    }
    PG8_WAIT_V(0);
    if constexpr (!ALIGN_EPI) { if (wr == 0) PG8_BAR; }
    PG8_BAR;
#undef PG8_SA
#undef PG8_SB
#undef PG8_STAGE
#undef PG8_LDA
#undef PG8_LDB
#undef PG8_MMA
#undef PG8_WAIT_V
#undef PG8_WAIT_L
#undef PG8_BAR
#undef PG8_SCHED
}
}
__device__ __forceinline__ float ssq_rinv(const float* ssq, int row) {
    const f32x4* sp = (const f32x4*)(ssq + (size_t)row * 16);
    const f32x4 a = sp[0], b = sp[1], c = sp[2], d = sp[3];
    const float s = ((a[0] + a[1]) + (a[2] + a[3])) + ((b[0] + b[1]) + (b[2] + b[3])) + ((c[0] + c[1]) + (c[2] + c[3])) + ((d[0] + d[1]) + (d[2] + d[3]));
    return rsqrtf(s * (1.f / 1024.f) + 1e-6f);
}
template <int EV> struct EpiProjV {
    static constexpr bool PERM = true;
    bf16_t* O; bf16_t* OG; int qkcols; int ldg; const LAS float* rtab;   const LAS float* stab;   int qcols;
    __device__ __forceinline__ void operator()(const f32x4 (&acc)[2][2][4][2], const pg8::Unit& u, int wr, int wc, int fr, int fq, int ui) const {
        const int row0 = u.pm * 256 + wr * 64 + fr, colb = u.pn * 256 + wc * 32 + 8 * fq, b = (u.pm * 256) >> 11;
        const LAS float* rt_u = rtab + ui * 256 + wr * 64 + fr; const LAS float* st_u = stab + ui * 256 + wc * 32 + 8 * fq; (void)b;
        f32x4 bv[2][2];
#pragma unroll
        for (int bj = 0; bj < 2; ++bj)
#pragma unroll
            for (int n = 0; n < 2; ++n) bv[bj][n] = (EV & 4) ? (f32x4){0.f, 0.f, 0.f, 0.f} : *(const LAS f32x4*)(st_u + bj * 128 + 4 * n);
#pragma unroll
        for (int ai = 0; ai < 2; ++ai)
#pragma unroll
            for (int m = 0; m < 4; ++m) {
                const int row = row0 + ai * 128 + m * 16; const float rt = (EV & 1) ? 1.f : rt_u[ai * 128 + m * 16];
                const int colt = u.pn * 256;
                bf16_t* rowp = (colt < qkcols) ? O + (((size_t)(b * (qkcols >> 6) + (colb >> 6))) * 2048 + (row & 2047)) * 64 + (colb & 63)
                                               : OG + (size_t)row * ldg + (colb - qkcols);
                const int bjs = (colt < qkcols) ? 2 * 2048 * 64 : 128;
#pragma unroll
                for (int bj = 0; bj < 2; ++bj) {
                    const float sc = (u.pn * 256 + bj * 128 < qcols) ? QSCALE : 1.f;
                    const f32x4 v0 = (acc[ai][bj][m][0] * rt + bv[bj][0]) * sc, v1 = (acc[ai][bj][m][1] * rt + bv[bj][1]) * sc;
                    u32x4 w; w.x = pk2(v0[0], v0[1]); w.y = pk2(v0[2], v0[3]); w.z = pk2(v1[0], v1[1]); w.w = pk2(v1[2], v1[3]);
                    if constexpr (!(EV & 2)) *(u32x4*)(rowp + (size_t)bj * bjs) = w; else asm volatile("" :: "v"(w));
                }
            }
    }
};
typedef EpiProjV<0> EpiProj;
struct EpiProjT {
    static constexpr bool PERM = true;
    bf16_t* VT; int NV; const LAS float* rtab;   const LAS float* stab;   int swap23;
    __device__ __forceinline__ void operator()(const f32x4 (&acc)[2][2][4][2], const pg8::Unit& u, int wr, int wc, int fr, int fq, int ui) const {
        const int tok0 = u.pn * 256, b = tok0 >> 11, t0 = tok0 & 2047;
        const int vrow0 = u.pm * 256 + wr * 64 + fr;
        const LAS float* st_u = stab + ui * 256 + wr * 64 + fr;
        bf16_t* base = VT + (size_t)b * NV * 2048 + t0;
#pragma unroll
        for (int bj = 0; bj < 2; ++bj) {
            float rt[2][4];
#pragma unroll
            for (int n = 0; n < 2; ++n)
#pragma unroll
                for (int i = 0; i < 4; ++i) rt[n][i] = rtab[ui * 256 + bj * 128 + wc * 32 + 8 * fq + 4 * n + i];
            const int cl = bj * 128 + wc * 32;
#pragma unroll
            for (int ai = 0; ai < 2; ++ai)
#pragma unroll
                for (int m = 0; m < 4; ++m) {
                    const int vrow = vrow0 + ai * 128 + m * 16; const float bias = st_u[ai * 128 + m * 16];
                    bf16_t* rowp = base + (size_t)vrow * 2048 + cl;
                    const f32x4 a0 = acc[ai][bj][m][0], a1 = acc[ai][bj][m][1];
                    u32x2 w0, w1;
                    w0.x = pk2(a0[0] * rt[0][0] + bias, a0[1] * rt[0][1] + bias); w0.y = pk2(a0[2] * rt[0][2] + bias, a0[3] * rt[0][3] + bias);
                    w1.x = pk2(a1[0] * rt[1][0] + bias, a1[1] * rt[1][1] + bias); w1.y = pk2(a1[2] * rt[1][2] + bias, a1[3] * rt[1][3] + bias);
                    if (swap23) {
                        *(u32x2*)(rowp + 16 * (fq >> 1) + 4 * (fq & 1)) = w0;
                        *(u32x2*)(rowp + 16 * (fq >> 1) + 8 + 4 * (fq & 1)) = w1;
                    } else {
                        u32x4 w; w.x = w0.x; w.y = w0.y; w.z = w1.x; w.w = w1.y; *(u32x4*)(rowp + 8 * fq) = w;
                    }
                }
        }
    }
};
struct EpiOut {
    static constexpr bool PERM = true;
    const float* xin_f32; const bf16_t* xin_b; bf16_t* xout_b; float* xout_f32; bf16_t* xg; float* ssq; const LAS float* gtab;   const LAS float* ntab;   int has_next;
    __device__ __forceinline__ void operator()(const f32x4 (&acc)[2][2][4][2], const pg8::Unit& u, int wr, int wc, int fr, int fq, int ui) const {
        const int row0 = u.pm * 256 + wr * 64 + fr, colb = u.pn * 256 + wc * 32 + 8 * fq, b = (u.pm * 256) >> 11;
        f32x4 gv[2][2], Gn[2][2]; (void)b;
#pragma unroll
        for (int bj = 0; bj < 2; ++bj)
#pragma unroll
            for (int n = 0; n < 2; ++n) {
                const int cl = wc * 32 + 8 * fq + bj * 128 + 4 * n;
                gv[bj][n] = *(const LAS f32x4*)(gtab + ui * 256 + cl);
                Gn[bj][n] = *(const LAS f32x4*)(ntab + ui * 256 + cl);
            }
#pragma unroll
        for (int ag = 0; ag < 4; ++ag) {
            const int ai = ag >> 1, m0 = (ag & 1) * 2;
            f32x4 xa[2][2][2];
            if (xin_f32) {
#pragma unroll
                for (int mm = 0; mm < 2; ++mm)
#pragma unroll
                    for (int bj = 0; bj < 2; ++bj) { const size_t off = (size_t)(row0 + ai * 128 + (m0 + mm) * 16) * 1024 + colb + bj * 128; xa[mm][bj][0] = *(const f32x4*)(xin_f32 + off); xa[mm][bj][1] = *(const f32x4*)(xin_f32 + off + 4); }
            } else {
                u32x4 xb[2][2];
#pragma unroll
                for (int mm = 0; mm < 2; ++mm)
#pragma unroll
                    for (int bj = 0; bj < 2; ++bj) xb[mm][bj] = *(const u32x4*)(xin_b + (size_t)(row0 + ai * 128 + (m0 + mm) * 16) * 1024 + colb + bj * 128);
#pragma unroll
                for (int mm = 0; mm < 2; ++mm)
#pragma unroll
                    for (int bj = 0; bj < 2; ++bj) { const u32x4 w = xb[mm][bj]; xa[mm][bj][0] = (f32x4){bflo(w.x), bfhi(w.x), bflo(w.y), bfhi(w.y)}; xa[mm][bj][1] = (f32x4){bflo(w.z), bfhi(w.z), bflo(w.w), bfhi(w.w)}; }
            }
#pragma unroll
            for (int mm = 0; mm < 2; ++mm) {
                const int m = m0 + mm; const int row = row0 + ai * 128 + m * 16; float ps = 0.f;
#pragma unroll
                for (int bj = 0; bj < 2; ++bj) {
                    const size_t off = (size_t)row * 1024 + colb + bj * 128;
                    const f32x4 y0 = xa[mm][bj][0] + gv[bj][0] * acc[ai][bj][m][0], y1 = xa[mm][bj][1] + gv[bj][1] * acc[ai][bj][m][1];
                    ps += (y0[0] * y0[0] + y0[1] * y0[1]) + (y0[2] * y0[2] + y0[3] * y0[3]) + (y1[0] * y1[0] + y1[1] * y1[1]) + (y1[2] * y1[2] + y1[3] * y1[3]);
                    if (has_next) {
                        u32x4 w; w.x = pk2(y0[0], y0[1]); w.y = pk2(y0[2], y0[3]); w.z = pk2(y1[0], y1[1]); w.w = pk2(y1[2], y1[3]); *(u32x4*)(xout_b + off) = w;
                        const f32x4 z0 = y0 * Gn[bj][0], z1 = y1 * Gn[bj][1];
                        u32x4 v; v.x = pk2(z0[0], z0[1]); v.y = pk2(z0[2], z0[3]); v.z = pk2(z1[0], z1[1]); v.w = pk2(z1[2], z1[3]); *(u32x4*)(xg + off) = v;
                    } else { *(f32x4*)(xout_f32 + off) = y0; *(f32x4*)(xout_f32 + off + 4) = y1; }
                }
                ps += __shfl_xor(ps, 16); ps += __shfl_xor(ps, 32);
                if (fq == 0) ssq[(size_t)row * 16 + u.pn * 4 + wc] = ps;
            }
        }
    }
};

__device__ __forceinline__ int remap_col(int n, int mode) {
    if (mode == 1) return n < 1024 ? n : (n < 1536 ? n + 1536 : n - 512);
    if (mode == 2) return n < 2048 ? n : (n < 3072 ? n + 1024 : n - 1024);
    return n;
}
__device__ __forceinline__ int unmap_col(int c, int odd) {
    if (!odd) return c < 1024 ? c : (c < 2560 ? c + 512 : c - 1536);
    return c < 2048 ? c : (c < 3072 ? c + 1024 : c - 1024);
}
__device__ __forceinline__ void p0_transpose_item(const float* W, int K, int N, bf16_t* WT, int item, LAS float* scr, int lane, int mode) {
    const int nblk = N / 32, kb = item / nblk, nb = item % nblk, k0 = 64 * kb, n0 = 32 * nb;
    { float wv[32];
#pragma unroll
      for (int i = 0; i < 32; ++i) wv[i] = W[(size_t)(k0 + 2 * i + (lane >> 5)) * N + n0 + (lane & 31)];
#pragma unroll
      for (int i = 0; i < 32; ++i) scr[(2 * i + (lane >> 5)) * 33 + (lane & 31)] = wv[i]; }
    LDS_WAIT(); asm volatile("" ::: "memory");
    const int c = lane & 7;
#pragma unroll
    for (int j = 0; j < 4; ++j) { const int n = (lane >> 3) + 8 * j; const LAS float* s = scr + (8 * c) * 33 + n;
        u32x4 o; o.x = pk2(s[0 * 33], s[1 * 33]); o.y = pk2(s[2 * 33], s[3 * 33]); o.z = pk2(s[4 * 33], s[5 * 33]); o.w = pk2(s[6 * 33], s[7 * 33]);
        *(u32x4*)(WT + (size_t)remap_col(n0 + n, mode) * K + k0 + 8 * c) = o; }
    LDS_WAIT(); asm volatile("" ::: "memory");
}
__device__ __forceinline__ void gemv16_item(const LAS float* vec, const float* W, int ldw, int col0, float* out, int out_ld, int ocol0, const float* bias, int lane) {
    const int n = lane & 15, kq = lane >> 4;
    float acc[16];
#pragma unroll
    for (int b = 0; b < 16; ++b) acc[b] = 0.f;
    const float* wp = W + (size_t)(kq * 256) * ldw + col0 + n; const LAS float* vp = vec + kq * 256;
    for (int i0 = 0; i0 < 256; i0 += 16) {
        float w[16];
#pragma unroll
        for (int j = 0; j < 16; ++j) w[j] = wp[(size_t)(i0 + j) * ldw];
#pragma unroll
        for (int j = 0; j < 16; ++j)
#pragma unroll
            for (int b = 0; b < 16; ++b) acc[b] += vp[b * 1024 + i0 + j] * w[j];
    }
#pragma unroll
    for (int b = 0; b < 16; ++b) { acc[b] += __shfl_xor(acc[b], 16); acc[b] += __shfl_xor(acc[b], 32); }
    if (kq == 0) { const float bs = bias ? bias[col0 + n] : 0.f;
#pragma unroll
        for (int b = 0; b < 16; ++b) out[(size_t)b * out_ld + ocol0 + n] = acc[b] + bs; }
}

__device__ __forceinline__ void phase_p0a(KPC p, const Frame& F) {
    unsigned char* ws = p->ws;
    bf16_t* WtE = (bf16_t*)(ws + WS_WTE); bf16_t* WtO = (bf16_t*)(ws + WS_WTO); bf16_t* WtOut = (bf16_t*)(ws + WS_WTOUT); bf16_t* Wg = (bf16_t*)(ws + WS_WG);
    float* mod = (float*)(ws + WS_MOD); float* scal = (float*)(ws + WS_SCAL);
    LAS float* scr = (LAS float*)(F.lds + F.wave * 8448);
    LAS float* vec = (LAS float*)(F.lds + 73728);
    const int gw = F.vcu * 8 + F.wave, NGW = F.G * 8;
    for (int i = F.tid; i < 16384; i += 512) vec[i] = fsilu(p->c[i]);
    for (int it = gw; it < 9216; it += NGW) {
        int r = it;
        if (r < 3072) { const int e = r / 1536; p0_transpose_item(p->even_w_in + (size_t)e * 1024 * 3072, 1024, 3072, WtE + (size_t)e * 3072 * 1024, r % 1536, scr, F.lane, 1); continue; }
        r -= 3072;
        if (r < 4096) { const int o = r / 2048; p0_transpose_item(p->odd_w_in + (size_t)o * 1024 * 4096, 1024, 4096, WtO + (size_t)o * 4096 * 1024, r % 2048, scr, F.lane, 2); continue; }
        r -= 4096;
        { const int j = r / 512; const int l = (j < 2) ? 2 * j : 2 * (j - 2) + 1; const float* src = (j < 2) ? p->even_w_out + (size_t)j * 1024 * 1024 : p->odd_w_out + (size_t)(j - 2) * 1024 * 1024;
          p0_transpose_item(src, 1024, 1024, WtOut + (size_t)l * 1024 * 1024, r % 512, scr, F.lane, 0); }
    }
    for (int idx = gw * 64 + F.lane; idx < 262144; idx += NGW * 64) {
        const int k = idx & 63, j = (idx >> 6) & 255, n = (idx >> 14) & 7, e = idx >> 17; const int set = j >> 6, d = j & 63, r = set >> 1;
        const float* src = (set & 1) ? p->w_x : p->w_a;
        const float v = src[((((size_t)e * 2 + r) * 8 + n) * 64 + k) * 64 + d];
        Wg[idx] = (bf16_t)(pk2(v, 0.f) & 0xffffu);
    }
    if (F.bx == 0 && F.tid < 2) {
        const int e = F.tid; const float* lp = p->da_lam + e * 256; float s01 = 0.f, s23 = 0.f;
        for (int i = 0; i < 64; ++i) { s01 += lp[i] * lp[64 + i]; s23 += lp[128 + i] * lp[192 + i]; }
        const float lam_init = (e == 0) ? 0.2f : 0.47071302f;
        scal[e * 4 + 0] = expf(s01) - expf(s23) + lam_init; scal[e * 4 + 1] = lam_init;
    }
    __syncthreads();
    for (int it = F.wave * F.G + F.vcu; it < 768; it += NGW) {
        const int l = it / 192, ch = it % 192;
        gemv16_item(vec, p->ada_w + (size_t)l * 1024 * 3072, 3072, ch * 16, mod + (size_t)l * 16 * 3072, 3072, ch * 16, p->ada_b + l * 3072, F.lane);
    }
}
__device__ __forceinline__ void phase_p0b(KPC p, const Frame& F) {
    unsigned char* ws = p->ws;
    const float* mod = (const float*)(ws + WS_MOD); float* sW = (float*)(ws + WS_SW); float* ssq = (float*)(ws + WS_SSQ); bf16_t* xg = (bf16_t*)(ws + WS_XG);
    LAS float* vec = (LAS float*)(F.lds);
    const int l = F.vcu & 3;
    for (int i = F.tid; i < 16384; i += 512) vec[i] = mod[((size_t)l * 16 + (i >> 10)) * 3072 + (i & 1023)];
    __syncthreads();
    {
        const int odd = l & 1, N = odd ? 4096 : 3072;
        const float* W = odd ? p->odd_w_in + (size_t)(l >> 1) * 1024 * 4096 : p->even_w_in + (size_t)(l >> 1) * 1024 * 3072;
        for (int it = (F.vcu >> 2) * 8 + F.wave; it < N / 16; it += (F.G >> 2) * 8)
            gemv16_item(vec, W, N, unmap_col(it * 16, odd), sW + (size_t)l * 16 * 4096, 4096, it * 16, nullptr, F.lane);
    }
    const int gw = F.vcu * 8 + F.wave, NGW = F.G * 8;
    for (int row0 = gw; row0 < MTOK; row0 += 2 * NGW) {
        f32x4 v[2][4];
#pragma unroll
        for (int rr = 0; rr < 2; ++rr) { const f32x4* xr = (const f32x4*)(p->x + (size_t)(row0 + rr * NGW) * 1024) + F.lane;
#pragma unroll
            for (int j = 0; j < 4; ++j) v[rr][j] = xr[64 * j]; }
#pragma unroll
        for (int rr = 0; rr < 2; ++rr) {
            const int row = row0 + rr * NGW, b = row >> 11; float s = 0.f;
#pragma unroll
            for (int j = 0; j < 4; ++j) s += (v[rr][j][0] * v[rr][j][0] + v[rr][j][1] * v[rr][j][1]) + (v[rr][j][2] * v[rr][j][2] + v[rr][j][3] * v[rr][j][3]);
            s = wave_sum(s);
            unsigned long long* o8 = (unsigned long long*)(xg + (size_t)row * 1024) + F.lane;
#pragma unroll
            for (int j = 0; j < 4; ++j) {
                const int k = 4 * F.lane + 256 * j;
                const f32x4 g = *(const f32x4*)(p->norm_g + k), sc = *(const f32x4*)(mod + (size_t)b * 3072 + 1024 + k);
                const f32x4 z = v[rr][j] * g * (sc + 1.f);
                o8[64 * j] = (unsigned long long)pk2(z[0], z[1]) | ((unsigned long long)pk2(z[2], z[3]) << 32);
            }
            if (F.lane < 16) ssq[(size_t)row * 16 + F.lane] = (F.lane == 0) ? s : 0.f;
        }
    }
}
__device__ __forceinline__ void phase_final(KPC p, const Frame& F) {
    const float* ssq = (const float*)(p->ws + WS_SSQ);
    const int gw = F.vcu * 8 + F.wave, NGW = F.G * 8;
    for (int row0 = gw; row0 < MTOK; row0 += 4 * NGW) {
        f32x4 v[4][4]; float rt[4];
#pragma unroll
        for (int rr = 0; rr < 4; ++rr) { const f32x4* xr = (const f32x4*)(p->out + (size_t)(row0 + rr * NGW) * 1024) + F.lane; rt[rr] = ssq_rinv(ssq, row0 + rr * NGW);
#pragma unroll
            for (int j = 0; j < 4; ++j) v[rr][j] = xr[64 * j]; }
#pragma unroll
        for (int rr = 0; rr < 4; ++rr) { f32x4* xr = (f32x4*)(p->out + (size_t)(row0 + rr * NGW) * 1024) + F.lane;
#pragma unroll
            for (int j = 0; j < 4; ++j) { const f32x4 g = *(const f32x4*)(p->final_g + 4 * F.lane + 256 * j); xr[64 * j] = v[rr][j] * rt[rr] * g; } }
    }
}
#define MFMA32(a, b, c) __builtin_amdgcn_mfma_f32_32x32x16_bf16((a), (b), (c), 0, 0, 0)
#define MFMA16(a, b, c) __builtin_amdgcn_mfma_f32_16x16x32_bf16((a), (b), (c), 0, 0, 0)
__device__ __forceinline__ float frcp(float v) { return __builtin_amdgcn_rcpf(v); }
__device__ __forceinline__ float fsigm_fast(float v) { return frcp(1.f + __expf(-v)); }
template <int VAR> __device__ __forceinline__ void attn_run(KPC p, const Frame& F, int e_layer, float lam, float lam_init, bf16_t* mixed, int a0, int astride, int count) {
    const int tid = F.tid, lane = F.lane, r = lane & 31, hh = lane >> 5, m = F.wave & 1, sub = F.wave >> 1, grp = F.wave >> 2;
    const bf16_t* P = (const bf16_t*)(p->ws + WS_PROJ); const bf16_t* PG = (const bf16_t*)(p->ws + WS_PROJG_E); const bf16_t* VT = (const bf16_t*)(p->ws + WS_VT);
    LAS unsigned char* lds = F.lds;
    LAS float* lutall = (LAS float*)(lds + 98304); LAS float* SG = (LAS float*)(lds + 106496); LAS float* SSX = (LAS float*)(lds + 107520); LAS float* X = (LAS float*)(lds + 110592) + sub * 2048;
    for (int i = tid; i < 2048; i += 512) { const int hd = i >> 9, idx = i & 511; lutall[i] = (idx < 511) ? p->t5[hd * 32 + t5_bucket(idx - 255)] * LOG2E : 0.f; }
    if (tid < 128) SG[tid] = p->da_subg[e_layer * 128 + tid] * (1.f - lam_init);
    const int skey = (tid >> 3) & 63, ve0 = tid >> 3, sch = (tid & 7) ^ ((skey >> 1) & 7);
    const unsigned koff = (unsigned)(skey * 64 + sch * 8), voff = (unsigned)(ve0 * 2048 + sch * 8);
    const unsigned dmaw = (unsigned)F.wave * 1024u;
    const unsigned swz = (unsigned)((r >> 1) & 7);
#define ATT_DMA(stage_off, ks_, vs_) do { \
        __builtin_amdgcn_global_load_lds((const unsigned*)((ks_) + koff), (LAS unsigned*)(lds + (stage_off) + dmaw), 16, 0, 0); \
        __builtin_amdgcn_global_load_lds((const unsigned*)((ks_) + (size_t)2048 * 64 + koff), (LAS unsigned*)(lds + (stage_off) + 8192 + dmaw), 16, 0, 0); \
        __builtin_amdgcn_global_load_lds((const unsigned*)((vs_) + voff), (LAS unsigned*)(lds + (stage_off) + 16384 + dmaw), 16, 0, 0); \
        __builtin_amdgcn_global_load_lds((const unsigned*)((vs_) + (size_t)64 * 2048 + voff), (LAS unsigned*)(lds + (stage_off) + 24576 + dmaw), 16, 0, 0); } while (0)
#define ATT_DMA8(stage_off, ks_, vs_) do { ATT_DMA(stage_off, ks_, vs_); \
        __builtin_amdgcn_global_load_lds((const unsigned*)((ks_) + koff + 32 * 64), (LAS unsigned*)(lds + (stage_off) + 4096 + dmaw), 16, 0, 0); \
        __builtin_amdgcn_global_load_lds((const unsigned*)((ks_) + (size_t)2048 * 64 + koff + 32 * 64), (LAS unsigned*)(lds + (stage_off) + 8192 + 4096 + dmaw), 16, 0, 0); \
        __builtin_amdgcn_global_load_lds((const unsigned*)((vs_) + voff + (size_t)32 * 2048), (LAS unsigned*)(lds + (stage_off) + 16384 + 4096 + dmaw), 16, 0, 0); \
        __builtin_amdgcn_global_load_lds((const unsigned*)((vs_) + (size_t)64 * 2048 + voff + (size_t)32 * 2048), (LAS unsigned*)(lds + (stage_off) + 24576 + 4096 + dmaw), 16, 0, 0); } while (0)
    bf16x8 qf[4];
    {
        const int a = a0, b = a >> 6, h = (a >> 4) & 3, qb = a & 15;
        const bf16_t* ksrc0 = P + ((size_t)(b * 16 + 8 + 2 * h)) * 2048 * 64;
        const bf16_t* vsrc0 = VT + ((size_t)(b * 512 + h * 128)) * 2048;
#pragma unroll
        for (int t = 0; t < 2; ++t) ATT_DMA(t * 32768, ksrc0 + (size_t)t * 64 * 64, vsrc0 + t * 64);
        const bf16_t* qp = P + (((size_t)(b * 16 + 2 * h + m)) * 2048 + qb * 128 + sub * 32 + r) * 64 + hh * 8;
#pragma unroll
        for (int s = 0; s < 4; ++s) qf[s] = *(const bf16x8*)(qp + 16 * s);
    }
    asm volatile("s_waitcnt vmcnt(0)" ::: "memory");
    __syncthreads();
    bf16x8 kfr[8];
#define ATT_LDK(stage_off) do { _Pragma("unroll") for (int s = 0; s < 4; ++s) { const unsigned co_ = (((unsigned)(2 * s + hh)) ^ swz) << 4; \
        kfr[2 * s] = *(const LAS bf16x8*)(lds + (stage_off) + m * 8192 + r * 128 + co_); kfr[2 * s + 1] = *(const LAS bf16x8*)(lds + (stage_off) + m * 8192 + (32 + r) * 128 + co_); } } while (0)
    ATT_LDK(0);
#ifdef PROBE_SEC
    unsigned sec_acc = 0, sec_last = 0;
#define ST_BEGIN() do { __builtin_amdgcn_sched_barrier(0); sec_last = (unsigned)__builtin_amdgcn_s_memtime(); __builtin_amdgcn_sched_barrier(0); } while (0)
#define ST(n) do { __builtin_amdgcn_sched_barrier(0); const unsigned now_ = (unsigned)__builtin_amdgcn_s_memtime(); if ((n) == PROBE_SEC) sec_acc += now_ - sec_last; sec_last = now_; __builtin_amdgcn_sched_barrier(0); } while (0)
#else
#define ST_BEGIN() do {} while (0)
#define ST(n) do {} while (0)
#endif
    int T = 0;
    for (int k = 0; k < count; ++k) {
        const int a = a0 + k * astride, b = a >> 6, h = (a >> 4) & 3, qb = a & 15;
        const int an = (k + 1 < count) ? a + astride : a, bn = an >> 6, hn = (an >> 4) & 3, qbn = an & 15;
        const size_t tokbase = (size_t)b * 2048; const int q0w = qb * 128 + sub * 32;
        const bf16_t* ksrc0 = P + ((size_t)(b * 16 + 8 + 2 * h)) * 2048 * 64;
        const bf16_t* vsrc0 = VT + ((size_t)(b * 512 + h * 128)) * 2048;
        const bf16_t* ksrcN = P + ((size_t)(bn * 16 + 8 + 2 * hn)) * 2048 * 64;
        const bf16_t* vsrcN = VT + ((size_t)(bn * 512 + hn * 128)) * 2048;
        LAS float* lut = lutall + h * 512;
        const float cL = lut[0], cR = lut[510];
        f32x16 O[4];
#pragma unroll
        for (int et = 0; et < 4; ++et)
#pragma unroll
            for (int i = 0; i < 16; ++i) O[et][i] = 0.f;
        constexpr float THR = 8.f;
        float m_run = 0.f, l_run = 0.f;
        if constexpr (!(VAR & 16)) { if (grp == 1) __builtin_amdgcn_s_barrier(); }
        ST_BEGIN();
        for (int j = 0; j < ((VAR & 128) ? 1 : 32); ++j) {
            const int st = (T % 3) * 32768;
            const bool own = j < 30; const int tl = own ? j + 2 : j - 30;
            const bf16_t* ksn = (own ? ksrc0 : ksrcN) + (size_t)tl * 64 * 64; const bf16_t* vsn = (own ? vsrc0 : vsrcN) + tl * 64;
            const int sn = ((T + 2) % 3) * 32768;

            const LAS unsigned char* vb = lds + st + 16384;
            __builtin_amdgcn_s_setprio(1);
            f32x16 S0, S1;
            { const int rel_max = 64 * j + 63 - q0w, rel_min = 64 * j - (q0w + 31);
              if (rel_max <= -91 || rel_min >= 91) { const float cv = ((rel_max <= -91) ? cL : cR) - m_run;
#pragma unroll
                  for (int i = 0; i < 16; ++i) { S0[i] = cv; S1[i] = cv; }
              } else {
                  const int ib = 64 * j + 4 * hh - (q0w + r) + 255;
#pragma unroll
                  for (int i = 0; i < 16; ++i) { const int idx = ib + (i & 3) + 8 * (i >> 2); S0[i] = lut[idx] - m_run; S1[i] = lut[idx + 32] - m_run; }
              } }
#pragma unroll
            for (int s = 0; s < 4; ++s) S0 = MFMA32(kfr[2 * s], qf[s], S0);
#pragma unroll
            for (int s = 0; s < 4; ++s) S1 = MFMA32(kfr[2 * s + 1], qf[s], S1);
            constexpr int NVPRE = 1;
            bf16x8 vf[NVPRE][4];
#pragma unroll
            for (int et = 0; et < NVPRE; ++et)
#pragma unroll
                for (int s = 0; s < 4; ++s) vf[et][s] = *(const LAS bf16x8*)(vb + (32 * et + r) * 128 + ((((unsigned)(2 * s + hh)) ^ swz) << 4));
            __builtin_amdgcn_sched_barrier(0);
            ST(1);
            if constexpr (!(VAR & 1)) {
                float mxa = fmaxf(fmaxf(S0[0], S0[1]), S1[0]), mxb = fmaxf(fmaxf(S0[2], S0[3]), S1[1]);
                mxa = fmaxf(fmaxf(mxa, S1[2]), S1[3]);
#pragma unroll
                for (int i = 4; i < 16; i += 4) { mxa = fmaxf(fmaxf(mxa, S0[i]), S0[i + 1]); mxb = fmaxf(fmaxf(mxb, S0[i + 2]), S0[i + 3]); mxa = fmaxf(fmaxf(mxa, S1[i]), S1[i + 1]); mxb = fmaxf(fmaxf(mxb, S1[i + 2]), S1[i + 3]); }
                float mx = fmaxf(mxa, mxb);
                mx = fmaxf(mx, __shfl_xor(mx, 32));
                if (j == 0 || __any(mx > THR)) {
                    const float dl = (j == 0 || mx > THR) ? mx : 0.f;
                    const float alpha = ex2(-dl); m_run += dl; l_run *= alpha;
#pragma unroll
                    for (int i = 0; i < 16; ++i) { S0[i] -= dl; S1[i] -= dl; }
#pragma unroll
                    for (int et = 0; et < 4; ++et)
#pragma unroll
                        for (int i = 0; i < 16; ++i) O[et][i] *= alpha;
                }
                float lsa = 0.f, lsb = 0.f;
#pragma unroll
                for (int i = 0; i < 16; ++i) { S0[i] = ex2(S0[i]); S1[i] = ex2(S1[i]); lsa += S0[i]; lsb += S1[i]; }
                l_run += lsa + lsb;
            }
            bf16x8 pf[4];
            { u32x4 w;
              w.x = pk2(S0[0], S0[1]); w.y = pk2(S0[2], S0[3]); w.z = pk2(S0[4], S0[5]); w.w = pk2(S0[6], S0[7]); pf[0] = __builtin_bit_cast(bf16x8, w);
              w.x = pk2(S0[8], S0[9]); w.y = pk2(S0[10], S0[11]); w.z = pk2(S0[12], S0[13]); w.w = pk2(S0[14], S0[15]); pf[1] = __builtin_bit_cast(bf16x8, w);
              w.x = pk2(S1[0], S1[1]); w.y = pk2(S1[2], S1[3]); w.z = pk2(S1[4], S1[5]); w.w = pk2(S1[6], S1[7]); pf[2] = __builtin_bit_cast(bf16x8, w);
              w.x = pk2(S1[8], S1[9]); w.y = pk2(S1[10], S1[11]); w.z = pk2(S1[12], S1[13]); w.w = pk2(S1[14], S1[15]); pf[3] = __builtin_bit_cast(bf16x8, w); }
            ST(2);
            if constexpr (!(VAR & 16)) { asm volatile("s_waitcnt vmcnt(0) lgkmcnt(0)\n\ts_barrier" ::: "memory"); }
            __builtin_amdgcn_s_setprio(0);
            ST(3);
            if constexpr (!(VAR & 8)) { if (grp == 0) ATT_DMA8(sn, ksn, vsn); }
            if (j == 31) {
                const bf16_t* qp = P + (((size_t)(bn * 16 + 2 * hn + m)) * 2048 + qbn * 128 + sub * 32 + r) * 64 + hh * 8;
#pragma unroll
                for (int s = 0; s < 4; ++s) qf[s] = *(const bf16x8*)(qp + 16 * s);
            }
            {
                bf16x8 va[4], vb2[4];
#define ATT_LDV(dst, et_) do { _Pragma("unroll") for (int s = 0; s < 4; ++s) dst[s] = *(const LAS bf16x8*)(vb + (32 * (et_) + r) * 128 + ((((unsigned)(2 * s + hh)) ^ swz) << 4)); } while (0)
#define ATT_MM(src, et_) do { _Pragma("unroll") for (int s = 0; s < 4; ++s) O[et_] = MFMA32(src[s], pf[s], O[et_]); } while (0)
                ATT_LDV(va, 1); __builtin_amdgcn_sched_barrier(0);
                ATT_MM(vf[0], 0); __builtin_amdgcn_sched_barrier(0);
                ATT_LDK(((T + 1) % 3) * 32768);
                __builtin_amdgcn_sched_barrier(0);
                ATT_LDV(vb2, 2); __builtin_amdgcn_sched_barrier(0);
                ATT_MM(va, 1); __builtin_amdgcn_sched_barrier(0);
                ATT_LDV(va, 3); __builtin_amdgcn_sched_barrier(0);
                ATT_MM(vb2, 2); __builtin_amdgcn_sched_barrier(0);
                ATT_MM(va, 3);
            }
            ST(4);
            if constexpr (!(VAR & 16)) asm volatile("s_waitcnt lgkmcnt(0)\n\ts_barrier" ::: "memory");
            ST(5);
            ++T;
        }
        if constexpr (!(VAR & 16)) { if (grp == 0) __builtin_amdgcn_s_barrier(); }
        const size_t tok = tokbase + q0w + r;
        const int et0 = 2 * m;
        u32x2 gav[8];
#pragma unroll
        for (int t = 0; t < 2; ++t)
#pragma unroll
            for (int g4 = 0; g4 < 4; ++g4) gav[t * 4 + g4] = *(const u32x2*)(PG + tok * 1536 + h * 128 + 32 * (et0 + t) + 8 * g4 + 4 * hh);
        l_run += __shfl_xor(l_run, 32);
        const float inv = __builtin_amdgcn_rcpf(l_run);
        f32x16 D0, D1;
        if (m == 1) {
#pragma unroll
            for (int i = 0; i < 16; ++i) { X[i * 64 + lane] = O[0][i] * inv; X[(16 + i) * 64 + lane] = O[1][i] * inv; }
        }
        __syncthreads();
        if (m == 0) {
#pragma unroll
            for (int i = 0; i < 16; ++i) { D0[i] = O[0][i] * inv - lam * X[i * 64 + lane]; D1[i] = O[1][i] * inv - lam * X[(16 + i) * 64 + lane]; }
        }
        __syncthreads();
        if (m == 0) {
#pragma unroll
            for (int i = 0; i < 16; ++i) { X[i * 64 + lane] = O[2][i] * inv; X[(16 + i) * 64 + lane] = O[3][i] * inv; }
        }
        __syncthreads();
        if (m == 1) {
#pragma unroll
            for (int i = 0; i < 16; ++i) { D0[i] = X[i * 64 + lane] - lam * O[2][i] * inv; D1[i] = X[(16 + i) * 64 + lane] - lam * O[3][i] * inv; }
        }
        float ss = 0.f;
#pragma unroll
        for (int i = 0; i < 16; ++i) ss += D0[i] * D0[i] + D1[i] * D1[i];
        ss += __shfl_xor(ss, 32);
        if (hh == 0) SSX[F.wave * 32 + r] = ss;
        __syncthreads();
        ss += SSX[(F.wave ^ 1) * 32 + r];
        const float rinv = rsqrtf(ss * (1.f / 128.f) + 1e-6f);
        if constexpr (!(VAR & 512)) {
#pragma unroll
            for (int t = 0; t < 2; ++t)
#pragma unroll
                for (int g4 = 0; g4 < 4; ++g4) {
                    const int e0 = 32 * (et0 + t) + 8 * g4 + 4 * hh;
                    const f32x4 sg = *(const LAS f32x4*)(SG + e0);
                    const u32x2 ga = gav[t * 4 + g4];
                    const float g0 = bflo(ga.x), g1 = bfhi(ga.x), g2 = bflo(ga.y), g3 = bfhi(ga.y);
                    const float d0 = t ? D1[4 * g4 + 0] : D0[4 * g4 + 0], d1 = t ? D1[4 * g4 + 1] : D0[4 * g4 + 1], d2 = t ? D1[4 * g4 + 2] : D0[4 * g4 + 2], d3 = t ? D1[4 * g4 + 3] : D0[4 * g4 + 3];
                    u32x2 w; w.x = pk2(d0 * rinv * sg[0] * g0 * fsigm_fast(g0), d1 * rinv * sg[1] * g1 * fsigm_fast(g1)); w.y = pk2(d2 * rinv * sg[2] * g2 * fsigm_fast(g2), d3 * rinv * sg[3] * g3 * fsigm_fast(g3));
                    *(u32x2*)(mixed + tok * 1024 + h * 128 + e0) = w;
                }
        }
        ST(6);
    }
    __syncthreads();
#ifdef PROBE_SEC
    if (F.bx == PROBE_BLK && F.wave == PROBE_WAVE && lane == 0) ((unsigned*)(p->ws + WS_SCAL))[64] = sec_acc;
#endif
}

template <int dir> __device__ __forceinline__ void lru_pass(KPC p, const Frame& F, int e_layer, int b, int n, int hf) {
    const int tid = F.tid, lane = F.lane, wave = F.wave;
    const bf16_t* P = (const bf16_t*)(p->ws + WS_PROJG_E);   bf16_t* mixed = (bf16_t*)(p->ws + WS_MIXED); float* HF = (float*)(p->ws + WS_XG);
    const bf16_t* Wg = (const bf16_t*)(p->ws + WS_WG) + ((size_t)(e_layer * 8 + n)) * 256 * 64;
    LAS unsigned char* lds = F.lds;
    LAS unsigned char* XA = lds; LAS float* XC = (LAS float*)(lds + 16384); LAS f32x2_t* PH = (LAS f32x2_t*)(lds + 34816); LAS float* Cc = (LAS float*)(lds + 36864);
    const size_t tokbase = (size_t)b * 2048;
    const int cg = tid & 7, tp = tid >> 3;
    f32x4 cwa[4], cwb[4], cba, cbb;
    { const float* cwp = p->conv_w + (size_t)e_layer * 4 * 512 + n * 64 + cg * 8;
#pragma unroll
      for (int j = 0; j < 4; ++j) { cwa[j] = *(const f32x4*)(cwp + j * 512); cwb[j] = *(const f32x4*)(cwp + j * 512 + 4); }
      const float* cbp = p->conv_b + e_layer * 512 + n * 64 + cg * 8; cba = *(const f32x4*)(cbp); cbb = *(const f32x4*)(cbp + 4); }
    const bf16_t* xcol = P + tokbase * 1536 + 512 + n * 64 + cg * 8;
    const int mt = wave, col = lane & 15, kq = lane >> 4;
    const int kqo = dir ? 3 - kq : kq, wo = dir ? 7 - mt : mt;
    bf16x8 wf[2][2][2];
    float ba[2], bx[2], sp[2];
#pragma unroll
    for (int jj = 0; jj < 2; ++jj) {
        const int ch = 32 * hf + 16 * jj + col;
#pragma unroll
        for (int gs = 0; gs < 2; ++gs)
#pragma unroll
            for (int ks = 0; ks < 2; ++ks) wf[jj][gs][ks] = *(const bf16x8*)(Wg + (size_t)((2 * dir + gs) * 64 + ch) * 64 + 32 * ks + 8 * kq);
        ba[jj] = p->b_a[(e_layer * 2 + dir) * 512 + n * 64 + ch]; bx[jj] = p->b_x[(e_layer * 2 + dir) * 512 + n * 64 + ch];
        const float y = -p->lru_lam[(e_layer * 2 + dir) * 512 + n * 64 + ch]; sp[jj] = -8.f * (fmaxf(y, 0.f) + log1pf(expf(-fabsf(y))));
    }
    if (tid < 64) Cc[tid] = 0.f;
    u32x4 xr[5];
    { const int t0 = (dir ? 15 : 0) * 128;
#pragma unroll
      for (int k = 0; k < 5; ++k) { int tt = t0 + 2 * tp - 2 + k; tt = tt < 0 ? 0 : (tt > 2047 ? 2047 : tt); xr[k] = *(const u32x4*)(xcol + (size_t)tt * 1536); } }
    float hfn[2][4]; bf16_t gvn[2][4];
    if (dir) {
#pragma unroll
        for (int jj = 0; jj < 2; ++jj)
#pragma unroll
            for (int i = 0; i < 4; ++i) { const size_t tok = tokbase + 15 * 128 + 16 * mt + 4 * kq + i; const int ch = n * 64 + 32 * hf + 16 * jj + col;
                hfn[jj][i] = HF[tok * 512 + ch]; gvn[jj][i] = P[tok * 1536 + 1024 + ch]; }
    }
    for (int cc = 0; cc < 16; ++cc) {
        const int chunk = dir ? 15 - cc : cc; const int t0 = chunk * 128; const int par = cc & 1;
        u32x4 xc5[5];
#pragma unroll
        for (int k = 0; k < 5; ++k) { const int tt = t0 + 2 * tp - 2 + k; const bool ok = (tt >= 0) && (tt < 2048); xc5[k] = xr[k]; if (!ok) xc5[k] = (u32x4){0u, 0u, 0u, 0u}; }
        { const int cn = (cc + 1 < 16) ? cc + 1 : cc; const int t1 = (dir ? 15 - cn : cn) * 128;
#pragma unroll
            for (int k = 0; k < 5; ++k) { int tt = t1 + 2 * tp - 2 + k; tt = tt < 0 ? 0 : (tt > 2047 ? 2047 : tt); xr[k] = *(const u32x4*)(xcol + (size_t)tt * 1536); } }
        float hfv[2][4]; bf16_t gvv[2][4];
        if (dir) {
#pragma unroll
            for (int jj = 0; jj < 2; ++jj)
#pragma unroll
                for (int i = 0; i < 4; ++i) { hfv[jj][i] = hfn[jj][i]; gvv[jj][i] = gvn[jj][i]; }
            const int cn2 = (cc + 1 < 16) ? cc + 1 : cc; const int t2 = (15 - cn2) * 128;
#pragma unroll
            for (int jj = 0; jj < 2; ++jj)
#pragma unroll
                for (int i = 0; i < 4; ++i) { const size_t tok = tokbase + t2 + 16 * mt + 4 * kq + i; const int ch = n * 64 + 32 * hf + 16 * jj + col;
                    hfn[jj][i] = HF[tok * 512 + ch]; gvn[jj][i] = P[tok * 1536 + 1024 + ch]; }
        }
#pragma unroll
        for (int i = 0; i < 2; ++i) {
            const int tl = 2 * tp + i;
            f32x4 va = cba, vb = cbb;
#pragma unroll
            for (int j = 0; j < 4; ++j) { const u32x4 x = xc5[i + j];
                va += cwa[j] * (f32x4){bflo(x.x), bfhi(x.x), bflo(x.y), bfhi(x.y)}; vb += cwb[j] * (f32x4){bflo(x.z), bfhi(x.z), bflo(x.w), bfhi(x.w)}; }
            u32x4 w; w.x = pk2(va[0], va[1]); w.y = pk2(va[2], va[3]); w.z = pk2(vb[0], vb[1]); w.w = pk2(vb[2], vb[3]);
            *(LAS u32x4*)(XA + tl * 128 + ((((unsigned)cg) ^ ((unsigned)(tl >> 1) & 7u)) << 4)) = w;
            if ((cg >> 2) == hf) { LAS float* xp = XC + tl * 36 + (cg & 3) * 8; *(LAS f32x4*)(xp) = va; *(LAS f32x4*)(xp + 4) = vb; }
        }
        __syncthreads();
        f32x4 acc[2][2];
#pragma unroll
        for (int jj = 0; jj < 2; ++jj)
#pragma unroll
            for (int gs = 0; gs < 2; ++gs) acc[jj][gs] = (f32x4){0.f, 0.f, 0.f, 0.f};
#pragma unroll
        for (int ks = 0; ks < 2; ++ks) {
            const int row = 16 * mt + col;
            const bf16x8 a = *(const LAS bf16x8*)(XA + row * 128 + ((((unsigned)(4 * ks + kq)) ^ ((unsigned)(row >> 1) & 7u)) << 4));
#pragma unroll
            for (int jj = 0; jj < 2; ++jj)
#pragma unroll
                for (int gs = 0; gs < 2; ++gs) acc[jj][gs] = MFMA16(a, wf[jj][gs][ks], acc[jj][gs]);
        }
        float hl[2][4], Pp[2][4], Pex[2], Hex[2];
#pragma unroll
        for (int jj = 0; jj < 2; ++jj) {
            const int chl = 16 * jj + col;
            float av[4], uv[4];
#pragma unroll
            for (int i = 0; i < 4; ++i) {
                const int tl = 16 * mt + 4 * kq + i;
                const float ga = fsigm_fast(acc[jj][0][i] + ba[jj]), gx = fsigm_fast(acc[jj][1][i] + bx[jj]);
                const float log_a = ga * sp[jj]; const float a = __expf(log_a);
                const float om = fmaxf(__builtin_fmaf(-a, a, 1.f), 0.f);
                av[i] = a; uv[i] = __builtin_amdgcn_sqrtf(om) * gx * XC[tl * 36 + chl];
            }
            if (!dir) { hl[jj][0] = uv[0]; Pp[jj][0] = av[0];
#pragma unroll
                for (int i = 1; i < 4; ++i) { hl[jj][i] = av[i] * hl[jj][i - 1] + uv[i]; Pp[jj][i] = av[i] * Pp[jj][i - 1]; }
            } else { hl[jj][3] = uv[3]; Pp[jj][3] = av[3];
#pragma unroll
                for (int i = 2; i >= 0; --i) { hl[jj][i] = av[i] * hl[jj][i + 1] + uv[i]; Pp[jj][i] = av[i] * Pp[jj][i + 1]; }
            }
            float Pi = dir ? Pp[jj][0] : Pp[jj][3], Hi = dir ? hl[jj][0] : hl[jj][3];
            { const float Pq = dir ? __shfl_down(Pi, 16) : __shfl_up(Pi, 16), Hq = dir ? __shfl_down(Hi, 16) : __shfl_up(Hi, 16);
              if (kqo >= 1) { Hi = Pi * Hq + Hi; Pi = Pi * Pq; } }
            { const float Pq = dir ? __shfl_down(Pi, 32) : __shfl_up(Pi, 32), Hq = dir ? __shfl_down(Hi, 32) : __shfl_up(Hi, 32);
              if (kqo >= 2) { Hi = Pi * Hq + Hi; Pi = Pi * Pq; } }
            { const float Pq = dir ? __shfl_down(Pi, 16) : __shfl_up(Pi, 16), Hq = dir ? __shfl_down(Hi, 16) : __shfl_up(Hi, 16);
              Pex[jj] = (kqo >= 1) ? Pq : 1.f; Hex[jj] = (kqo >= 1) ? Hq : 0.f; }
            if (kqo == 3) PH[mt * 32 + chl] = (f32x2_t){Pi, Hi};
        }
        __syncthreads();
#pragma unroll
        for (int jj = 0; jj < 2; ++jj) {
            const int chl = 16 * jj + col;
            float cw_ = Cc[par * 32 + chl];
            f32x2_t ph[7];
#pragma unroll
            for (int s = 0; s < 7; ++s) ph[s] = PH[(dir ? 7 - s : s) * 32 + chl];
#pragma unroll
            for (int s = 0; s < 7; ++s) cw_ = (s < wo) ? ph[s].x * cw_ + ph[s].y : cw_;
            const float cin = Pex[jj] * cw_ + Hex[jj];
#pragma unroll
            for (int i = 0; i < 4; ++i) hl[jj][i] += Pp[jj][i] * cin;
            if (wo == 7 && kqo == 3) Cc[(par ^ 1) * 32 + chl] = dir ? hl[jj][0] : hl[jj][3];
#pragma unroll
            for (int i = 0; i < 4; ++i) {
                const size_t tok = tokbase + t0 + 16 * mt + 4 * kq + i; const int ch = n * 64 + 32 * hf + chl;
                if (!dir) HF[tok * 512 + ch] = hl[jj][i];
                else { const float g = bf2f(gvv[jj][i]); mixed[tok * 1024 + 512 + ch] = (bf16_t)(pk2((hfv[jj][i] + hl[jj][i]) * g * fsigm_fast(g), 0.f) & 0xffffu); }
            }
        }
    }
    asm volatile("s_waitcnt vmcnt(0)" ::: "memory");
    __syncthreads();
}
__device__ __forceinline__ void lru_unit(KPC p, const Frame& F, int e_layer, int b, int n, int hf) {
    lru_pass<0>(p, F, e_layer, b, n, hf);
    lru_pass<1>(p, F, e_layer, b, n, hf);
}

template <int VAR> __device__ __forceinline__ void na_unit(KPC p, const Frame& F, int o_layer, int b, int h, bf16_t* mixed) {
    const int tid = F.tid, lane = F.lane, wave = F.wave;
    const bf16_t* P = (const bf16_t*)(p->ws + WS_PROJ); const bf16_t* PG = (const bf16_t*)(p->ws + WS_PROJG_O); const bf16_t* VT = (const bf16_t*)(p->ws + WS_VT);
    LAS unsigned char* lds = F.lds; LAS unsigned char* KL = lds; LAS unsigned char* VTL = lds + 73728; LAS float* rpbs = (LAS float*)(lds + 148480);
    const size_t tokbase = (size_t)b * 2048;
    const int skey = tid >> 3, sch = tid & 7;
    const bf16_t* ksrc = P + (((size_t)(b * 32 + 16 + h)) * 2048 + skey) * 64 + sch * 8;
    const bf16_t* vsrc = VT + ((size_t)(b * 1024 + h * 64 + skey)) * 2048 + sch * 8;
    const unsigned kdst = (unsigned)(skey * 128 + ((sch ^ ((skey >> 1) & 7)) << 4));
    const unsigned vdst = (unsigned)(73728 + skey * 1168 + sch * 16);
    if (tid < 465) rpbs[tid] = p->rpb[((size_t)o_layer * 16 + h) * 465 + tid] * LOG2E;
    if constexpr (!(VAR & 256)) { u32x4 kr[9], vr[9];
#pragma unroll
      for (int r = 0; r < 9; ++r) { kr[r] = *(const u32x4*)(ksrc + (size_t)r * 64 * 64); vr[r] = *(const u32x4*)(vsrc + r * 64); }
#pragma unroll
      for (int r = 0; r < 9; ++r) { *(LAS u32x4*)(lds + kdst + r * 8192) = kr[r]; *(LAS u32x4*)(lds + vdst + r * 128) = vr[r]; } }
    const int ri = wave >> 2, g = wave & 3, c0 = 16 * g, kc0 = (g == 0) ? 0 : (g == 1 ? 8 : (g == 2 ? 24 : 32));
    const int q = lane & 15, kq = lane >> 4;
    const int c = c0 + q; int cs = c - 8; cs = cs < 0 ? 0 : (cs > 48 ? 48 : cs);
    f32x4 BT[8][2]; int boff = -1;
    bf16x8 qf[2]; u32x2 gf[4];
    { const size_t tok = tokbase + ri * 64 + c0 + q; const size_t tq_ = (size_t)(b * 32 + h) * 2048 + ri * 64 + c0 + q;
#pragma unroll
      for (int ks = 0; ks < 2; ++ks) qf[ks] = *(const bf16x8*)(P + tq_ * 64 + 32 * ks + 8 * kq);
      (void)tok; }
    for (int rp = 0; rp < ((VAR & 128) ? 1 : 16); ++rp) {
        const int r0 = 2 * rp; int rb = r0 - 4; rb = rb < 0 ? 0 : (rb > 24 ? 24 : rb); int rbn = r0 - 2; rbn = rbn < 0 ? 0 : (rbn > 24 ? 24 : rbn);
        const int newA = rb + 9, newB = rb + 10; const bool do_new = rbn > rb; const bool validA = do_new && newA < 32, validB = do_new && newB < 32;
        const int la = newA < 31 ? newA : 31, lb = newB < 31 ? newB : 31;
        if constexpr (!(VAR & 16)) __syncthreads();
        u32x4 kn0 = {0u,0u,0u,0u}, kn1 = kn0, vn0 = kn0, vn1 = kn0;
        if constexpr (!(VAR & 8)) { kn0 = *(const u32x4*)(ksrc + (size_t)la * 64 * 64); kn1 = *(const u32x4*)(ksrc + (size_t)lb * 64 * 64); vn0 = *(const u32x4*)(vsrc + la * 64); vn1 = *(const u32x4*)(vsrc + lb * 64); }
        bf16x8 qn[2];
        { int rn = r0 + 2 + ri; rn = rn > 31 ? 31 : rn; const size_t tqn = (size_t)(b * 32 + h) * 2048 + rn * 64 + c0 + q;
#pragma unroll
          for (int ks = 0; ks < 2; ++ks) qn[ks] = *(const bf16x8*)(P + tqn * 64 + 32 * ks + 8 * kq); }
        { const size_t tokc = tokbase + (r0 + ri) * 64 + c0 + q;
#pragma unroll
          for (int et = 0; et < 4; ++et) gf[et] = *(const u32x2*)(PG + tokc * 1024 + h * 64 + 16 * et + 4 * kq); }
        {
            const int rr = r0 + ri; int rs = rr - 4; rs = rs < 0 ? 0 : (rs > 24 ? 24 : rs);
            const size_t tok = tokbase + rr * 64 + c0 + q;
            const int off = rr - rs;
            if (off != boff) {
                boff = off;
#pragma unroll
                for (int i = 0; i < 8; ++i)
#pragma unroll
                    for (int a = 0; a < 2; ++a)
#pragma unroll
                        for (int j = 0; j < 4; ++j) {
                            const int kc = kc0 + 16 * a + 4 * kq + j; const bool valid = (kc >= cs) && (kc < cs + 16);
                            int dc = kc - c + 15; dc = dc < 0 ? 0 : (dc > 30 ? 30 : dc);
                            const float bias = rpbs[(i - off + 7) * 31 + dc];
                            BT[i][a][j] = valid ? bias : -1e30f;
                        }
            }
            f32x4 S[8][2];
            {
                bf16x8 ka[4], kb4[4];
#define NA_LDK(dst, i_) do { const int li_ = (rs + (i_)) % 9; _Pragma("unroll") for (int a_ = 0; a_ < 2; ++a_) { const int keyl_ = li_ * 64 + kc0 + 16 * a_ + q; \
                _Pragma("unroll") for (int ks_ = 0; ks_ < 2; ++ks_) dst[a_ * 2 + ks_] = *(const LAS bf16x8*)(KL + keyl_ * 128 + ((((unsigned)(4 * ks_ + kq)) ^ ((unsigned)(keyl_ >> 1) & 7u)) << 4)); } } while (0)
#define NA_QK(src, i_) do { _Pragma("unroll") for (int a_ = 0; a_ < 2; ++a_) { f32x4 acc_ = BT[i_][a_]; acc_ = MFMA16(src[a_ * 2], qf[0], acc_); acc_ = MFMA16(src[a_ * 2 + 1], qf[1], acc_); S[i_][a_] = acc_; } } while (0)
                NA_LDK(ka, 0); __builtin_amdgcn_sched_barrier(0);
                NA_LDK(kb4, 1); __builtin_amdgcn_sched_barrier(0);
                NA_QK(ka, 0); __builtin_amdgcn_sched_barrier(0); NA_LDK(ka, 2); __builtin_amdgcn_sched_barrier(0);
                NA_QK(kb4, 1); __builtin_amdgcn_sched_barrier(0); NA_LDK(kb4, 3); __builtin_amdgcn_sched_barrier(0);
                NA_QK(ka, 2); __builtin_amdgcn_sched_barrier(0); NA_LDK(ka, 4); __builtin_amdgcn_sched_barrier(0);
                NA_QK(kb4, 3); __builtin_amdgcn_sched_barrier(0); NA_LDK(kb4, 5); __builtin_amdgcn_sched_barrier(0);
                NA_QK(ka, 4); __builtin_amdgcn_sched_barrier(0); NA_LDK(ka, 6); __builtin_amdgcn_sched_barrier(0);
                NA_QK(kb4, 5); __builtin_amdgcn_sched_barrier(0); NA_LDK(kb4, 7); __builtin_amdgcn_sched_barrier(0);
                NA_QK(ka, 6); __builtin_amdgcn_sched_barrier(0);
                NA_QK(kb4, 7);
            }
            float l = 1.f;
            if constexpr (!(VAR & 1)) {
            float mx = -1e30f;
#pragma unroll
            for (int i = 0; i < 8; ++i)
#pragma unroll
                for (int a = 0; a < 2; ++a)
#pragma unroll
                    for (int j = 0; j < 4; ++j) mx = fmaxf(mx, S[i][a][j]);
            mx = fmaxf(mx, __shfl_xor(mx, 16)); mx = fmaxf(mx, __shfl_xor(mx, 32));
            l = 0.f;
#pragma unroll
            for (int i = 0; i < 8; ++i)
#pragma unroll
                for (int a = 0; a < 2; ++a)
#pragma unroll
                    for (int j = 0; j < 4; ++j) { const float e = ex2(S[i][a][j] - mx); S[i][a][j] = e; l += e; }
            l += __shfl_xor(l, 16); l += __shfl_xor(l, 32);
            }
            f32x4 O[4];
#pragma unroll
            for (int et = 0; et < 4; ++et) O[et] = (f32x4){0.f, 0.f, 0.f, 0.f};
            {
                u32x4 va4[4], vb4[4];
#define NA_LDV(dst, i_) do { const int li_ = (rs + (i_)) % 9; _Pragma("unroll") for (int et_ = 0; et_ < 4; ++et_) { const LAS unsigned char* vp_ = VTL + (16 * et_ + q) * 1168 + (li_ * 64 + kc0 + 4 * kq) * 2; \
                const u32x2 lo_ = *(const LAS u32x2*)(vp_), hi_ = *(const LAS u32x2*)(vp_ + 32); dst[et_].x = lo_.x; dst[et_].y = lo_.y; dst[et_].z = hi_.x; dst[et_].w = hi_.y; } } while (0)
#define NA_PV(src, i_) do { u32x4 w_; w_.x = pk2(S[i_][0][0], S[i_][0][1]); w_.y = pk2(S[i_][0][2], S[i_][0][3]); w_.z = pk2(S[i_][1][0], S[i_][1][1]); w_.w = pk2(S[i_][1][2], S[i_][1][3]); \
                const bf16x8 pf_ = __builtin_bit_cast(bf16x8, w_); _Pragma("unroll") for (int et_ = 0; et_ < 4; ++et_) O[et_] = MFMA16(__builtin_bit_cast(bf16x8, src[et_]), pf_, O[et_]); } while (0)
                NA_LDV(va4, 0); __builtin_amdgcn_sched_barrier(0);
                NA_LDV(vb4, 1); __builtin_amdgcn_sched_barrier(0);
                NA_PV(va4, 0); __builtin_amdgcn_sched_barrier(0); NA_LDV(va4, 2); __builtin_amdgcn_sched_barrier(0);
                NA_PV(vb4, 1); __builtin_amdgcn_sched_barrier(0); NA_LDV(vb4, 3); __builtin_amdgcn_sched_barrier(0);
                NA_PV(va4, 2); __builtin_amdgcn_sched_barrier(0); NA_LDV(va4, 4); __builtin_amdgcn_sched_barrier(0);
                NA_PV(vb4, 3); __builtin_amdgcn_sched_barrier(0); NA_LDV(vb4, 5); __builtin_amdgcn_sched_barrier(0);
                NA_PV(va4, 4); __builtin_amdgcn_sched_barrier(0); NA_LDV(va4, 6); __builtin_amdgcn_sched_barrier(0);
                NA_PV(vb4, 5); __builtin_amdgcn_sched_barrier(0); NA_LDV(vb4, 7); __builtin_amdgcn_sched_barrier(0);
                NA_PV(va4, 6); __builtin_amdgcn_sched_barrier(0);
                NA_PV(vb4, 7);
            }
            const float inv = __builtin_amdgcn_rcpf(l);
#pragma unroll
            for (int et = 0; et < 4; ++et) {
                const int e0 = 16 * et + 4 * kq; const u32x2 ga = gf[et];
                const float g0 = bflo(ga.x), g1 = bfhi(ga.x), g2 = bflo(ga.y), g3 = bfhi(ga.y);
                u32x2 w; w.x = pk2(O[et][0] * inv * g0 * fsigm_fast(g0), O[et][1] * inv * g1 * fsigm_fast(g1)); w.y = pk2(O[et][2] * inv * g2 * fsigm_fast(g2), O[et][3] * inv * g3 * fsigm_fast(g3));
                *(u32x2*)(mixed + tok * 1024 + h * 64 + e0) = w;
            }
        }
        if constexpr (!(VAR & 16)) __syncthreads();
        if constexpr (!(VAR & 8)) {
        if (validA) { *(LAS u32x4*)(lds + kdst + (newA % 9) * 8192) = kn0; *(LAS u32x4*)(lds + vdst + (newA % 9) * 128) = vn0; }
        if (validB) { *(LAS u32x4*)(lds + kdst + (newB % 9) * 8192) = kn1; *(LAS u32x4*)(lds + vdst + (newB % 9) * 128) = vn1; }
        }
#pragma unroll
        for (int ks = 0; ks < 2; ++ks) qf[ks] = qn[ks];
    }
    __syncthreads();
}
#ifdef PROBE_PROTO
__device__ __forceinline__ void attn_proto(KPC p, const Frame& F, bf16_t* outp, int a0, int astride, int count) {
    const int tid = F.tid, lane = F.lane, r = lane & 31, hh = lane >> 5, wave = F.wave;
    const bool isS = wave < 4; const int sub = wave & 3;
    const bf16_t* P = (const bf16_t*)(p->ws + WS_PROJ); const bf16_t* VT = (const bf16_t*)(p->ws + WS_VT);
    LAS unsigned char* lds = F.lds;
    const int skey = (tid >> 3) & 63, ve0 = tid >> 3, sch = (tid & 7) ^ ((skey >> 1) & 7);
    const unsigned dmaw = (unsigned)wave * 1024u; const unsigned swz = (unsigned)((r >> 1) & 7);
#define PR_DMA_K(st, ks_) do { __builtin_amdgcn_global_load_lds((const unsigned*)(ks_), (LAS unsigned*)(lds + (st) * 16384 + dmaw), 16, 0, 0); \
        __builtin_amdgcn_global_load_lds((const unsigned*)((ks_) + (size_t)2048 * 64), (LAS unsigned*)(lds + (st) * 16384 + 8192 + dmaw), 16, 0, 0); } while (0)
#define PR_DMA_V(st, vs_) do { __builtin_amdgcn_global_load_lds((const unsigned*)(vs_), (LAS unsigned*)(lds + 49152 + (st) * 16384 + dmaw), 16, 0, 0); \
        __builtin_amdgcn_global_load_lds((const unsigned*)((vs_) + (size_t)64 * 2048), (LAS unsigned*)(lds + 49152 + (st) * 16384 + 8192 + dmaw), 16, 0, 0); } while (0)
#define PR_STEP_COMMON(t) if (!(PROBE_PROTO & 8)) { const int tk = ((t) + 2 < 32) ? (t) + 2 : 31, tv = ((t) + 1 < 32) ? (t) + 1 : 31; \
              PR_DMA_K(((t) + 2) % 3, ksrc0 + (size_t)tk * 64 * 64); PR_DMA_V(((t) + 1) % 3, vsrc0 + tv * 64); }
#define PR_BAR() asm volatile("s_waitcnt vmcnt(4) lgkmcnt(0)\n\ts_barrier" ::: "memory")
    if (isS) {
      for (int k = 0; k < count; ++k) {
        const int a = a0 + k * astride, b = a >> 6, h = (a >> 4) & 3, qb = a & 15;
        const bf16_t* ksrc0 = P + (((size_t)(b * 16 + 8 + 2 * h)) * 2048 + skey) * 64 + sch * 8;
        const bf16_t* vsrc0 = VT + ((size_t)(b * 512 + h * 128 + ve0)) * 2048 + sch * 8;
        PR_DMA_K(0, ksrc0); PR_DMA_K(1, ksrc0 + (size_t)64 * 64); PR_DMA_V(0, vsrc0);
        bf16x8 qf[2][4];
#pragma unroll
        for (int mm = 0; mm < 2; ++mm) { const bf16_t* qp = P + (((size_t)(b * 16 + 2 * h + mm)) * 2048 + qb * 128 + sub * 32 + r) * 64 + hh * 8;
#pragma unroll
            for (int s = 0; s < 4; ++s) qf[mm][s] = *(const bf16x8*)(qp + 16 * s); }
        float mrun0 = 0.f, mrun1 = 0.f, l0 = 0.f, l1 = 0.f;
        asm volatile("s_waitcnt vmcnt(0)" ::: "memory");
        __syncthreads();
        for (int t = 0; t < 33; ++t) {
            PR_STEP_COMMON(t);
            if (t < 32 && !(PROBE_PROTO & 2)) {
                const LAS unsigned char* kb = lds + (t % 3) * 16384;
                LAS unsigned char* pb = lds + 98304 + (t & 1) * 32768 + sub * 8192;
#pragma unroll
                for (int mm = 0; mm < 2; ++mm) {
                    f32x16 S0, S1; float& mrun = mm ? mrun1 : mrun0; float& lr = mm ? l1 : l0;
                    const float cv = 0.25f - mrun;
#pragma unroll
                    for (int i = 0; i < 16; ++i) { S0[i] = cv; S1[i] = cv; }
#pragma unroll
                    for (int s = 0; s < 4; ++s) {
                        const unsigned co = (((unsigned)(2 * s + hh)) ^ swz) << 4;
                        const bf16x8 a0v = *(const LAS bf16x8*)(kb + mm * 8192 + r * 128 + co), a1v = *(const LAS bf16x8*)(kb + mm * 8192 + (32 + r) * 128 + co);
                        S0 = MFMA32(a0v, qf[mm][s], S0); S1 = MFMA32(a1v, qf[mm][s], S1);
                    }
                    float mxa = fmaxf(fmaxf(S0[0], S0[1]), S1[0]), mxb = fmaxf(fmaxf(S0[2], S0[3]), S1[1]);
                    mxa = fmaxf(fmaxf(mxa, S1[2]), S1[3]);
#pragma unroll
                    for (int i = 4; i < 16; i += 4) { mxa = fmaxf(fmaxf(mxa, S0[i]), S0[i + 1]); mxb = fmaxf(fmaxf(mxb, S0[i + 2]), S0[i + 3]); mxa = fmaxf(fmaxf(mxa, S1[i]), S1[i + 1]); mxb = fmaxf(fmaxf(mxb, S1[i + 2]), S1[i + 3]); }
                    float mx = fmaxf(mxa, mxb); mx = fmaxf(mx, __shfl_xor(mx, 32));
                    if (t == 0 || __any(mx > 8.f)) { const float dl = (t == 0 || mx > 8.f) ? mx : 0.f; mrun += dl; lr *= ex2(-dl);
#pragma unroll
                        for (int i = 0; i < 16; ++i) { S0[i] -= dl; S1[i] -= dl; } }
                    float lsa = 0.f, lsb = 0.f;
#pragma unroll
                    for (int i = 0; i < 16; ++i) { S0[i] = ex2(S0[i]); S1[i] = ex2(S1[i]); lsa += S0[i]; lsb += S1[i]; }
                    lr += lsa + lsb;
                    u32x4 w;
                    w.x = pk2(S0[0], S0[1]); w.y = pk2(S0[2], S0[3]); w.z = pk2(S0[4], S0[5]); w.w = pk2(S0[6], S0[7]); *(LAS u32x4*)(pb + mm * 4096 + 0 * 1024 + lane * 16) = w;
                    w.x = pk2(S0[8], S0[9]); w.y = pk2(S0[10], S0[11]); w.z = pk2(S0[12], S0[13]); w.w = pk2(S0[14], S0[15]); *(LAS u32x4*)(pb + mm * 4096 + 1 * 1024 + lane * 16) = w;
                    w.x = pk2(S1[0], S1[1]); w.y = pk2(S1[2], S1[3]); w.z = pk2(S1[4], S1[5]); w.w = pk2(S1[6], S1[7]); *(LAS u32x4*)(pb + mm * 4096 + 2 * 1024 + lane * 16) = w;
                    w.x = pk2(S1[8], S1[9]); w.y = pk2(S1[10], S1[11]); w.z = pk2(S1[12], S1[13]); w.w = pk2(S1[14], S1[15]); *(LAS u32x4*)(pb + mm * 4096 + 3 * 1024 + lane * 16) = w;
                }
            }
            PR_BAR();
        }
        if (lane == 0) ((float*)outp)[(a * 8 + wave) * 2] = l0 + l1 + mrun0 + mrun1;
        asm volatile("s_waitcnt vmcnt(0)" ::: "memory");
        __syncthreads();
      }
    } else {
      for (int k = 0; k < count; ++k) {
        const int a = a0 + k * astride, b = a >> 6, h = (a >> 4) & 3;
        const bf16_t* ksrc0 = P + (((size_t)(b * 16 + 8 + 2 * h)) * 2048 + skey) * 64 + sch * 8;
        const bf16_t* vsrc0 = VT + ((size_t)(b * 512 + h * 128 + ve0)) * 2048 + sch * 8;
        PR_DMA_K(0, ksrc0); PR_DMA_K(1, ksrc0 + (size_t)64 * 64); PR_DMA_V(0, vsrc0);
        f32x16 O0[4], O1[4];
#pragma unroll
        for (int et = 0; et < 4; ++et)
#pragma unroll
            for (int i = 0; i < 16; ++i) { O0[et][i] = 0.f; O1[et][i] = 0.f; }
        asm volatile("s_waitcnt vmcnt(0)" ::: "memory");
        __syncthreads();
        for (int t = 0; t < 33; ++t) {
            PR_STEP_COMMON(t);
            if (t >= 1 && !(PROBE_PROTO & 4)) {
                const LAS unsigned char* vb = lds + 49152 + ((t - 1) % 3) * 16384;
                const LAS unsigned char* pb = lds + 98304 + ((t - 1) & 1) * 32768 + sub * 8192;
                bf16x8 pf0[4], pf1[4];
#pragma unroll
                for (int s = 0; s < 4; ++s) { pf0[s] = *(const LAS bf16x8*)(pb + s * 1024 + lane * 16); pf1[s] = *(const LAS bf16x8*)(pb + 4096 + s * 1024 + lane * 16); }
                bf16x8 vfa[4], vfb[4];
#define PR_LDV(dst, et_) do { _Pragma("unroll") for (int s = 0; s < 4; ++s) dst[s] = *(const LAS bf16x8*)(vb + (32 * (et_) + r) * 128 + ((((unsigned)(2 * s + hh)) ^ swz) << 4)); } while (0)
#define PR_MM(src, et_) do { _Pragma("unroll") for (int s = 0; s < 4; ++s) { O0[et_] = MFMA32(src[s], pf0[s], O0[et_]); O1[et_] = MFMA32(src[s], pf1[s], O1[et_]); } } while (0)
                PR_LDV(vfa, 0); PR_LDV(vfb, 1); __builtin_amdgcn_sched_barrier(0);
                PR_MM(vfa, 0); __builtin_amdgcn_sched_barrier(0);
                PR_LDV(vfa, 2); __builtin_amdgcn_sched_barrier(0);
                PR_MM(vfb, 1); __builtin_amdgcn_sched_barrier(0);
                PR_LDV(vfb, 3); __builtin_amdgcn_sched_barrier(0);
                PR_MM(vfa, 2); __builtin_amdgcn_sched_barrier(0);
                PR_MM(vfb, 3);
            }
            PR_BAR();
        }
        float acc = 0.f;
#pragma unroll
        for (int et = 0; et < 4; ++et)
#pragma unroll
            for (int i = 0; i < 16; ++i) acc += O0[et][i] - O1[et][i];
        ((float*)outp)[1024 * 64 + (a * 8 + wave) * 64 + lane] = acc;
        asm volatile("s_waitcnt vmcnt(0)" ::: "memory");
        __syncthreads();
      }
    }
}
#endif
#if defined(PROBE_EMPTY)
constexpr int N_PHASES = 15 + PROBE_EMPTY;
#elif defined(PROBE_ATT) || defined(PROBE_NA) || defined(PROBE_GEMM) || defined(PROBE_PROTO)
constexpr int N_PHASES = 16;
#else
constexpr int N_PHASES = 15;
#endif
__device__ __forceinline__ void run_phase(KPC p, const Frame& F, int ph) {
    unsigned char* ws = p->ws;
    if (ph == 0) { phase_p0a(p, F); return; }
    if (ph == 1) { phase_p0b(p, F); return; }
    if (ph == 14) { phase_final(p, F); return; }
#ifdef PROBE_EMPTY
    if (ph >= 15) { return; }
#endif
#ifdef PROBE_PROTO
    if (ph == 15) {
        Frame Fu = F; asm volatile("" : "+v"(Fu.tid)); Fu.lane = Fu.tid & 63;
        attn_proto(p, Fu, (bf16_t*)(ws + WS_XG), F.vcu, F.G, 4);
        return;
    }
#endif
#ifdef PROBE_GEMM
    if (ph == 15) {
        pg8::Gemm g{(const bf16_t*)(ws + WS_XG), (const bf16_t*)(ws + WS_WTE), MTOK, 2560, 1024}; pg8::StaticOrder S; S.init(MTOK, 2560, F.G, F.bx);
        EpiProjV<PROBE_GEMM> E{(bf16_t*)(ws + WS_PROJ), (bf16_t*)(ws + WS_PROJG_E), 1024, 1536, (LAS float*)(F.lds + LDS_SPARE), (LAS float*)(F.lds + LDS_SPARE) + 12 * 256, 512};
        pg8::gemm_phase<EpiProjV<PROBE_GEMM>, pg8::StaticOrder, true, true>(F.lds, g, S, E, F.tid);
        return;
    }
#endif
#ifdef PROBE_NA
    if (ph == 15) {
        for (int u = F.vcu; u < 256; u += F.G) { Frame Fu = F; asm volatile("" : "+v"(Fu.tid)); Fu.lane = Fu.tid & 63; na_unit<PROBE_NA>(p, Fu, 1, u >> 4, u & 15, (bf16_t*)(ws + WS_XG)); }
        return;
    }
#endif
#ifdef PROBE_ATT
    if (ph == 15) {
        const float* scal = (const float*)(ws + WS_SCAL); const float lam = scal[0], lam_init = scal[1];
        { Frame Fu = F; asm volatile("" : "+v"(Fu.tid)); Fu.lane = Fu.tid & 63;
          const int cnt = (F.vcu < 1024) ? (1024 - F.vcu + F.G - 1) / F.G : 0;
          if (cnt > 0) attn_run<PROBE_ATT>(p, Fu, 0, lam, lam_init, (bf16_t*)(ws + WS_XG), F.vcu, F.G, cnt); }
        return;
    }
#endif
    const int l = (ph - 2) / 3, k = (ph - 2) % 3, odd = l & 1, ei = l >> 1;
    bf16_t* xg = (bf16_t*)(ws + WS_XG); bf16_t* mixed = (bf16_t*)(ws + WS_MIXED); bf16_t* proj = (bf16_t*)(ws + WS_PROJ); bf16_t* VT = (bf16_t*)(ws + WS_VT);
    float* ssq = (float*)(ws + WS_SSQ); const float* sW = (const float*)(ws + WS_SW) + (size_t)l * 16 * 4096; const float* mod = (const float*)(ws + WS_MOD);
    if (k == 0) {
        const int N1 = odd ? 3072 : 2560, NV = odd ? 1024 : 512;
        const bf16_t* Wt = odd ? (const bf16_t*)(ws + WS_WTO) + (size_t)ei * 4096 * 1024 : (const bf16_t*)(ws + WS_WTE) + (size_t)ei * 3072 * 1024;
        LAS float* rtab1 = (LAS float*)(F.lds + LDS_SPARE); LAS float* rtab2 = rtab1 + 8 * 256; LAS float* stab1 = rtab2 + 4 * 256; LAS float* stab2 = stab1 + 8 * 256;
        pg8::StaticOrder S1; S1.init(MTOK, N1, F.G, F.bx); pg8::StaticOrder S2; S2.init(NV, MTOK, F.G, F.bx);
        { const int rl = F.tid & 255, half = F.tid >> 8; pg8::Unit u;
          for (int i = half; i < 8; i += 2) { if (S1.next(i, u)) { rtab1[i * 256 + rl] = ssq_rinv(ssq, u.pm * 256 + rl); stab1[i * 256 + rl] = sW[(size_t)((u.pm * 256) >> 11) * 4096 + u.pn * 256 + rl]; } }
          for (int i = half; i < 4; i += 2) { if (S2.next(i, u)) { rtab2[i * 256 + rl] = ssq_rinv(ssq, u.pn * 256 + rl); stab2[i * 256 + rl] = sW[(size_t)((u.pn * 256) >> 11) * 4096 + N1 + u.pm * 256 + rl]; } } }
        __syncthreads();
        { pg8::Gemm g{xg, Wt, MTOK, N1, 1024};
          EpiProj E{proj, (bf16_t*)(ws + (odd ? WS_PROJG_O : WS_PROJG_E)), odd ? 2048 : 1024, odd ? 1024 : 1536, rtab1, stab1, odd ? 1024 : 512};
          pg8::gemm_phase<EpiProj, pg8::StaticOrder, true, true>(F.lds, g, S1, E, F.tid); }
        { pg8::Gemm g{Wt + (size_t)N1 * 1024, xg, NV, MTOK, 1024};
          EpiProjT E{VT, NV, rtab2, stab2, odd ? 0 : 1};
          pg8::gemm_phase<EpiProjT, pg8::StaticOrder, true, true>(F.lds, g, S2, E, F.tid); }
    } else if (k == 1) {
        if (!odd) {
            const float* scal = (const float*)(ws + WS_SCAL); const float lam = scal[ei * 4 + 0], lam_init = scal[ei * 4 + 1];
            for (int u = F.vcu; u < 256; u += F.G) {
                Frame Fu = F; asm volatile("" : "+v"(Fu.tid)); Fu.lane = Fu.tid & 63;
                lru_unit(p, Fu, ei, u >> 4, (u >> 1) & 7, u & 1);
            }
            { Frame Fu = F; asm volatile("" : "+v"(Fu.tid)); Fu.lane = Fu.tid & 63;
              const int cnt = (F.vcu < 1024) ? (1024 - F.vcu + F.G - 1) / F.G : 0;
              if (cnt > 0) attn_run<0>(p, Fu, ei, lam, lam_init, mixed, F.vcu, F.G, cnt); }
#ifdef PROBE_MIX
            if (l == 0 && PROBE_MIX == 1) for (int u = F.vcu; u < 256; u += F.G) { Frame Fu = F; asm volatile("" : "+v"(Fu.tid)); Fu.lane = Fu.tid & 63; lru_unit(p, Fu, ei, u >> 4, (u >> 1) & 7, u & 1); }
#endif
        } else {
            for (int u = F.vcu; u < 256; u += F.G) { Frame Fu = F; asm volatile("" : "+v"(Fu.tid)); Fu.lane = Fu.tid & 63;
                na_unit<0>(p, Fu, ei, u >> 4, u & 15, mixed); }
        }
    } else {
        pg8::Gemm g{mixed, (const bf16_t*)(ws + WS_WTOUT) + (size_t)l * 1024 * 1024, MTOK, 1024, 1024}; pg8::StaticOrder S; S.init(MTOK, 1024, F.G, F.bx);
        bf16_t* xbf = (bf16_t*)(ws + WS_XB);
        LAS float* gtab = (LAS float*)(F.lds + LDS_SPARE); LAS float* ntab = gtab + 4 * 256;
        { const int rl = F.tid & 255, half = F.tid >> 8; pg8::Unit u;
          for (int i = half; i < 4; i += 2) { if (S.next(i, u)) { const int b = (u.pm * 256) >> 11, col = u.pn * 256 + rl;
              gtab[i * 256 + rl] = mod[((size_t)l * 16 + b) * 3072 + 2048 + col];
              ntab[i * 256 + rl] = (l < 3) ? p->norm_g[(l + 1) * 1024 + col] * (1.f + mod[((size_t)(l + 1) * 16 + b) * 3072 + 1024 + col]) : 0.f; } } }
        __syncthreads();
        EpiOut E{l == 0 ? p->x : nullptr, xbf, xbf, p->out, xg, ssq, gtab, ntab, l < 3 ? 1 : 0};
        pg8::gemm_phase<EpiOut, pg8::StaticOrder, true, true>(F.lds, g, S, E, F.tid);
    }
}


#define XB_TMO      128
#define XB_XCNT(j)  (256  + 64 * (j))
#define XB_XSUB(j)  (1280 + 64 * (j))
#define XB_XGEN(j)  (2304 + 64 * (j))
#define XB_TOP      3328
#define XB_TOPGEN   3392
#define XCD_BAR_WORDS 3456
#define XB_SPIN_CAP (1u << 20)
__device__ __forceinline__ unsigned xb_ld(unsigned* p)              { return __hip_atomic_load(p, __ATOMIC_RELAXED, __HIP_MEMORY_SCOPE_AGENT); }
__device__ __forceinline__ unsigned xb_add(unsigned* p, unsigned v) { return __hip_atomic_fetch_add(p, v, __ATOMIC_RELAXED, __HIP_MEMORY_SCOPE_AGENT); }
__device__ __forceinline__ unsigned xb_xcc_id() { return (unsigned)__builtin_amdgcn_s_getreg((3 << 11) | 20) & 0xFu; }
#define XB_SPIN(cond, bar) do { unsigned _sp = 0; while (cond) { __builtin_amdgcn_s_sleep(1); \
    if ((++_sp & 255u) == 0u) { if (xb_ld(&(bar)[XB_TMO])) break; if (_sp > XB_SPIN_CAP) { atomicAdd(&(bar)[XB_TMO], 1u); break; } } } } while (0)
struct XcdBarrier { unsigned* bar; unsigned x; volatile LAS unsigned* st; };
__device__ __forceinline__ XcdBarrier xcd_barrier_post(unsigned* bar, volatile LAS unsigned* st, bool leader) {
    XcdBarrier b; b.bar = bar; b.x = xb_xcc_id(); b.st = st;
    if (leader) (void)xb_add(&bar[XB_XCNT(b.x)], 1u);
    return b;
}
__device__ __forceinline__ void xcd_barrier_complete(unsigned* bar, unsigned x, unsigned& nloc, unsigned& nx) {
    const unsigned G = gridDim.x * gridDim.y * gridDim.z;
    unsigned sum, cnt, mine, sp = 0u;
    for (;;) {
        sum = 0u; cnt = 0u; mine = 0u;
#pragma unroll
        for (unsigned j = 0; j < 16; ++j) { const unsigned c = xb_ld(&bar[XB_XCNT(j)]); sum += c; cnt += (c > 0u) ? 1u : 0u; mine = (j == x) ? c : mine; }
        if (sum == G) break;
        __builtin_amdgcn_s_sleep(1);
        if ((++sp & 255u) == 0u) { if (xb_ld(&bar[XB_TMO])) break; if (sp > XB_SPIN_CAP) { atomicAdd(&bar[XB_TMO], 1u); break; } }
    }
    nloc = mine > 0u ? mine : 1u; nx = cnt > 0u ? cnt : 1u;
}
__device__ __forceinline__ void xcd_barrier(const XcdBarrier& b, bool leader) {
    asm volatile("s_waitcnt vmcnt(0)" ::: "memory");
    __syncthreads();
    if (leader) {
        unsigned* bar = b.bar;
        __builtin_amdgcn_s_waitcnt(0);
        unsigned nloc = b.st[0], nx = b.st[1];
        if (nloc == 0u) { xcd_barrier_complete(bar, b.x, nloc, nx); b.st[0] = nloc; b.st[1] = nx; }
        const unsigned old = xb_add(&bar[XB_XSUB(b.x)], 1u);
        const unsigned gen = old / nloc;
        if (old + 1u == (gen + 1u) * nloc) {
            __builtin_amdgcn_fence(__ATOMIC_RELEASE, "agent");
            asm volatile("s_waitcnt vmcnt(0)" ::: "memory");
            const unsigned og = xb_add(&bar[XB_TOP], 1u);
            const unsigned tg = og / nx;
            if (og + 1u == (tg + 1u) * nx) xb_add(&bar[XB_TOPGEN], 1u);
            else XB_SPIN(xb_ld(&bar[XB_TOPGEN]) == tg, bar);
            __builtin_amdgcn_fence(__ATOMIC_ACQUIRE, "agent");
            xb_add(&bar[XB_XGEN(b.x)], 1u);
            asm volatile("s_waitcnt vmcnt(0)" ::: "memory");
        } else {
            XB_SPIN(xb_ld(&bar[XB_XGEN(b.x)]) == gen, bar);
            __builtin_amdgcn_fence(__ATOMIC_ACQUIRE, "agent");
            asm volatile("s_waitcnt vmcnt(0)" ::: "memory");
        }
    }
    __syncthreads();
}
#ifndef MK_CG_SYNC
#define MK_CG_SYNC 0
#endif

__global__ void __launch_bounds__(512, 2) mega(KP p) {
    extern __shared__ __attribute__((aligned(16))) unsigned char lds_raw[];
    const int wave_id = __builtin_amdgcn_readfirstlane(threadIdx.x >> 6);
#define MK_LANE() ((int)__builtin_amdgcn_mbcnt_hi(~0u, __builtin_amdgcn_mbcnt_lo(~0u, 0u)))
    volatile LAS unsigned* misc = (volatile LAS unsigned*)((LAS unsigned char*)lds_raw + LDS_BYTES - 64);
    if (wave_id == 0 && MK_LANE() < 16) misc[MK_LANE()] = 0u;
    __syncthreads();
    XcdBarrier xbar = xcd_barrier_post((unsigned*)(p.ws + WS_CTL), misc, wave_id == 0 && MK_LANE() == 0);
#ifdef PROBE_PH
    int probe_rep = 0;
#endif
#ifdef PROBE_CLK
    unsigned probe_val = 0;
#endif
    for (int ph = p.ph_lo; ph < p.ph_hi; ++ph) {
        if (ph > p.ph_lo) {
#if MK_CG_SYNC
            cooperative_groups::this_grid().sync();
#else
            { unsigned zb_ = 0u; asm volatile("" : "+v"(zb_)); xcd_barrier(xbar, wave_id == 0 && __builtin_amdgcn_mbcnt_hi(~0u, __builtin_amdgcn_mbcnt_lo(~0u, zb_)) == 0u); }
#endif
        }
        KPC pp = (KPC)__builtin_amdgcn_kernarg_segment_ptr(); asm volatile("" : "+s"(pp));
        unsigned z_ = 0u; asm volatile("" : "+v"(z_));
        int tid = wave_id * 64 + (int)__builtin_amdgcn_mbcnt_hi(~0u, __builtin_amdgcn_mbcnt_lo(~0u, z_)); asm volatile("" : "+v"(tid));
        int bx = blockIdx.x; asm volatile("" : "+s"(bx));
        Frame F; F.lds = (LAS unsigned char*)lds_raw; F.tid = tid; F.lane = tid & 63; F.wave = __builtin_amdgcn_readfirstlane(tid >> 6);
        F.G = gridDim.x; F.bx = bx; F.vcu = (F.G % 8 == 0) ? (bx % 8) * (F.G / 8) + bx / 8 : bx;
#ifdef PROBE_CLK
        unsigned long long c0_ = 0, r0_ = 0;
        if (ph == PROBE_CLK) { c0_ = __builtin_amdgcn_s_memtime(); r0_ = __builtin_amdgcn_s_memrealtime(); }
#endif
        run_phase(pp, F, ph);
#ifdef PROBE_CLK
        if (ph == PROBE_CLK) { const unsigned long long c1_ = __builtin_amdgcn_s_memtime(), r1_ = __builtin_amdgcn_s_memrealtime();
            probe_val = (unsigned)(((c1_ - c0_) * 10ull) / (r1_ - r0_ + 1ull)); }
        if (ph == p.ph_hi - 1 && blockIdx.x == 0 && wave_id == 0 && MK_LANE() == 0) {
            const unsigned long long t0_ = __builtin_amdgcn_s_memrealtime();
            while (__builtin_amdgcn_s_memrealtime() - t0_ < (unsigned long long)probe_val * 100ull) __builtin_amdgcn_s_sleep(8);
        }
#endif
#ifdef PROBE_PH
        if (ph == PROBE_PH && probe_rep == 0) { probe_rep = 1; --ph; }
#endif
    }
#ifdef PROBE_SEC
    if (blockIdx.x == 0 && wave_id == 0 && MK_LANE() == 0) {
        const unsigned v_ = __hip_atomic_load((unsigned*)(p.ws + WS_SCAL) + 64, __ATOMIC_RELAXED, __HIP_MEMORY_SCOPE_AGENT) / 1280u;
        const unsigned long long t0_ = __builtin_amdgcn_s_memrealtime();
        while (__builtin_amdgcn_s_memrealtime() - t0_ < (unsigned long long)v_ * 100ull) __builtin_amdgcn_s_sleep(8);
    }
#endif
}

#ifndef MK_PER_PHASE
#define MK_PER_PHASE 0
#endif
#ifndef MK_DBG
#define MK_DBG 0
#endif
#if MK_DBG
#endif

static void fill_kp(KP& p, void* const* d_in, void* d_out, void* d_ws) {
    const float** f = (const float**)&p;
    for (int i = 0; i < 21; ++i) f[i] = (const float*)d_in[i];
    p.out = (float*)d_out; p.ws = (unsigned char*)d_ws;
}

extern "C" void kernel_launch(void* const* d_in, const int* in_sizes, int n_in, void* d_out, int out_size, void* d_ws, size_t ws_size, hipStream_t stream) {
    static int grid = 0;
    if (grid == 0) {
        int dev = 0, cus = 0, per_cu = 0;
        if (n_in != 21 || out_size != MTOK * DM || ws_size < WS_END) { fprintf(stderr, "kernel_launch: unexpected shapes (n_in %d out %d ws %zu)\n", n_in, out_size, ws_size); grid = -1; return; }
        (void)hipGetDevice(&dev); (void)hipDeviceGetAttribute(&cus, hipDeviceAttributeMultiprocessorCount, dev);
        if (hipFuncSetAttribute((const void*)mega, hipFuncAttributeMaxDynamicSharedMemorySize, LDS_BYTES) != hipSuccess) { fprintf(stderr, "kernel_launch: hipFuncSetAttribute failed\n"); grid = -1; return; }
        if (hipOccupancyMaxActiveBlocksPerMultiprocessor(&per_cu, (const void*)mega, 512, LDS_BYTES) != hipSuccess || per_cu < 1) { fprintf(stderr, "kernel_launch: occupancy query says %d\n", per_cu); per_cu = 1; }
        (void)hipGetLastError();
        grid = cus * 1;
        if (grid % 8 != 0 || grid < 8) grid = 256;
    }
    if (grid < 0) return;
    KP p{}; fill_kp(p, d_in, d_out, d_ws);
#if MK_DBG
    dbg_forward(p, grid, stream);
#elif MK_PER_PHASE
    (void)hipMemsetAsync((char*)d_ws + WS_CTL, 0, 65536, stream);
    for (int ph = 0; ph < N_PHASES; ++ph) { p.ph_lo = ph; p.ph_hi = ph + 1; hipLaunchKernelGGL(mega, dim3(grid), dim3(512), LDS_BYTES, stream, p); }
#else
    p.ph_lo = 0; p.ph_hi = N_PHASES;
#if MK_CG_SYNC
    void* args[] = {&p};
    hipError_t e = hipLaunchCooperativeKernel((const void*)mega, dim3(grid), dim3(512), args, LDS_BYTES, stream);
    if (e != hipSuccess) fprintf(stderr, "cooperative launch failed: %s (grid %d)\n", hipGetErrorString(e), grid);
#else
    (void)hipMemsetAsync((char*)d_ws + WS_CTL, 0, 65536, stream);
    hipLaunchKernelGGL(mega, dim3(grid), dim3(512), LDS_BYTES, stream, p);
#endif
#endif
}
```
